# Optimizing an MI355X kernel written in HIP

```python
import math
import jax
import jax.numpy as jnp
from jax import lax
import numpy as np

D_MODEL = 2048
BATCH = 2
SEQ = 8192
DEPTH = 1
DEC_BATCH = 128
DEC_SEQ = 1
PAST_LEN = 16384
PAGE_SIZE = 128

N_HEADS = 32
HEAD_DIM = 64
N_KV_HEADS = 4
GQA_GROUP = N_HEADS // N_KV_HEADS
D_ATTN = N_HEADS * HEAD_DIM
D_KV = N_KV_HEADS * HEAD_DIM
WINDOW = 128
BLOCK = 128
N_BUCKETS = 32
MAX_DISTANCE = WINDOW
SG_GROUPS = 16
SG_CHUNK = 128
D_SG = D_MODEL
SG_CH = D_SG // SG_GROUPS
D_FF = ((8 * D_MODEL // 3 + 255) // 256) * 256
CONV_W = 3
N_MOD = 6
EPS = 1e-6
NEG = -1e30
D_IN = D_ATTN + 2 * D_KV + 2 * D_SG + 2 * D_MODEL
SPLITS = (D_ATTN, D_ATTN + D_KV, D_ATTN + 2 * D_KV, D_ATTN + 2 * D_KV + D_SG,
          D_ATTN + 2 * D_KV + 2 * D_SG, D_ATTN + 2 * D_KV + 2 * D_SG + D_MODEL)

kernel_name = 'hybrid_swa_sink_gmlp_convffn_step'


def _rmsnorm(x, g):
    xf = x.astype(jnp.float32)
    y = xf * lax.rsqrt(jnp.mean(xf * xf, axis=-1, keepdims=True) + EPS)
    return (y * g.astype(jnp.float32)).astype(x.dtype)


def _layernorm(x, g, b):
    xf = x.astype(jnp.float32)
    xc = xf - jnp.mean(xf, axis=-1, keepdims=True)
    y = xc * lax.rsqrt(jnp.mean(xc * xc, axis=-1, keepdims=True) + EPS)
    return (y * g.astype(jnp.float32) + b.astype(jnp.float32)).astype(x.dtype)


def _t5_bucket(dist):
    max_exact = N_BUCKETS // 2
    d = jnp.maximum(dist, 0)
    ratio = jnp.log(jnp.maximum(d, 1).astype(jnp.float32) / max_exact) / math.log(MAX_DISTANCE / max_exact)
    large = jnp.minimum(max_exact + (ratio * (N_BUCKETS - max_exact)).astype(jnp.int32), N_BUCKETS - 1)
    return jnp.where(d < max_exact, d, large)


def _rel_bias(rel_bias, dist):
    b = rel_bias.astype(jnp.float32)[_t5_bucket(dist)]
    return jnp.transpose(b, (2, 0, 1)).reshape(N_KV_HEADS, GQA_GROUP, dist.shape[0], dist.shape[1])


def _sink_softmax(s, sinks):
    sink = sinks.astype(jnp.float32).reshape(N_KV_HEADS, GQA_GROUP, 1, 1)
    m = jnp.maximum(jnp.max(s, axis=-1, keepdims=True), sink)
    p = jnp.exp(s - m)
    return p / (jnp.sum(p, axis=-1, keepdims=True) + jnp.exp(sink - m))


def _swa_prompt(q, k, v, sinks, rel_bias):
    B, S = q.shape[0], q.shape[1]
    nb = S // BLOCK
    qb = q.reshape(B, nb, BLOCK, N_KV_HEADS, GQA_GROUP, HEAD_DIM)
    kb = k.reshape(B, nb, BLOCK, N_KV_HEADS, HEAD_DIM)
    vb = v.reshape(B, nb, BLOCK, N_KV_HEADS, HEAD_DIM)
    pad = ((0, 0), (1, 0), (0, 0), (0, 0), (0, 0))
    kk = jnp.concatenate([jnp.pad(kb, pad)[:, :-1], kb], axis=2)
    vv = jnp.concatenate([jnp.pad(vb, pad)[:, :-1], vb], axis=2)
    qi = jnp.arange(BLOCK)[:, None] + BLOCK
    kj = jnp.arange(2 * BLOCK)[None, :]
    dist = qi - kj
    in_window = (dist >= 0) & (dist <= WINDOW)
    valid = in_window[None] & ((jnp.arange(nb)[:, None, None] > 0) | (kj[None] >= BLOCK))
    s = jnp.einsum('bnqkgd,bnskd->bnkgqs', qb, kk, preferred_element_type=jnp.float32) * (HEAD_DIM ** -0.5)
    s = s + _rel_bias(rel_bias, dist)
    s = jnp.where(valid[None, :, None, None], s, NEG)
    p = _sink_softmax(s, sinks).astype(v.dtype)
    o = jnp.einsum('bnkgqs,bnskd->bnqkgd', p, vv).reshape(B, S, D_ATTN)
    return o, k[:, S - WINDOW:], v[:, S - WINDOW:]


def _swa_sample(q, k, v, k_buf, v_buf, sinks, rel_bias):
    B, T = q.shape[0], q.shape[1]
    kk = jnp.concatenate([k_buf.astype(k.dtype), k], axis=1)
    vv = jnp.concatenate([v_buf.astype(v.dtype), v], axis=1)
    dist = (jnp.arange(T)[:, None] + WINDOW) - jnp.arange(WINDOW + T)[None, :]
    valid = (dist >= 0) & (dist <= WINDOW)
    qg = q.reshape(B, T, N_KV_HEADS, GQA_GROUP, HEAD_DIM)
    s = jnp.einsum('btkgd,bskd->bkgts', qg, kk, preferred_element_type=jnp.float32) * (HEAD_DIM ** -0.5)
    s = s + _rel_bias(rel_bias, dist)
    s = jnp.where(valid, s, NEG)
    p = _sink_softmax(s, sinks).astype(v.dtype)
    o = jnp.einsum('bkgts,bskd->btkgd', p, vv).reshape(B, T, D_ATTN)
    return o, kk[:, T:], vv[:, T:]


def _spatial_gate(u, vn, w_s, b_s):
    T = u.shape[2]
    w = jnp.where(jnp.tril(jnp.ones((T, T), dtype=bool))[None], w_s[:, :T, :T], 0)
    s = jnp.einsum('gij,bnjgc->bnigc', w, vn) + b_s[:, :T].T[None, None, :, :, None]
    return u * s


def _conv_ffn(h, w_up, w_gate, conv_w, conv_b, w_down, conv_buf):
    T = h.shape[1]
    a = h @ w_gate
    u = h @ w_up
    if conv_buf is None:
        ap = jnp.pad(a, ((0, 0), (CONV_W - 1, 0), (0, 0)))
    else:
        ap = jnp.concatenate([conv_buf.astype(a.dtype), a], axis=1)
    conv = conv_b
    for tap in range(CONV_W):
        conv = conv + conv_w[tap] * ap[:, tap:tap + T]
    hid = jax.nn.gelu(conv) * u
    return hid @ w_down, ap[:, T:]


def _layer(x, c, w_ada, b_ada, g_pre_mix, g_post_mix, g_pre_ffn, g_post_ffn, w_in, w_o, sinks, rel_bias,
           sg_ln_g, sg_ln_b, w_s, b_s, w_up, w_gate, conv_w, conv_b, w_down, k_buf, v_buf, conv_buf):
    B, T = x.shape[0], x.shape[1]
    mod = jax.nn.silu(c) @ w_ada + b_ada
    sh_m, sc_m, gt_m, sh_f, sc_f, gt_f = jnp.split(mod[:, None, :], N_MOD, axis=-1)
    h = _rmsnorm(x, g_pre_mix) * (1 + sc_m) + sh_m
    z = h @ w_in
    q, k, v, u, vg, ga, gb = jnp.split(z, SPLITS, axis=-1)
    q = q.reshape(B, T, N_HEADS, HEAD_DIM)
    k = k.reshape(B, T, N_KV_HEADS, HEAD_DIM)
    v = v.reshape(B, T, N_KV_HEADS, HEAD_DIM)
    if k_buf is None:
        y_a, k_new, v_new = _swa_prompt(q, k, v, sinks, rel_bias)
        chunk = SG_CHUNK
    else:
        y_a, k_new, v_new = _swa_sample(q, k, v, k_buf, v_buf, sinks, rel_bias)
        chunk = T
    u = jax.nn.gelu(u)
    vn = _layernorm(jax.nn.gelu(vg), sg_ln_g, sg_ln_b)
    shp = (B, T // chunk, chunk, SG_GROUPS, SG_CH)
    y_b = _spatial_gate(u.reshape(shp), vn.reshape(shp), w_s, b_s).reshape(B, T, D_SG)
    merged = jax.nn.sigmoid(ga) * y_a + jax.nn.sigmoid(gb) * y_b
    x = x + gt_m * _rmsnorm(merged @ w_o, g_post_mix)
    h2 = _rmsnorm(x, g_pre_ffn) * (1 + sc_f) + sh_f
    y_f, conv_new = _conv_ffn(h2, w_up, w_gate, conv_w, conv_b, w_down, conv_buf)
    x = x + gt_f * _rmsnorm(y_f, g_post_ffn)
    return x, k_new, v_new, conv_new, vn


def setup_inputs(seed: int = 0) -> dict:
    key = jax.random.key(seed)
    ks = jax.random.split(key, 32)

    def nrm(k, shape, scale=1.0):
        return scale * jax.random.normal(k, shape, jnp.float32)

    L = DEPTH
    return {
        'x_prompt': nrm(ks[0], (BATCH, SEQ, D_MODEL)),
        'x_sample': nrm(ks[1], (DEC_BATCH, DEC_SEQ, D_MODEL)),
        'c_prompt': nrm(ks[2], (BATCH, D_MODEL)),
        'c_sample': nrm(ks[3], (DEC_BATCH, D_MODEL)),
        'cache_k_win': nrm(ks[4], (L, DEC_BATCH, WINDOW, N_KV_HEADS, HEAD_DIM)),
        'cache_v_win': nrm(ks[5], (L, DEC_BATCH, WINDOW, N_KV_HEADS, HEAD_DIM)),
        'state_ffn_conv': nrm(ks[6], (L, DEC_BATCH, CONV_W - 1, D_FF)),
        'w_ada': nrm(ks[7], (L, D_MODEL, N_MOD * D_MODEL), 0.5 * D_MODEL ** -0.5),
        'b_ada': nrm(ks[8], (L, N_MOD * D_MODEL), 0.01),
        'g_pre_mix': 1.0 + nrm(ks[9], (L, D_MODEL), 0.05),
        'g_post_mix': 1.0 + nrm(ks[10], (L, D_MODEL), 0.05),
        'g_pre_ffn': 1.0 + nrm(ks[11], (L, D_MODEL), 0.05),
        'g_post_ffn': 1.0 + nrm(ks[12], (L, D_MODEL), 0.05),
        'w_in': nrm(ks[13], (L, D_MODEL, D_IN), D_MODEL ** -0.5),
        'w_o': nrm(ks[14], (L, D_MODEL, D_MODEL), D_MODEL ** -0.5),
        'sinks': nrm(ks[15], (L, N_HEADS)),
        'rel_bias': nrm(ks[16], (N_BUCKETS, N_HEADS), 0.5),
        'sg_ln_g': 1.0 + nrm(ks[17], (L, D_SG), 0.05),
        'sg_ln_b': nrm(ks[18], (L, D_SG), 0.02),
        'w_s': nrm(ks[19], (L, SG_GROUPS, SG_CHUNK, SG_CHUNK), SG_CHUNK ** -0.5),
        'b_s': 1.0 + nrm(ks[20], (L, SG_GROUPS, SG_CHUNK), 0.1),
        'w_up': nrm(ks[21], (L, D_MODEL, D_FF), D_MODEL ** -0.5),
        'w_gate': nrm(ks[22], (L, D_MODEL, D_FF), D_MODEL ** -0.5),
        'conv_w': nrm(ks[23], (L, CONV_W, D_FF), CONV_W ** -0.5),
        'conv_b': nrm(ks[24], (L, D_FF), 0.01),
        'w_down': nrm(ks[25], (L, D_FF, D_MODEL), D_FF ** -0.5),
    }


def reference(x_prompt, x_sample, c_prompt, c_sample, cache_k_win, cache_v_win, state_ffn_conv,
              w_ada, b_ada, g_pre_mix, g_post_mix, g_pre_ffn, g_post_ffn, w_in, w_o, sinks, rel_bias,
              sg_ln_g, sg_ln_b, w_s, b_s, w_up, w_gate, conv_w, conv_b, w_down):
    y_p, y_s = x_prompt, x_sample
    kp_l, vp_l, cp_l, ks_l, vs_l, cs_l, sg_l = [], [], [], [], [], [], []
    for l in range(DEPTH):
        lw = (w_ada[l], b_ada[l], g_pre_mix[l], g_post_mix[l], g_pre_ffn[l], g_post_ffn[l], w_in[l], w_o[l],
              sinks[l], rel_bias, sg_ln_g[l], sg_ln_b[l], w_s[l], b_s[l], w_up[l], w_gate[l], conv_w[l],
              conv_b[l], w_down[l])
        y_p, kp, vp, cp, _ = _layer(y_p, c_prompt, *lw, None, None, None)
        y_s, ksn, vsn, csn, sgv = _layer(y_s, c_sample, *lw, cache_k_win[l], cache_v_win[l], state_ffn_conv[l])
        kp_l.append(kp)
        vp_l.append(vp)
        cp_l.append(cp)
        ks_l.append(ksn)
        vs_l.append(vsn)
        cs_l.append(csn)
        sg_l.append(sgv)
    return (y_p, y_s, jnp.stack(kp_l), jnp.stack(vp_l), jnp.stack(cp_l),
            jnp.stack(ks_l), jnp.stack(vs_l), jnp.stack(cs_l), jnp.stack(sg_l))
```

```cpp
#include <hip/hip_runtime.h>
#include <cstdio>
#include <cstdint>

constexpr int DM = 2048, SEQ = 8192, NBATCH = 2, MPROMPT = NBATCH * SEQ, NSAMP = 128, MTOK = MPROMPT + NSAMP, MPAD = 16640;
constexpr int DIN = 10752, DFF = 5632, NMODC = 12288, NMODR = 130;
constexpr int CQ = 0, CK = 2048, CV = 2304, CU = 2560, CG = 4608, CGA = 6656, CGB = 8704;
constexpr float EPS = 1e-6f, LOG2E = 1.4426950408889634f, QSCALE = 0.125f * 1.4426950408889634f;
constexpr size_t O_YP = 0, O_YS = 33554432, O_KP = 33816576, O_VP = 33882112, O_CP = 33947648, O_KS = 33970176, O_VS = 38164480, O_CS = 42358784, O_SG = 43800576, O_END = 44062720;

constexpr size_t KiB = 1024, MiB = 1u << 20;
constexpr size_t WS_CTL = 0, CTL_ZERO_BYTES = 64 * KiB;
constexpr size_t WS_MOD = 1 * MiB;
constexpr size_t WS_STAT = WS_MOD + 6656 * KiB;
constexpr size_t WS_TRIL = WS_STAT + 4352 * KiB;
constexpr size_t WS_WO = WS_TRIL + 512 * KiB;
constexpr size_t WS_WGU = WS_WO + 8 * MiB;
constexpr size_t WS_WD = WS_WGU + 44 * MiB;
constexpr size_t WS_ARENA = WS_WD + 22 * MiB;
constexpr size_t WS_WIN = WS_ARENA;
constexpr size_t WS_Z = WS_ARENA + 42 * MiB;
constexpr size_t WS_O = WS_ARENA;
constexpr size_t WS_ABUF = WS_ARENA;
constexpr size_t WS_UBUF = WS_ABUF + (size_t)MPAD * DFF * 2;
constexpr size_t WS_H2 = WS_UBUF + (size_t)MPAD * DFF * 2;
constexpr size_t WS_YF = WS_ABUF;
constexpr size_t WS_END = WS_H2 + (size_t)MPAD * DM * 2;
static_assert(WS_MOD + (size_t)NMODR * NMODC * 4 <= WS_STAT && WS_STAT + (size_t)32 * MPAD * 8 <= WS_TRIL, "ws map");
static_assert(WS_Z + (size_t)MPAD * DIN * 2 <= 512 * MiB && WS_END <= 512 * MiB, "ws map exceeds 512 MiB");

constexpr int RING_BYTES = 131072;
constexpr int MISC_OFF = 143360;
constexpr int LDS_BYTES = 147456;

#define GAS __attribute__((address_space(1)))
#define LAS __attribute__((address_space(3)))
typedef unsigned short bf16;
typedef unsigned v4u __attribute__((ext_vector_type(4)));
typedef unsigned v2u __attribute__((ext_vector_type(2)));
typedef float f32x2 __attribute__((ext_vector_type(2)));
typedef float f32x4 __attribute__((ext_vector_type(4)));
typedef float f32x16 __attribute__((ext_vector_type(16)));
typedef short bf16x8 __attribute__((ext_vector_type(8)));
typedef short s16x4 __attribute__((ext_vector_type(4)));
typedef __bf16 bf16x2_t __attribute__((ext_vector_type(2)));
typedef GAS unsigned gu32;
#define RLX_AGENT __ATOMIC_RELAXED, __HIP_MEMORY_SCOPE_AGENT
#define LDS_WAIT() asm volatile("s_waitcnt lgkmcnt(0)" ::: "memory")
#define VM_WAIT() asm volatile("s_waitcnt vmcnt(0)" ::: "memory")

__device__ __forceinline__ unsigned cvtpk(float lo, float hi) { f32x2 v = {lo, hi}; bf16x2_t b = __builtin_convertvector(v, bf16x2_t); return __builtin_bit_cast(unsigned, b); }
__device__ __forceinline__ float bflo(unsigned w) { return __uint_as_float(w << 16); }
__device__ __forceinline__ float bfhi(unsigned w) { return __uint_as_float(w & 0xffff0000u); }
__device__ __forceinline__ float bf1(bf16 b) { return __uint_as_float((unsigned)b << 16); }
__device__ __forceinline__ float fast_rcp(float x) { return __builtin_amdgcn_rcpf(x); }
__device__ __forceinline__ float fast_exp2(float x) { return __builtin_amdgcn_exp2f(x); }
__device__ __forceinline__ float sigmoid_f(float x) { return fast_rcp(1.0f + fast_exp2(-LOG2E * x)); }
__device__ __forceinline__ float gelu_f(float x) { const float u = x * (0.7978845608028654f + 0.035677408136300125f * x * x); return x * fast_rcp(1.0f + fast_exp2(-2.0f * LOG2E * u)); }
__device__ __forceinline__ float silu_f(float x) { return x * sigmoid_f(x); }
__device__ __forceinline__ float wave_sum(float v) {
#pragma unroll
    for (int o = 1; o < 64; o <<= 1) v += __shfl_xor(v, o);
    return v;
}
__device__ __forceinline__ float wave_max(float v) {
#pragma unroll
    for (int o = 1; o < 64; o <<= 1) v = fmaxf(v, __shfl_xor(v, o));
    return v;
}
__device__ __forceinline__ int t5_bucket(int d) {
    if (d < 16) return d;
    int b = 16;
    b += d >= 19; b += d >= 21; b += d >= 24; b += d >= 27; b += d >= 31; b += d >= 35; b += d >= 40; b += d >= 46; b += d >= 52; b += d >= 59; b += d >= 67; b += d >= 77; b += d >= 87; b += d >= 99; b += d >= 113;
    return b;
}
namespace pg8 {
#define PG8_LAS __attribute__((address_space(3)))
typedef unsigned short bf16_t;
typedef short bf16x8 __attribute__((ext_vector_type(8)));
typedef float f32x4 __attribute__((ext_vector_type(4)));
typedef unsigned u32x4 __attribute__((ext_vector_type(4)));
constexpr int BM = 256, BK = 64, HALF = 128, HTB = HALF * BK * 2  , STAGE_BYTES = 8 * HTB, NXCD = 8, WGM = 8;

__host__ __device__ __forceinline__ int lds_byte(int r, int c) { const int st = (r >> 4) * 2 + (c >> 5), rr = r & 15, cc = c & 31, ob = rr * 64 + cc * 2; return st * 1024 + (ob ^ (((ob >> 9) & 1) << 5)); }
__host__ __device__ __forceinline__ void stage_rc(int b, int& R, int& C) { const int st = b / 1024, sb = b % 1024, swz = sb ^ (((sb >> 9) & 1) << 5); R = (st >> 1) * 16 + swz / 64; C = (st & 1) * 32 + (swz % 64) / 2; }
__host__ __device__ __forceinline__ int perm32(int rho) { const int n = rho >> 4, i = rho & 15; return 8 * (i >> 2) + 4 * n + (i & 3); }

struct Unit { int pm, pn; };
struct Gemm { const bf16_t* A; const bf16_t* Bt; int M, N, K; };

struct StaticOrder {
    int nM, nN, nwg, G, c;
    __host__ __device__ void init(int M, int N, int G_, int c_) { nM = M / BM; nN = N / BM; nwg = nM * nN; G = G_; c = c_; }
    __host__ __device__ bool next(int i, Unit& u) const {
        const long L = (long)i * G + c; if (L >= nwg) return false;
        int wgid = (int)L; { const int q = nwg / NXCD, r = nwg % NXCD, xcd = wgid % NXCD, off = wgid / NXCD; wgid = (xcd < r ? xcd * (q + 1) : r * (q + 1) + (xcd - r) * q) + off; }
        const int nig = WGM * nN, gid = wgid / nig, fm = gid * WGM, gsz = (nM - fm) < WGM ? (nM - fm) : WGM;
        u.pm = fm + ((wgid % nig) % gsz); u.pn = (wgid % nig) / gsz; return true;
    }
    __device__ __forceinline__ void a_ready(const Unit&) const {}
    __device__ __forceinline__ void done(const Unit&) const {}
};

__device__ __forceinline__ void store8(bf16_t* p, const f32x4 v0, const f32x4 v1) {
    u32x4 w; w.x = cvtpk(v0[0], v0[1]); w.y = cvtpk(v0[2], v0[3]); w.z = cvtpk(v1[0], v1[1]); w.w = cvtpk(v1[2], v1[3]); *(u32x4*)p = w;
}
struct EpiPlain {
    static constexpr bool PERM = true, AFTER_DRAIN = false;
    bf16_t* O; int ldc;
    __device__ __forceinline__ void operator()(const f32x4 (&acc)[2][2][4][2], const Unit& u, int wr, int wc, int fr, int fq) const {
        const int row0 = u.pm * BM + wr * 64 + fr, col0 = u.pn * BM + wc * 32 + 8 * fq;
#pragma unroll
        for (int ai = 0; ai < 2; ++ai)
#pragma unroll
            for (int m = 0; m < 4; ++m) { bf16_t* rowp = O + (size_t)(row0 + ai * HALF + m * 16) * ldc + col0;
#pragma unroll
                for (int bj = 0; bj < 2; ++bj) store8(rowp + bj * HALF, acc[ai][bj][m][0], acc[ai][bj][m][1]); }
    }
};
struct EpiZ {
    static constexpr bool PERM = true, AFTER_DRAIN = false;
    bf16_t* Z; float* out; f32x2* stat;
    __device__ __forceinline__ void operator()(const f32x4 (&acc)[2][2][4][2], const Unit& u, int wr, int wc, int fr, int fq) const {
        const int pn = u.pn, row0 = u.pm * BM + wr * 64 + fr, cw = wc * 32 + 8 * fq, col0 = pn * BM + cw;
        if (pn < 8) {
#pragma unroll
            for (int ai = 0; ai < 2; ++ai)
#pragma unroll
                for (int m = 0; m < 4; ++m) { bf16_t* rowp = Z + (size_t)(row0 + ai * HALF + m * 16) * DIN + col0;
#pragma unroll
                    for (int bj = 0; bj < 2; ++bj) store8(rowp + bj * HALF, acc[ai][bj][m][0] * QSCALE, acc[ai][bj][m][1] * QSCALE); }
        } else if (pn < 10) {
            const size_t o_p = (pn == 8) ? O_KP : O_VP, o_s = (pn == 8) ? O_KS : O_VS;
#pragma unroll
            for (int ai = 0; ai < 2; ++ai)
#pragma unroll
                for (int m = 0; m < 4; ++m) { const int lr = wr * 64 + m * 16 + fr; bf16_t* rowp = Z + (size_t)(row0 + ai * HALF + m * 16) * DIN + col0;
#pragma unroll
                    for (int bj = 0; bj < 2; ++bj) { const f32x4 v0 = acc[ai][bj][m][0], v1 = acc[ai][bj][m][1]; store8(rowp + bj * HALF, v0, v1);
                        if (ai == 1 && (u.pm == 31 || u.pm == 63)) { float* d = out + o_p + (size_t)((u.pm >> 5) * 128 + lr) * 256 + cw + bj * HALF; *(f32x4*)d = v0; *(f32x4*)(d + 4) = v1; }
                        if (ai == 0 && u.pm == 64) { float* d = out + o_s + (size_t)(lr * 128 + 127) * 256 + cw + bj * HALF; *(f32x4*)d = v0; *(f32x4*)(d + 4) = v1; } } }
        } else if (pn < 26) {
#pragma unroll
            for (int ai = 0; ai < 2; ++ai)
#pragma unroll
                for (int m = 0; m < 4; ++m) { const int row = row0 + ai * HALF + m * 16; bf16_t* rowp = Z + (size_t)row * DIN + col0; float s1 = 0.f, s2 = 0.f;
#pragma unroll
                    for (int bj = 0; bj < 2; ++bj) { f32x4 v0 = acc[ai][bj][m][0], v1 = acc[ai][bj][m][1];
#pragma unroll
                        for (int i = 0; i < 4; ++i) { v0[i] = gelu_f(v0[i]); v1[i] = gelu_f(v1[i]); s1 += v0[i] + v1[i]; s2 += v0[i] * v0[i] + v1[i] * v1[i]; }
                        store8(rowp + bj * HALF, v0, v1); }
                    if (pn >= 18) { s1 += __shfl_xor(s1, 16); s1 += __shfl_xor(s1, 32); s2 += __shfl_xor(s2, 16); s2 += __shfl_xor(s2, 32);
                        if (fq == 0) stat[(size_t)((pn - 18) * 4 + wc) * MPAD + row] = (f32x2){s1, s2}; } }
        } else {
#pragma unroll
            for (int ai = 0; ai < 2; ++ai)
#pragma unroll
                for (int m = 0; m < 4; ++m) { bf16_t* rowp = Z + (size_t)(row0 + ai * HALF + m * 16) * DIN + col0;
#pragma unroll
                    for (int bj = 0; bj < 2; ++bj) { f32x4 v0 = acc[ai][bj][m][0], v1 = acc[ai][bj][m][1];
#pragma unroll
                        for (int i = 0; i < 4; ++i) { v0[i] = sigmoid_f(v0[i]); v1[i] = sigmoid_f(v1[i]); }
                        store8(rowp + bj * HALF, v0, v1); } }
        }
    }
};
struct EpiGU {
    static constexpr bool PERM = true, AFTER_DRAIN = false;
    bf16_t* A; bf16_t* U; float* out;
    __device__ __forceinline__ void operator()(const f32x4 (&acc)[2][2][4][2], const Unit& u, int wr, int wc, int fr, int fq) const {
        const bool isa = u.pn < 22; const int row0 = u.pm * BM + wr * 64 + fr, col0 = (isa ? u.pn : u.pn - 22) * BM + wc * 32 + 8 * fq; bf16_t* base = isa ? A : U;
#pragma unroll
        for (int ai = 0; ai < 2; ++ai)
#pragma unroll
            for (int m = 0; m < 4; ++m) { const int lr = wr * 64 + m * 16 + fr; bf16_t* rowp = base + (size_t)(row0 + ai * HALF + m * 16) * DFF + col0;
#pragma unroll
                for (int bj = 0; bj < 2; ++bj) { const f32x4 v0 = acc[ai][bj][m][0], v1 = acc[ai][bj][m][1]; store8(rowp + bj * HALF, v0, v1);
                    if (isa && ai == 1 && lr >= 126 && (u.pm == 31 || u.pm == 63)) { float* d = out + O_CP + (size_t)((u.pm >> 5) * 2 + (lr - 126)) * DFF + col0 + bj * HALF; *(f32x4*)d = v0; *(f32x4*)(d + 4) = v1; }
                    if (isa && ai == 0 && u.pm == 64) { float* d = out + O_CS + (size_t)(lr * 2 + 1) * DFF + col0 + bj * HALF; *(f32x4*)d = v0; *(f32x4*)(d + 4) = v1; } } }
    }
};
template <class Epi, class Sched, bool ALIGN_EPI = false, bool SP2 = false>
__device__ __forceinline__ void gemm_phase(PG8_LAS unsigned char* lds, const Gemm g, const Sched& S, const Epi& E) {
    const int tid = threadIdx.x, wid = __builtin_amdgcn_readfirstlane(tid >> 6), lane = tid & 63, wr = wid >> 2, wc = wid & 3, fr = lane & 15, fq = lane >> 4;
    const int K = g.K, nt = K / BK;
    unsigned voffA[2], voffB[2];
#pragma unroll
    for (int i = 0; i < 2; ++i) { int R, C; stage_rc(tid * 16 + i * 8192, R, C); const int Rb = Epi::PERM ? ((R & ~31) + perm32(R & 31)) : R;
        voffA[i] = (unsigned)(R * K + C) * 2u; voffB[i] = (unsigned)(Rb * K + C) * 2u; }
    const size_t kstep = (size_t)(BK * 2);
    const size_t hstep = (size_t)HALF * K * 2;
    const size_t tstep = 2 * hstep;
    const unsigned ldsw = (unsigned)wid * 1024u;
    const int aoff = lds_byte(wr * 64 + fr, fq * 8), boff = lds_byte(wc * 32 + fr, fq * 8);
#define PG8_SA(b, h) (((b) * 2 + (h)) * HTB)
#define PG8_SB(b, h) ((4 + (b) * 2 + (h)) * HTB)
#define PG8_STAGE(bufoff, gbase, voff) do { _Pragma("unroll") for (int _i = 0; _i < 2; ++_i) \
        __builtin_amdgcn_global_load_lds((const unsigned*)((const char*)(gbase) + (voff)[_i]), (PG8_LAS unsigned*)(lds + (bufoff) + ldsw + _i * 8192), 16, 0, 0); } while (0)
#define PG8_LDA(dst, b, h) do { _Pragma("unroll") for (int m = 0; m < 4; ++m) _Pragma("unroll") for (int k = 0; k < 2; ++k) dst[m][k] = *(const PG8_LAS bf16x8*)(lds + PG8_SA(b, h) + aoff + m * 2048 + k * 1024); } while (0)
#define PG8_LDB(dst, b, h) do { _Pragma("unroll") for (int n = 0; n < 2; ++n) _Pragma("unroll") for (int k = 0; k < 2; ++k) dst[n][k] = *(const PG8_LAS bf16x8*)(lds + PG8_SB(b, h) + boff + n * 2048 + k * 1024); } while (0)
#define PG8_MMA(ai, bj, At, Bt) do { __builtin_amdgcn_s_setprio(1); _Pragma("unroll") for (int m = 0; m < 4; ++m) _Pragma("unroll") for (int n = 0; n < 2; ++n) _Pragma("unroll") for (int k = 0; k < 2; ++k) \
        acc[ai][bj][m][n] = __builtin_amdgcn_mfma_f32_16x16x32_bf16(Bt[n][k], At[m][k], acc[ai][bj][m][n], 0, 0, 0); __builtin_amdgcn_s_setprio(0); } while (0)
#define PG8_WAIT_V(n) asm volatile("s_waitcnt vmcnt(" #n ")" ::: "memory")
#define PG8_WAIT_L(n) asm volatile("s_waitcnt lgkmcnt(" #n ")" ::: "memory")
#define PG8_BAR __builtin_amdgcn_s_barrier()
#define PG8_SCHED __builtin_amdgcn_sched_barrier(0)
    Unit cur, nxt; int ui = 0;
    if (!S.next(0, cur)) return;
    f32x4 acc[2][2][4][2];
#pragma unroll
    for (int a = 0; a < 2; ++a)
#pragma unroll
        for (int b = 0; b < 2; ++b)
#pragma unroll
            for (int m = 0; m < 4; ++m)
#pragma unroll
                for (int n = 0; n < 2; ++n) acc[a][b][m][n] = (f32x4){0.f, 0.f, 0.f, 0.f};
    bf16x8 At[4][2], B0[2][2], B1[2][2];
    const char* cA = (const char*)g.A + (size_t)cur.pm * tstep; const char* cB = (const char*)g.Bt + (size_t)cur.pn * tstep;
    S.a_ready(cur);
    if constexpr (SP2) {
        PG8_STAGE(PG8_SB(0, 0), cB, voffB); PG8_STAGE(PG8_SB(0, 1), cB + hstep, voffB); PG8_STAGE(PG8_SA(0, 0), cA, voffA); PG8_STAGE(PG8_SA(0, 1), cA + hstep, voffA);
        if (wr == 1) PG8_BAR;
        PG8_WAIT_V(2); PG8_BAR;
        PG8_STAGE(PG8_SB(1, 0), cB + kstep, voffB); PG8_STAGE(PG8_SA(1, 0), cA + kstep, voffA); PG8_STAGE(PG8_SB(1, 1), cB + hstep + kstep, voffB);
        PG8_WAIT_V(6); PG8_BAR;
    } else {
        PG8_STAGE(PG8_SB(0, 0), cB, voffB); PG8_STAGE(PG8_SA(0, 0), cA, voffA); PG8_STAGE(PG8_SB(0, 1), cB + hstep, voffB); PG8_STAGE(PG8_SA(0, 1), cA + hstep, voffA);
        if (wr == 1) PG8_BAR;
        PG8_WAIT_V(4); PG8_BAR;
        PG8_STAGE(PG8_SB(1, 0), cB + kstep, voffB); PG8_STAGE(PG8_SA(1, 0), cA + kstep, voffA); PG8_STAGE(PG8_SB(1, 1), cB + hstep + kstep, voffB);
        PG8_WAIT_V(6); PG8_BAR;
    }
    for (;;) {
        const bool has_next = S.next(ui + 1, nxt);
        const char* nA = has_next ? (const char*)g.A + (size_t)nxt.pm * tstep : cA; const char* nB = has_next ? (const char*)g.Bt + (size_t)nxt.pn * tstep : cB;
        for (int t = 0; t < nt; t += 2) {
            const bool last = (t == nt - 2);
            const char* a1 = cA + (size_t)(t + 1) * kstep;
            const char* a2 = last ? nA : cA + (size_t)(t + 2) * kstep; const char* b2 = last ? nB : cB + (size_t)(t + 2) * kstep;
            const char* a3 = a2 + kstep; const char* b3 = b2 + kstep;
            if (last && has_next) S.a_ready(nxt);
            if constexpr (SP2) {
            PG8_LDB(B0, 0, 0); PG8_LDB(B1, 0, 1); PG8_SCHED; PG8_LDA(At, 0, 0); PG8_STAGE(PG8_SA(1, 1), a1 + hstep, voffA);
            PG8_WAIT_V(8); PG8_WAIT_L(0); PG8_BAR; PG8_MMA(0, 0, At, B0); PG8_MMA(0, 1, At, B1); PG8_BAR; PG8_SCHED;
            PG8_LDA(At, 0, 1); PG8_STAGE(PG8_SB(0, 0), b2, voffB); PG8_STAGE(PG8_SB(0, 1), b2 + hstep, voffB); PG8_STAGE(PG8_SA(0, 0), a2, voffA);
            PG8_WAIT_V(8); PG8_WAIT_L(0); PG8_BAR; PG8_MMA(1, 0, At, B0); PG8_MMA(1, 1, At, B1); PG8_BAR; PG8_SCHED;
            PG8_LDB(B0, 1, 0); PG8_LDB(B1, 1, 1); PG8_SCHED; PG8_LDA(At, 1, 0); PG8_STAGE(PG8_SA(0, 1), a2 + hstep, voffA);
            PG8_WAIT_V(8); PG8_WAIT_L(0); PG8_BAR; PG8_MMA(0, 0, At, B0); PG8_MMA(0, 1, At, B1); PG8_BAR; PG8_SCHED;
            PG8_LDA(At, 1, 1); PG8_STAGE(PG8_SB(1, 0), b3, voffB); PG8_STAGE(PG8_SB(1, 1), b3 + hstep, voffB); PG8_STAGE(PG8_SA(1, 0), a3, voffA);
            PG8_WAIT_V(8); PG8_WAIT_L(0); PG8_BAR; PG8_MMA(1, 0, At, B0); PG8_MMA(1, 1, At, B1); PG8_BAR; PG8_SCHED;
            } else {
            PG8_LDB(B0, 0, 0); PG8_SCHED; PG8_LDA(At, 0, 0); PG8_STAGE(PG8_SA(1, 1), a1 + hstep, voffA);
            PG8_WAIT_L(8); PG8_BAR; PG8_WAIT_L(0); PG8_MMA(0, 0, At, B0); PG8_BAR; PG8_SCHED;
            PG8_LDB(B1, 0, 1); PG8_STAGE(PG8_SB(0, 0), b2, voffB);
            PG8_BAR; PG8_WAIT_L(0); PG8_MMA(0, 1, At, B1); PG8_BAR;
            PG8_LDA(At, 0, 1); PG8_STAGE(PG8_SA(0, 0), a2, voffA);
            PG8_BAR; PG8_WAIT_L(0); PG8_MMA(1, 0, At, B0); PG8_BAR; PG8_SCHED;
            PG8_STAGE(PG8_SB(0, 1), b2 + hstep, voffB);
            PG8_WAIT_V(6); PG8_BAR; PG8_MMA(1, 1, At, B1); PG8_BAR;
            PG8_LDB(B0, 1, 0); PG8_SCHED; PG8_LDA(At, 1, 0); PG8_STAGE(PG8_SA(0, 1), a2 + hstep, voffA);
            PG8_WAIT_L(8); PG8_BAR; PG8_WAIT_L(0); PG8_MMA(0, 0, At, B0); PG8_BAR; PG8_SCHED;
            PG8_LDB(B1, 1, 1); PG8_STAGE(PG8_SB(1, 0), b3, voffB);
            PG8_BAR; PG8_WAIT_L(0); PG8_MMA(0, 1, At, B1); PG8_BAR;
            PG8_LDA(At, 1, 1); PG8_STAGE(PG8_SA(1, 0), a3, voffA);
            PG8_BAR; PG8_WAIT_L(0); PG8_MMA(1, 0, At, B0); PG8_BAR; PG8_SCHED;
            PG8_STAGE(PG8_SB(1, 1), b3 + hstep, voffB);
            PG8_WAIT_V(6); PG8_BAR; PG8_MMA(1, 1, At, B1); PG8_BAR;
            }
        }
        if constexpr (ALIGN_EPI) { if (wr == 0) PG8_BAR; }
        if constexpr (!Epi::AFTER_DRAIN) { E(acc, cur, wr, wc, fr, fq); S.done(cur); }
        if (!has_next) break;
#pragma unroll
        for (int a = 0; a < 2; ++a)
#pragma unroll
            for (int b = 0; b < 2; ++b)
#pragma unroll
                for (int m = 0; m < 4; ++m)
#pragma unroll
                    for (int n = 0; n < 2; ++n) acc[a][b][m][n] = (f32x4){0.f, 0.f, 0.f, 0.f};
        cur = nxt; cA = nA; cB = nB; ++ui;
        if constexpr (ALIGN_EPI) { if (wr == 1) PG8_BAR; }
    }
    PG8_WAIT_V(0);
    if constexpr (!ALIGN_EPI) { if (wr == 0) PG8_BAR; }
    PG8_BAR;
    if constexpr (Epi::AFTER_DRAIN) { E.fused(acc, cur, wr, wc, fr, fq, lds, wid, lane); S.done(cur); }
#undef PG8_SA
#undef PG8_SB
#undef PG8_STAGE
#undef PG8_LDA
#undef PG8_LDB
#undef PG8_MMA
#undef PG8_WAIT_V
#undef PG8_WAIT_L
#undef PG8_BAR
#undef PG8_SCHED
}
}

#ifndef PG8_SP2
#define PG8_SP2 true
#endif
#ifndef PG8_ALIGN
#define PG8_ALIGN true
#endif
#define XB_TMO      128
#define XB_XCNT(j)  (256  + 64 * (j))
#define XB_XSUB(j)  (1280 + 64 * (j))
#define XB_XGEN(j)  (2304 + 64 * (j))
#define XB_TOP      3328
#define XB_TOPGEN   3392
#define XCD_BAR_WORDS 3456
#define XB_SPIN_CAP (1u << 18)

__device__ __forceinline__ unsigned xb_ld(unsigned* p)              { return __hip_atomic_load(p, __ATOMIC_RELAXED, __HIP_MEMORY_SCOPE_AGENT); }
__device__ __forceinline__ unsigned xb_add(unsigned* p, unsigned v) { return __hip_atomic_fetch_add(p, v, __ATOMIC_RELAXED, __HIP_MEMORY_SCOPE_AGENT); }
__device__ __forceinline__ unsigned xb_xcc_id() { return (unsigned)__builtin_amdgcn_s_getreg((3 << 11) | 20) & 0xFu; }
#define XB_SPIN(cond, bar) do { unsigned _sp = 0; while (cond) { __builtin_amdgcn_s_sleep(1); \
    if ((++_sp & 255u) == 0u) { if (xb_ld(&(bar)[XB_TMO])) break; if (_sp > XB_SPIN_CAP) { atomicAdd(&(bar)[XB_TMO], 1u); break; } } } } while (0)

struct XcdBarrier {
    unsigned* bar; unsigned x;
    volatile LAS unsigned* st;
};

__device__ __forceinline__ XcdBarrier xcd_barrier_post(unsigned* bar, volatile LAS unsigned* st) {
    XcdBarrier b; b.bar = bar; b.x = xb_xcc_id(); b.st = st;
    if (threadIdx.x == 0) (void)xb_add(&bar[XB_XCNT(b.x)], 1u);
    return b;
}
__device__ __forceinline__ void xcd_barrier_complete(unsigned* bar, unsigned x, unsigned& nloc, unsigned& nx) {
    const unsigned G = gridDim.x * gridDim.y * gridDim.z;
    unsigned sum, cnt, mine, sp = 0u;
    for (;;) {
        sum = 0u; cnt = 0u; mine = 0u;
#pragma unroll
        for (unsigned j = 0; j < 16; ++j) { const unsigned c = xb_ld(&bar[XB_XCNT(j)]); sum += c; cnt += (c > 0u) ? 1u : 0u; mine = (j == x) ? c : mine; }
        if (sum == G) break;
        __builtin_amdgcn_s_sleep(1);
        if ((++sp & 255u) == 0u) { if (xb_ld(&bar[XB_TMO])) break; if (sp > XB_SPIN_CAP) { atomicAdd(&bar[XB_TMO], 1u); break; } }
    }
    nloc = mine > 0u ? mine : 1u; nx = cnt > 0u ? cnt : 1u;
}

__device__ __forceinline__ void xcd_barrier(const XcdBarrier& b) {
    asm volatile("s_waitcnt vmcnt(0)" ::: "memory");
    __syncthreads();
    if (threadIdx.x == 0) {
        unsigned* bar = b.bar;
        __builtin_amdgcn_s_waitcnt(0);
        unsigned nloc = b.st[0], nx = b.st[1];
        if (nloc == 0u) { xcd_barrier_complete(bar, b.x, nloc, nx); b.st[0] = nloc; b.st[1] = nx; }
        const unsigned old = xb_add(&bar[XB_XSUB(b.x)], 1u);
        const unsigned gen = old / nloc;
        if (old + 1u == (gen + 1u) * nloc) {
            __builtin_amdgcn_fence(__ATOMIC_RELEASE, "agent");
            asm volatile("s_waitcnt vmcnt(0)" ::: "memory");
            const unsigned og = xb_add(&bar[XB_TOP], 1u);
            const unsigned tg = og / nx;
            if (og + 1u == (tg + 1u) * nx) xb_add(&bar[XB_TOPGEN], 1u);
            else XB_SPIN(xb_ld(&bar[XB_TOPGEN]) == tg, bar);
            __builtin_amdgcn_fence(__ATOMIC_ACQUIRE, "agent");
            xb_add(&bar[XB_XGEN(b.x)], 1u);
            asm volatile("s_waitcnt vmcnt(0)" ::: "memory");
        } else {
            XB_SPIN(xb_ld(&bar[XB_XGEN(b.x)]) == gen, bar);
            __builtin_amdgcn_fence(__ATOMIC_ACQUIRE, "agent");
            asm volatile("s_waitcnt vmcnt(0)" ::: "memory");
        }
    }
    __syncthreads();
}

typedef short v4i16_t __attribute__((ext_vector_type(4)));
__device__ __forceinline__ s16x4 tr16(const LAS unsigned char* p) { return __builtin_bit_cast(s16x4, __builtin_amdgcn_ds_read_tr16_b64_v4i16((LAS v4i16_t*)p)); }
__device__ __forceinline__ bf16x8 cat8(s16x4 a, s16x4 b) { return (bf16x8){a[0], a[1], a[2], a[3], b[0], b[1], b[2], b[3]}; }
__device__ __forceinline__ int crow(int r, int hi) { return (r & 3) + 8 * (r >> 2) + 4 * hi; }
__device__ __forceinline__ f32x16 mfma32(bf16x8 a, bf16x8 b, f32x16 c) { return __builtin_amdgcn_mfma_f32_32x32x16_bf16(a, b, c, 0, 0, 0); }
__device__ __forceinline__ f32x4 mfma16(bf16x8 a, bf16x8 b, f32x4 c) { return __builtin_amdgcn_mfma_f32_16x16x32_bf16(a, b, c, 0, 0, 0); }
__device__ __forceinline__ v4u pack8(const float* v) { v4u w; w.x = cvtpk(v[0], v[1]); w.y = cvtpk(v[2], v[3]); w.z = cvtpk(v[4], v[5]); w.w = cvtpk(v[6], v[7]); return w; }
__device__ __forceinline__ void unpack8(v4u w, float* v) { v[0] = bflo(w.x); v[1] = bfhi(w.x); v[2] = bflo(w.y); v[3] = bfhi(w.y); v[4] = bflo(w.z); v[5] = bfhi(w.z); v[6] = bflo(w.w); v[7] = bfhi(w.w); }

__device__ __forceinline__ void p0_transpose_tile(const float* W, int K, int N, bf16* WT, int tile, int lane) {
    const int nblk = N >> 6, kb = tile / nblk, nb = tile - kb * nblk, nq = lane & 15, kq = lane >> 4;
    const float* src = W + (size_t)(64 * kb + 16 * kq) * N + 64 * nb + 4 * nq;
    f32x4 v[16];
#pragma unroll
    for (int i = 0; i < 16; ++i) v[i] = *(const f32x4*)(src + (size_t)i * N);
    bf16* dst = WT + (size_t)(64 * nb + 4 * nq) * K + 64 * kb + 16 * kq;
#pragma unroll
    for (int e = 0; e < 4; ++e) {
        v4u lo, hi;
        lo.x = cvtpk(v[0][e], v[1][e]); lo.y = cvtpk(v[2][e], v[3][e]); lo.z = cvtpk(v[4][e], v[5][e]); lo.w = cvtpk(v[6][e], v[7][e]);
        hi.x = cvtpk(v[8][e], v[9][e]); hi.y = cvtpk(v[10][e], v[11][e]); hi.z = cvtpk(v[12][e], v[13][e]); hi.w = cvtpk(v[14][e], v[15][e]);
        *(v4u*)(dst + (size_t)e * K) = lo; *(v4u*)(dst + (size_t)e * K + 8) = hi;
    }
}
__device__ __forceinline__ void p0_mod_item(LAS unsigned char* lds, const float* cp, const float* cs, const float* w_ada, const float* b_ada, float* MOD, int item, int tid, int lane, int wave) {
    const int n0 = 64 * item, nq = lane & 15, kg = lane >> 4;
    f32x4 acc[9][4];
#pragma unroll
    for (int rb = 0; rb < 9; ++rb)
#pragma unroll
        for (int e = 0; e < 4; ++e) acc[rb][e] = (f32x4){0.f, 0.f, 0.f, 0.f};
    for (int ks = 0; ks < 8; ++ks) {
        const int k0 = 256 * wave + 32 * ks + 8 * kg;
        f32x4 bv[8];
#pragma unroll
        for (int j = 0; j < 8; ++j) bv[j] = *(const f32x4*)(w_ada + (size_t)(k0 + j) * NMODC + n0 + 4 * nq);
        bf16x8 bfr[4];
#pragma unroll
        for (int e = 0; e < 4; ++e) { v4u w; w.x = cvtpk(bv[0][e], bv[1][e]); w.y = cvtpk(bv[2][e], bv[3][e]); w.z = cvtpk(bv[4][e], bv[5][e]); w.w = cvtpk(bv[6][e], bv[7][e]); bfr[e] = __builtin_bit_cast(bf16x8, w); }
#pragma unroll
        for (int rb = 0; rb < 9; ++rb) {
            const int r = 16 * rb + nq;
            v4u aw = (v4u){0u, 0u, 0u, 0u};
            if (r < NMODR) { const float* crow_ = (r < 2) ? cp + (size_t)r * DM : cs + (size_t)(r - 2) * DM;
                const f32x4 a0 = *(const f32x4*)(crow_ + k0), a1 = *(const f32x4*)(crow_ + k0 + 4);
                aw.x = cvtpk(silu_f(a0[0]), silu_f(a0[1])); aw.y = cvtpk(silu_f(a0[2]), silu_f(a0[3])); aw.z = cvtpk(silu_f(a1[0]), silu_f(a1[1])); aw.w = cvtpk(silu_f(a1[2]), silu_f(a1[3])); }
            const bf16x8 af = __builtin_bit_cast(bf16x8, aw);
#pragma unroll
            for (int e = 0; e < 4; ++e) acc[rb][e] = mfma16(af, bfr[e], acc[rb][e]);
        }
    }
    LAS float* RED = (LAS float*)lds;
    __syncthreads();
    for (int w = 0; w < 8; ++w) {
        if (wave == w) {
#pragma unroll
            for (int rb = 0; rb < 9; ++rb)
#pragma unroll
                for (int e = 0; e < 4; ++e)
#pragma unroll
                    for (int reg = 0; reg < 4; ++reg) { const int idx = (16 * rb + 4 * kg + reg) * 64 + 4 * nq + e; const float p = acc[rb][e][reg]; RED[idx] = (w == 0) ? p : RED[idx] + p; }
        }
        __syncthreads();
    }
    for (int idx = tid; idx < NMODR * 64; idx += 512) { const int r = idx >> 6, cc = idx & 63; MOD[(size_t)r * NMODC + n0 + cc] = RED[idx] + b_ada[n0 + cc]; }
    __syncthreads();
}

__device__ __forceinline__ int mod_row(int r) { return r < MPROMPT ? (r >> 13) : 2 + (r - MPROMPT); }

__device__ __forceinline__ void p1_rows(const float* xp, const float* xs, const float* gpre, const float* MOD, bf16* H, int gw, int NGW, int lane) {
    for (int r = gw; r < MPAD; r += NGW) {
        bf16* hrow = H + (size_t)r * DM + 8 * lane;
        if (r >= MTOK) {
#pragma unroll
            for (int j = 0; j < 4; ++j) *(v4u*)(hrow + 512 * j) = (v4u){0u, 0u, 0u, 0u};
            continue; }
        const float* xr = (r < MPROMPT ? xp + (size_t)r * DM : xs + (size_t)(r - MPROMPT) * DM) + 8 * lane;
        const float* mr = MOD + (size_t)mod_row(r) * NMODC + 8 * lane;
        f32x4 v[4][2]; float ss = 0.f;
#pragma unroll
        for (int j = 0; j < 4; ++j) { v[j][0] = *(const f32x4*)(xr + 512 * j); v[j][1] = *(const f32x4*)(xr + 512 * j + 4);
#pragma unroll
            for (int i = 0; i < 4; ++i) ss += v[j][0][i] * v[j][0][i] + v[j][1][i] * v[j][1][i]; }
        const float rstd = rsqrtf(wave_sum(ss) * (1.0f / DM) + EPS);
#pragma unroll
        for (int j = 0; j < 4; ++j) { float o[8];
#pragma unroll
            for (int q = 0; q < 2; ++q) { const f32x4 g = *(const f32x4*)(gpre + 8 * lane + 512 * j + 4 * q), sh = *(const f32x4*)(mr + 512 * j + 4 * q), sc = *(const f32x4*)(mr + DM + 512 * j + 4 * q);
#pragma unroll
                for (int i = 0; i < 4; ++i) o[4 * q + i] = v[j][q][i] * rstd * g[i] * (1.0f + sc[i]) + sh[i]; }
            *(v4u*)(hrow + 512 * j) = pack8(o); }
    }
}
__device__ __forceinline__ void p5_rows(const float* xp, const float* xs, const bf16* O, const float* gpost, const float* gpre, const float* MOD, float* out, bf16* H2, int gw, int NGW, int lane) {
    for (int r = gw; r < MPAD; r += NGW) {
        bf16* hrow = H2 + (size_t)r * DM + 8 * lane;
        if (r >= MTOK) {
#pragma unroll
            for (int j = 0; j < 4; ++j) *(v4u*)(hrow + 512 * j) = (v4u){0u, 0u, 0u, 0u};
            continue; }
        const float* xr = (r < MPROMPT ? xp + (size_t)r * DM : xs + (size_t)(r - MPROMPT) * DM) + 8 * lane;
        float* x1r = (r < MPROMPT ? out + O_YP + (size_t)r * DM : out + O_YS + (size_t)(r - MPROMPT) * DM) + 8 * lane;
        const float* mr = MOD + (size_t)mod_row(r) * NMODC + 8 * lane;
        const bf16* orow = O + (size_t)r * DM + 8 * lane;
        float ov[4][8]; float ss = 0.f;
#pragma unroll
        for (int j = 0; j < 4; ++j) { unpack8(*(const v4u*)(orow + 512 * j), ov[j]);
#pragma unroll
            for (int i = 0; i < 8; ++i) ss += ov[j][i] * ov[j][i]; }
        const float rstd_o = rsqrtf(wave_sum(ss) * (1.0f / DM) + EPS);
        float x1[4][8]; float s1 = 0.f;
#pragma unroll
        for (int j = 0; j < 4; ++j)
#pragma unroll
            for (int q = 0; q < 2; ++q) { const f32x4 xv = *(const f32x4*)(xr + 512 * j + 4 * q), g = *(const f32x4*)(gpost + 8 * lane + 512 * j + 4 * q), gt = *(const f32x4*)(mr + 2 * DM + 512 * j + 4 * q);
                f32x4 y;
#pragma unroll
                for (int i = 0; i < 4; ++i) { y[i] = xv[i] + gt[i] * (ov[j][4 * q + i] * rstd_o * g[i]); x1[j][4 * q + i] = y[i]; s1 += y[i] * y[i]; }
                *(f32x4*)(x1r + 512 * j + 4 * q) = y; }
        const float rstd_1 = rsqrtf(wave_sum(s1) * (1.0f / DM) + EPS);
#pragma unroll
        for (int j = 0; j < 4; ++j) { float o[8];
#pragma unroll
            for (int q = 0; q < 2; ++q) { const f32x4 g = *(const f32x4*)(gpre + 8 * lane + 512 * j + 4 * q), sh = *(const f32x4*)(mr + 3 * DM + 512 * j + 4 * q), sc = *(const f32x4*)(mr + 4 * DM + 512 * j + 4 * q);
#pragma unroll
                for (int i = 0; i < 4; ++i) o[4 * q + i] = x1[j][4 * q + i] * rstd_1 * g[i] * (1.0f + sc[i]) + sh[i]; }
            *(v4u*)(hrow + 512 * j) = pack8(o); }
    }
}
__device__ __forceinline__ void p9_rows(const bf16* YF, const float* gpost, const float* MOD, float* out, int gw, int NGW, int lane) {
    for (int r = gw; r < MTOK; r += NGW) {
        float* x1r = (r < MPROMPT ? out + O_YP + (size_t)r * DM : out + O_YS + (size_t)(r - MPROMPT) * DM) + 8 * lane;
        const float* mr = MOD + (size_t)mod_row(r) * NMODC + 8 * lane;
        const bf16* yrow = YF + (size_t)r * DM + 8 * lane;
        float yv[4][8]; float ss = 0.f;
#pragma unroll
        for (int j = 0; j < 4; ++j) { unpack8(*(const v4u*)(yrow + 512 * j), yv[j]);
#pragma unroll
            for (int i = 0; i < 8; ++i) ss += yv[j][i] * yv[j][i]; }
        const float rstd = rsqrtf(wave_sum(ss) * (1.0f / DM) + EPS);
#pragma unroll
        for (int j = 0; j < 4; ++j)
#pragma unroll
            for (int q = 0; q < 2; ++q) { const f32x4 xv = *(const f32x4*)(x1r + 512 * j + 4 * q), g = *(const f32x4*)(gpost + 8 * lane + 512 * j + 4 * q), gt = *(const f32x4*)(mr + 5 * DM + 512 * j + 4 * q);
                f32x4 y;
#pragma unroll
                for (int i = 0; i < 4; ++i) y[i] = xv[i] + gt[i] * (yv[j][4 * q + i] * rstd * g[i]);
                *(f32x4*)(x1r + 512 * j + 4 * q) = y; }
    }
}
__device__ __forceinline__ void p7_prompt(const bf16* A, bf16* U, const float* conv_w, const float* conv_b, int gw, int NGW, int lane) {
    for (int it = gw; it < 11 * (MPROMPT / 32); it += NGW) {
        const int rr = it / 11, cg = it - rr * 11, r0 = 32 * rr, c0 = 512 * cg + 8 * lane;
        float w0[8], w1[8], w2[8], bb[8], am2[8], am1[8];
#pragma unroll
        for (int q = 0; q < 2; ++q) { const f32x4 a = *(const f32x4*)(conv_w + c0 + 4 * q), b = *(const f32x4*)(conv_w + DFF + c0 + 4 * q), c = *(const f32x4*)(conv_w + 2 * DFF + c0 + 4 * q), d = *(const f32x4*)(conv_b + c0 + 4 * q);
#pragma unroll
            for (int i = 0; i < 4; ++i) { w0[4 * q + i] = a[i]; w1[4 * q + i] = b[i]; w2[4 * q + i] = c[i]; bb[4 * q + i] = d[i]; } }
        if ((r0 & (SEQ - 1)) == 0) {
#pragma unroll
            for (int i = 0; i < 8; ++i) { am2[i] = 0.f; am1[i] = 0.f; }
        } else { unpack8(*(const v4u*)(A + (size_t)(r0 - 2) * DFF + c0), am2); unpack8(*(const v4u*)(A + (size_t)(r0 - 1) * DFF + c0), am1); }
#pragma unroll 4
        for (int r = r0; r < r0 + 32; ++r) {
            float a[8], u[8], o[8];
            unpack8(*(const v4u*)(A + (size_t)r * DFF + c0), a); unpack8(*(const v4u*)(U + (size_t)r * DFF + c0), u);
#pragma unroll
            for (int i = 0; i < 8; ++i) { const float cv = bb[i] + w0[i] * am2[i] + w1[i] * am1[i] + w2[i] * a[i]; o[i] = gelu_f(cv) * u[i]; am2[i] = am1[i]; am1[i] = a[i]; }
            *(v4u*)(U + (size_t)r * DFF + c0) = pack8(o);
        }
    }
}
__device__ __forceinline__ void p7_sample(const bf16* A, bf16* U, const float* state, const float* conv_w, const float* conv_b, float* out, int gtid, int NGT) {
    for (int it = gtid; it < NSAMP * (DFF / 8); it += NGT) {
        const int sb = it / (DFF / 8), c0 = 8 * (it - sb * (DFF / 8)); const size_t row = (size_t)(MPROMPT + sb) * DFF + c0;
        float a[8], u[8], o[8];
        unpack8(*(const v4u*)(A + row), a); unpack8(*(const v4u*)(U + row), u);
#pragma unroll
        for (int q = 0; q < 2; ++q) { const f32x4 w0 = *(const f32x4*)(conv_w + c0 + 4 * q), w1 = *(const f32x4*)(conv_w + DFF + c0 + 4 * q), w2 = *(const f32x4*)(conv_w + 2 * DFF + c0 + 4 * q), bb = *(const f32x4*)(conv_b + c0 + 4 * q);
            const f32x4 s0 = *(const f32x4*)(state + (size_t)(sb * 2 + 0) * DFF + c0 + 4 * q), s1 = *(const f32x4*)(state + (size_t)(sb * 2 + 1) * DFF + c0 + 4 * q);
#pragma unroll
            for (int i = 0; i < 4; ++i) { const float cv = bb[i] + w0[i] * s0[i] + w1[i] * s1[i] + w2[i] * a[4 * q + i]; o[4 * q + i] = gelu_f(cv) * u[4 * q + i]; }
            *(f32x4*)(out + O_CS + (size_t)(sb * 2 + 0) * DFF + c0 + 4 * q) = s1; }
        *(v4u*)(U + row) = pack8(o);
    }
}
constexpr int MX_K = 0, MX_V = 32768, MX_VN = 65536, MX_STG = 98304, MX_TAB = 131072, MX_MEAN = MX_TAB + 1536, MX_RSTD = MX_MEAN + 512, MX_END = MX_RSTD + 512;
static_assert(MX_END <= MISC_OFF, "mixer LDS");
__device__ __forceinline__ void mixer_prompt_item(LAS unsigned char* lds, const bf16* Z, const f32x2* STAT, const bf16* TRIL, bf16* MERGED, const float* sinks, const float* rel_bias,
                                                  const float* lng, const float* lnb, const float* b_s, int item, int tid, int lane, int wave) {
    const int g = item & 15, n = (item >> 4) & 63, b = item >> 10, kvh = g >> 2, R0 = b * SEQ + n * 128;
    LAS unsigned char* Kt = lds + MX_K; LAS unsigned char* Vt = lds + MX_V; LAS unsigned char* VNt = lds + MX_VN; LAS unsigned char* STG = lds + MX_STG + wave * 4096;
    LAS float* TAB = (LAS float*)(lds + MX_TAB); LAS float* MEAN = (LAS float*)(lds + MX_MEAN); LAS float* RSTD = (LAS float*)(lds + MX_RSTD);
    __syncthreads();
    if (tid < 128) {
        float s1 = 0.f, s2 = 0.f;
#pragma unroll 8
        for (int p = 0; p < 32; ++p) { const f32x2 v = STAT[(size_t)p * MPAD + R0 + tid]; s1 += v.x; s2 += v.y; }
        const float mean = s1 * (1.0f / DM), var = s2 * (1.0f / DM) - mean * mean;
        MEAN[tid] = mean; RSTD[tid] = rsqrtf(fmaxf(var, 0.f) + EPS);
    } else {
        const int e = tid - 128, hh = e / 192, idx = e - hh * 192, dist = idx - 32;
        TAB[e] = (dist >= 0 && dist <= 128) ? rel_bias[t5_bucket(dist) * 32 + 2 * g + hh] * LOG2E : -1e30f;
    }
#pragma unroll
    for (int i = 0; i < 4; ++i) {
        const int q = tid + 512 * i, j = q >> 3, c = q & 7;
        if (n > 0 || j >= 128) {
            const bf16* src = Z + (size_t)(R0 - 128 + j) * DIN + 64 * kvh + 8 * c;
            const v4u kv = *(const v4u*)(src + CK), vv = *(const v4u*)(src + CV);
            *(LAS v4u*)(Kt + j * 128 + ((c ^ ((j >> 1) & 7)) << 4)) = kv;
            *(LAS v4u*)(Vt + (j >> 4) * 2048 + (c >> 2) * 1024 + ((j >> 3) & 1) * 512 + (j & 7) * 64 + (c & 3) * 16) = vv;
        }
    }
    __syncthreads();
#pragma unroll
    for (int i = 0; i < 4; ++i) {
        const int q = tid + 512 * i, j = q >> 4, c = q & 15, ch = 128 * g + 8 * c;
        float v[8]; unpack8(*(const v4u*)(Z + (size_t)(R0 + j) * DIN + CG + ch), v);
        const float mean = MEAN[j], rstd = RSTD[j];
#pragma unroll
        for (int qq = 0; qq < 2; ++qq) { const f32x4 gg = *(const f32x4*)(lng + ch + 4 * qq), bb = *(const f32x4*)(lnb + ch + 4 * qq);
#pragma unroll
            for (int k = 0; k < 4; ++k) v[4 * qq + k] = (v[4 * qq + k] - mean) * rstd * gg[k] + bb[k]; }
        *(LAS v4u*)(VNt + (j >> 4) * 4096 + (c >> 2) * 1024 + ((j >> 3) & 1) * 512 + (j & 7) * 64 + (c & 3) * 16) = pack8(v);
    }
    __syncthreads();
    const int hh = wave & 1, qb = wave >> 1, head = 2 * g + hh, ql = lane & 31, hi = lane >> 5;
    const int tmin = (n == 0) ? (4 - qb) : 0;
    bf16x8 qf[4];
    { const bf16* qp = Z + (size_t)(R0 + 32 * qb + ql) * DIN + CQ + 64 * head + 8 * hi;
#pragma unroll
      for (int d0 = 0; d0 < 4; ++d0) qf[d0] = *(const bf16x8*)(qp + 16 * d0); }
    f32x16 p[5];
    const LAS float* TABh = TAB + hh * 192;
#pragma unroll
    for (int t = 0; t < 5; ++t) {
        if (t >= tmin) {
            const int key = 32 * (qb + t) + ql, sw = (key >> 1) & 7; const LAS unsigned char* kp = Kt + key * 128;
            f32x16 acc = {};
#pragma unroll
            for (int d0 = 0; d0 < 4; ++d0) { const bf16x8 kf = *(const LAS bf16x8*)(kp + (((2 * d0 + hi) ^ sw) << 4)); acc = mfma32(kf, qf[d0], acc); }
#pragma unroll
            for (int r = 0; r < 16; ++r) acc[r] += TABh[160 + ql - 32 * t - crow(r, hi)];
            p[t] = acc;
        } else {
#pragma unroll
            for (int r = 0; r < 16; ++r) p[t][r] = -1e30f;
        }
    }
    float m = -1e30f;
#pragma unroll
    for (int t = 0; t < 5; ++t)
#pragma unroll
        for (int r = 0; r < 16; ++r) m = fmaxf(m, p[t][r]);
    m = fmaxf(m, __shfl_xor(m, 32));
    const float sk = sinks[head] * LOG2E; m = fmaxf(m, sk);
    float sum = 0.f;
#pragma unroll
    for (int t = 0; t < 5; ++t)
#pragma unroll
        for (int r = 0; r < 16; ++r) { p[t][r] = fast_exp2(p[t][r] - m); sum += p[t][r]; }
    sum += __shfl_xor(sum, 32);
    const float inv = 1.0f / (sum + fast_exp2(sk - m));
    f32x16 o[2] = {{}, {}}, sg[2] = {{}, {}};
    const int vlane = (4 * hi + ((lane & 15) >> 2)) * 64 + ((lane >> 4) & 1) * 32 + (lane & 3) * 8;
#pragma unroll
    for (int t = 0; t < 5; ++t) {
        if (t >= tmin) {
#pragma unroll
            for (int s = 0; s < 2; ++s) {
                v4u pw; pw.x = cvtpk(p[t][8 * s + 0] * inv, p[t][8 * s + 1] * inv); pw.y = cvtpk(p[t][8 * s + 2] * inv, p[t][8 * s + 3] * inv);
                pw.z = cvtpk(p[t][8 * s + 4] * inv, p[t][8 * s + 5] * inv); pw.w = cvtpk(p[t][8 * s + 6] * inv, p[t][8 * s + 7] * inv);
                const bf16x8 pa = __builtin_bit_cast(bf16x8, pw);
                const LAS unsigned char* vp = Vt + (2 * (qb + t) + s) * 2048 + vlane;
#pragma unroll
                for (int dh = 0; dh < 2; ++dh) { const bf16x8 vf = cat8(tr16(vp + dh * 1024), tr16(vp + dh * 1024 + 512)); o[dh] = mfma32(pa, vf, o[dh]); }
            }
        }
    }
    { const bf16* wp = TRIL + ((size_t)g * 128 + 32 * qb + ql) * 128 + 8 * hi;
      const int nlane = hi * 512 + ((lane & 15) >> 2) * 64 + ((lane >> 4) & 1) * 32 + (lane & 3) * 8, nsteps = 2 * (qb + 1);
#pragma unroll
      for (int s = 0; s < 8; ++s) {
          if (s < nsteps) {
              const bf16x8 wf = *(const bf16x8*)(wp + 16 * s);
              const LAS unsigned char* np = VNt + s * 4096 + (2 * hh) * 1024 + nlane;
#pragma unroll
              for (int dh = 0; dh < 2; ++dh) { const bf16x8 vf = cat8(tr16(np + dh * 1024), tr16(np + dh * 1024 + 256)); sg[dh] = mfma32(wf, vf, sg[dh]); }
          }
      } }
    v4u t1[4], t2[4];
    LAS bf16* stg = (LAS bf16*)STG;
#pragma unroll
    for (int dh = 0; dh < 2; ++dh)
#pragma unroll
        for (int r = 0; r < 16; ++r) stg[crow(r, hi) * 64 + 32 * dh + ql] = (bf16)(cvtpk(o[dh][r], 0.f) & 0xffffu);
    LDS_WAIT();
#pragma unroll
    for (int i = 0; i < 4; ++i) t1[i] = *(const LAS v4u*)(STG + (8 * i + (lane >> 3)) * 128 + (lane & 7) * 16);
    LDS_WAIT();
#pragma unroll
    for (int r = 0; r < 16; ++r) { const float bs = b_s[g * 128 + 32 * qb + crow(r, hi)];
#pragma unroll
        for (int dh = 0; dh < 2; ++dh) stg[crow(r, hi) * 64 + 32 * dh + ql] = (bf16)(cvtpk(sg[dh][r] + bs, 0.f) & 0xffffu); }
    LDS_WAIT();
#pragma unroll
    for (int i = 0; i < 4; ++i) t2[i] = *(const LAS v4u*)(STG + (8 * i + (lane >> 3)) * 128 + (lane & 7) * 16);
    LDS_WAIT();
#pragma unroll
    for (int i = 0; i < 4; ++i) {
        const size_t grow = (size_t)(R0 + 32 * qb + 8 * i + (lane >> 3)); const int ch = 128 * g + 64 * hh + 8 * (lane & 7);
        const bf16* zr = Z + grow * DIN + ch;
        float a[8], s[8], ga[8], gb[8], u[8], o8[8];
        unpack8(t1[i], a); unpack8(t2[i], s); unpack8(*(const v4u*)(zr + CGA), ga); unpack8(*(const v4u*)(zr + CGB), gb); unpack8(*(const v4u*)(zr + CU), u);
#pragma unroll
        for (int k = 0; k < 8; ++k) o8[k] = ga[k] * a[k] + gb[k] * (u[k] * s[k]);
        *(v4u*)(MERGED + grow * DM + ch) = pack8(o8);
    }
}
constexpr int SM_K = 0, SM_V = 33792, SM_Q = SM_V + 129 * 64 * 4, SM_S = SM_Q + 2048, SM_END = SM_S + 8 * 132 * 4;
static_assert(SM_K + 129 * 65 * 4 <= SM_V && SM_END <= RING_BYTES, "sample mixer LDS");
__device__ __forceinline__ void mixer_sample_item(LAS unsigned char* lds, const bf16* Z, const f32x2* STAT, bf16* MERGED, const float* cache_k, const float* cache_v, const float* sinks, const float* rel_bias,
                                                  const float* lng, const float* lnb, const float* w_s, const float* b_s, float* out, int item, int tid, int lane, int wave) {
    const int kvh = item & 3, sb = item >> 2; const size_t zrow = (size_t)(MPROMPT + sb) * DIN;
    LAS float* KS = (LAS float*)(lds + SM_K); LAS float* VS = (LAS float*)(lds + SM_V); LAS float* QS = (LAS float*)(lds + SM_Q); LAS float* SC = (LAS float*)(lds + SM_S);
    __syncthreads();
    for (int e = tid; e < 129 * 64; e += 512) {
        const int j = e >> 6, d = e & 63; float kv, vv;
        if (j < 128) { const size_t ci = ((size_t)(sb * 128 + j) * 4 + kvh) * 64 + d; kv = cache_k[ci]; vv = cache_v[ci];
            if (j >= 1) { out[O_KS + ci - 256] = kv; out[O_VS + ci - 256] = vv; } }
        else { kv = bf1(Z[zrow + CK + 64 * kvh + d]); vv = bf1(Z[zrow + CV + 64 * kvh + d]); }
        KS[j * 65 + d] = kv; VS[j * 64 + d] = vv;
    }
    QS[tid] = bf1(Z[zrow + CQ + 64 * (8 * kvh + (tid >> 6)) + (tid & 63)]);
    __syncthreads();
    for (int e = tid; e < 8 * 129; e += 512) {
        const int h8 = e / 129, j = e - 129 * h8; float dot = 0.f;
#pragma unroll 16
        for (int d = 0; d < 64; ++d) dot += QS[h8 * 64 + d] * KS[j * 65 + d];
        SC[h8 * 132 + j] = dot + rel_bias[t5_bucket(128 - j) * 32 + 8 * kvh + h8] * LOG2E;
    }
    __syncthreads();
    const int head = 8 * kvh + wave;
    { const float s0 = SC[wave * 132 + lane], s1 = SC[wave * 132 + 64 + lane], s2 = (lane == 0) ? SC[wave * 132 + 128] : -1e30f;
      const float sk = sinks[head] * LOG2E; const float m = fmaxf(wave_max(fmaxf(fmaxf(s0, s1), s2)), sk);
      const float e0 = fast_exp2(s0 - m), e1 = fast_exp2(s1 - m), e2 = fast_exp2(s2 - m);
      const float inv = 1.0f / (wave_sum(e0 + e1 + e2) + fast_exp2(sk - m));
      SC[wave * 132 + lane] = e0 * inv; SC[wave * 132 + 64 + lane] = e1 * inv; if (lane == 0) SC[wave * 132 + 128] = e2 * inv; }
    __syncthreads();
    float ya = 0.f;
#pragma unroll 3
    for (int j = 0; j < 129; ++j) ya += SC[wave * 132 + j] * VS[j * 64 + lane];
    const int ch = 64 * head + lane, grp = ch >> 7;
    float s1 = 0.f, s2 = 0.f;
#pragma unroll 8
    for (int p = 0; p < 32; ++p) { const f32x2 v = STAT[(size_t)p * MPAD + MPROMPT + sb]; s1 += v.x; s2 += v.y; }
    const float mean = s1 * (1.0f / DM), var = s2 * (1.0f / DM) - mean * mean, rstd = rsqrtf(fmaxf(var, 0.f) + EPS);
    const float vn = (bf1(Z[zrow + CG + ch]) - mean) * rstd * lng[ch] + lnb[ch];
    out[O_SG + (size_t)sb * DM + ch] = vn;
    const float sgate = w_s[(size_t)grp * 128 * 128] * vn + b_s[grp * 128];
    const float yb = bf1(Z[zrow + CU + ch]) * sgate;
    const float mg = bf1(Z[zrow + CGA + ch]) * ya + bf1(Z[zrow + CGB + ch]) * yb;
    MERGED[(size_t)(MPROMPT + sb) * DM + ch] = (bf16)(cvtpk(mg, 0.f) & 0xffffu);
}
constexpr int NWAVES = 8;
constexpr int CW_BAR = 4096;
static_assert((CW_BAR + XCD_BAR_WORDS) * 4 <= (int)CTL_ZERO_BYTES, "control words inside the memset region");
constexpr int N_PHASES = 10;
struct Args { const float* in[26]; float* out; unsigned char* ws; int ph_lo, ph_hi; };

__global__ void __launch_bounds__(NWAVES * 64, 2) fwd_kernel(Args args) {
    extern __shared__ __attribute__((aligned(16))) unsigned char lds_raw[];
    LAS unsigned char* lds = (LAS unsigned char*)lds_raw;
    volatile LAS unsigned* MISC = (volatile LAS unsigned*)(lds + MISC_OFF);
    const int tid = threadIdx.x, lane = tid & 63, wave = __builtin_amdgcn_readfirstlane(tid >> 6);
    const int G = gridDim.x, bx = blockIdx.x, vcu = (G % 8 == 0) ? (bx % 8) * (G / 8) + bx / 8 : bx;
    const int gw = vcu * NWAVES + wave, NGW = G * NWAVES;
    unsigned char* ws = args.ws; float* out = args.out;
    gu32* ctl = (gu32*)(ws + WS_CTL);
    float* MOD = (float*)(ws + WS_MOD); f32x2* STAT = (f32x2*)(ws + WS_STAT); bf16* TRIL = (bf16*)(ws + WS_TRIL);
    bf16* WO_T = (bf16*)(ws + WS_WO); bf16* WGU_T = (bf16*)(ws + WS_WGU); bf16* WD_T = (bf16*)(ws + WS_WD); bf16* WIN_T = (bf16*)(ws + WS_WIN);
    bf16* Zb = (bf16*)(ws + WS_Z); bf16* Ob = (bf16*)(ws + WS_O); bf16* ABUF = (bf16*)(ws + WS_ABUF); bf16* UBUF = (bf16*)(ws + WS_UBUF); bf16* H2 = (bf16*)(ws + WS_H2); bf16* YF = (bf16*)(ws + WS_YF);
    bf16* Hb = (bf16*)out;
    for (int u = tid; u < 32; u += NWAVES * 64) MISC[u] = 0u;
    __syncthreads();
    const int lo = args.ph_lo, hi = args.ph_hi;
    const bool one_launch = (hi - lo) > 1;
    XcdBarrier bar; bar.bar = (unsigned*)(ctl + CW_BAR); bar.x = 0; bar.st = nullptr;
    if (one_launch) bar = xcd_barrier_post((unsigned*)(ctl + CW_BAR), MISC + 8);
#define IN(k) (lo <= (k) && (k) < hi)
#define SEAM(k) do { if (IN(k) && IN((k) + 1)) xcd_barrier(bar); } while (0)

    if (IN(0)) {
        if (bx < NMODC / 64) p0_mod_item(lds, args.in[2], args.in[3], args.in[7], args.in[8], MOD, bx, tid, lane, wave);
        constexpr int T_IN = 32 * 168, T_O = 32 * 32, T_G = 32 * 88, T_D = 88 * 32, T_ALL = T_IN + T_O + 2 * T_G + T_D;
        for (int it = gw; it < T_ALL; it += NGW) {
            int r = it;
            if (r < T_IN) { p0_transpose_tile(args.in[13], DM, DIN, WIN_T, r, lane); continue; } r -= T_IN;
            if (r < T_O) { p0_transpose_tile(args.in[14], DM, DM, WO_T, r, lane); continue; } r -= T_O;
            if (r < T_G) { p0_transpose_tile(args.in[22], DM, DFF, WGU_T, r, lane); continue; } r -= T_G;
            if (r < T_G) { p0_transpose_tile(args.in[21], DM, DFF, WGU_T + (size_t)DFF * DM, r, lane); continue; } r -= T_G;
            p0_transpose_tile(args.in[25], DFF, DM, WD_T, r, lane);
        }
        { const float* w_s = args.in[19];
          for (int it = vcu * 512 + tid; it < 16 * 128 * 128 / 8; it += G * 512) { const int e0 = 8 * it, j0 = e0 & 127, i = (e0 >> 7) & 127;
              const f32x4 a = *(const f32x4*)(w_s + e0), b = *(const f32x4*)(w_s + e0 + 4); float v[8];
#pragma unroll
              for (int k = 0; k < 4; ++k) { v[k] = (j0 + k <= i) ? a[k] : 0.f; v[4 + k] = (j0 + 4 + k <= i) ? b[k] : 0.f; }
              *(v4u*)(TRIL + e0) = pack8(v); } }
    }
    SEAM(0);
    if (IN(1)) p1_rows(args.in[0], args.in[1], args.in[9], MOD, Hb, gw, NGW, lane);
    SEAM(1);
    if (IN(2)) {
        pg8::Gemm g{Hb, WIN_T, MPAD, DIN, DM}; pg8::StaticOrder S; S.init(MPAD, DIN, G, bx);
        pg8::EpiZ E{Zb, out, STAT};
        pg8::gemm_phase<pg8::EpiZ, pg8::StaticOrder, PG8_ALIGN, PG8_SP2>(lds, g, S, E);
    }
    SEAM(2);
    if (IN(3)) {
        for (int it = vcu; it < 2048 + 512; it += G) {
            if (it < 2048) mixer_prompt_item(lds, Zb, STAT, TRIL, Hb, args.in[15], args.in[16], args.in[17], args.in[18], args.in[20], it, tid, lane, wave);
            else mixer_sample_item(lds, Zb, STAT, Hb, args.in[4], args.in[5], args.in[15], args.in[16], args.in[17], args.in[18], args.in[19], args.in[20], out, it - 2048, tid, lane, wave);
        }
    }
    SEAM(3);
    if (IN(4)) {
        pg8::Gemm g{Hb, WO_T, MPAD, DM, DM}; pg8::StaticOrder S; S.init(MPAD, DM, G, bx);
        pg8::EpiPlain E{Ob, DM};
        pg8::gemm_phase<pg8::EpiPlain, pg8::StaticOrder, PG8_ALIGN, PG8_SP2>(lds, g, S, E);
    }
    SEAM(4);
    if (IN(5)) p5_rows(args.in[0], args.in[1], Ob, args.in[10], args.in[11], MOD, out, H2, gw, NGW, lane);
    SEAM(5);
    if (IN(6)) {
        pg8::Gemm g{H2, WGU_T, MPAD, 2 * DFF, DM}; pg8::StaticOrder S; S.init(MPAD, 2 * DFF, G, bx);
        pg8::EpiGU E{ABUF, UBUF, out};
        pg8::gemm_phase<pg8::EpiGU, pg8::StaticOrder, PG8_ALIGN, PG8_SP2>(lds, g, S, E);
    }
    SEAM(6);
    if (IN(7)) {
        p7_prompt(ABUF, UBUF, args.in[23], args.in[24], gw, NGW, lane);
        p7_sample(ABUF, UBUF, args.in[6], args.in[23], args.in[24], out, vcu * 512 + tid, G * 512);
    }
    SEAM(7);
    if (IN(8)) {
        pg8::Gemm g{UBUF, WD_T, MPAD, DM, DFF}; pg8::StaticOrder S; S.init(MPAD, DM, G, bx);
        pg8::EpiPlain E{YF, DM};
        pg8::gemm_phase<pg8::EpiPlain, pg8::StaticOrder, PG8_ALIGN, PG8_SP2>(lds, g, S, E);
    }
    SEAM(8);
    if (IN(9)) p9_rows(YF, args.in[12], MOD, out, gw, NGW, lane);
#undef IN
#undef SEAM
}

#ifndef MK_ONE_LAUNCH
#define MK_ONE_LAUNCH 1
#endif
extern "C" void kernel_launch(void* const* d_in, const int* in_sizes, int n_in, void* d_out, int out_size, void* d_ws, size_t ws_size, hipStream_t stream) {
    static int grid = 0;
    if (grid == 0) {
        if (n_in != 26 || in_sizes[0] != MPROMPT * DM || out_size != (int)O_END || ws_size < WS_END) {
            fprintf(stderr, "kernel_launch: unexpected problem shape (n_in %d, in0 %d, out %d, ws %zu); nothing launched\n", n_in, n_in > 0 ? in_sizes[0] : -1, out_size, ws_size); grid = -1; return; }
        int dev = 0, cus = 0, per_cu = 0;
        if (hipGetDevice(&dev) != hipSuccess || hipDeviceGetAttribute(&cus, hipDeviceAttributeMultiprocessorCount, dev) != hipSuccess) { grid = -1; return; }
        if (hipFuncSetAttribute((const void*)fwd_kernel, hipFuncAttributeMaxDynamicSharedMemorySize, LDS_BYTES) != hipSuccess) { fprintf(stderr, "kernel_launch: hipFuncSetAttribute failed\n"); grid = -1; return; }
        if (hipOccupancyMaxActiveBlocksPerMultiprocessor(&per_cu, (const void*)fwd_kernel, NWAVES * 64, LDS_BYTES) != hipSuccess || per_cu < 1) { fprintf(stderr, "kernel_launch: occupancy query says %d blocks per CU; nothing launched\n", per_cu); (void)hipGetLastError(); grid = -1; return; }
        grid = cus;
    }
    if (grid < 0) return;
    if (hipMemsetAsync((char*)d_ws + WS_CTL, 0, CTL_ZERO_BYTES, stream) != hipSuccess) return;
    Args a{};
    for (int i = 0; i < 26; ++i) a.in[i] = (const float*)d_in[i];
    a.out = (float*)d_out; a.ws = (unsigned char*)d_ws;
#if MK_ONE_LAUNCH
    a.ph_lo = 0; a.ph_hi = N_PHASES;
    void* kargs[] = {&a};
    hipError_t e = hipLaunchCooperativeKernel((const void*)fwd_kernel, dim3(grid), dim3(NWAVES * 64), kargs, LDS_BYTES, stream);
    if (e != hipSuccess) fprintf(stderr, "kernel_launch: cooperative launch failed: %s (grid %d)\n", hipGetErrorString(e), grid);
#else
    for (int p = 0; p < N_PHASES; ++p) { a.ph_lo = p; a.ph_hi = p + 1; hipLaunchKernelGGL(fwd_kernel, dim3(grid), dim3(NWAVES * 64), LDS_BYTES, stream, a); }
#endif
}
```

```cpp
#include <hip/hip_runtime.h>
#include <cstdio>
#include <cstdint>

constexpr int DM = 2048, SEQ = 8192, NBATCH = 2, MPROMPT = NBATCH * SEQ, NSAMP = 128, MTOK = MPROMPT + NSAMP, MPAD = 16640;
constexpr int DIN = 10752, DFF = 5632, NMODC = 12288, NMODR = 130;
constexpr int CQ = 0, CK = 2048, CV = 2304, CU = 2560, CG = 4608, CGA = 6656, CGB = 8704;
constexpr float EPS = 1e-6f, LOG2E = 1.4426950408889634f, QSCALE = 0.125f * 1.4426950408889634f;
constexpr size_t O_YP = 0, O_YS = 33554432, O_KP = 33816576, O_VP = 33882112, O_CP = 33947648, O_KS = 33970176, O_VS = 38164480, O_CS = 42358784, O_SG = 43800576, O_END = 44062720;

constexpr size_t KiB = 1024, MiB = 1u << 20;
constexpr size_t WS_CTL = 0, CTL_ZERO_BYTES = 64 * KiB;
constexpr size_t WS_MOD = 1 * MiB;
constexpr size_t WS_STAT = WS_MOD + 6656 * KiB;
constexpr size_t WS_TRIL = WS_STAT + 4352 * KiB;
constexpr size_t WS_WO = WS_TRIL + 512 * KiB;
constexpr size_t WS_WGU = WS_WO + 8 * MiB;
constexpr size_t WS_WD = WS_WGU + 44 * MiB;
constexpr size_t WS_ARENA = WS_WD + 22 * MiB;
constexpr size_t WS_WIN = WS_ARENA;
constexpr size_t WS_Z = WS_ARENA + 42 * MiB;
constexpr size_t WS_O = WS_ARENA;
constexpr size_t WS_ABUF = WS_ARENA;
constexpr size_t WS_UBUF = WS_ABUF + (size_t)MPAD * DFF * 2;
constexpr size_t WS_H2 = WS_UBUF + (size_t)MPAD * DFF * 2;
constexpr size_t WS_YF = WS_ABUF;
constexpr size_t WS_END = WS_H2 + (size_t)MPAD * DM * 2;
static_assert(WS_MOD + (size_t)NMODR * NMODC * 4 <= WS_STAT && WS_STAT + (size_t)32 * MPAD * 8 <= WS_TRIL, "ws map");
static_assert(WS_Z + (size_t)MPAD * DIN * 2 <= 512 * MiB && WS_END <= 512 * MiB, "ws map exceeds 512 MiB");

constexpr int RING_BYTES = 131072;
constexpr int MISC_OFF = 143360;
constexpr int LDS_BYTES = 147456;

#define GAS __attribute__((address_space(1)))
#define LAS __attribute__((address_space(3)))
typedef unsigned short bf16;
typedef unsigned v4u __attribute__((ext_vector_type(4)));
typedef unsigned v2u __attribute__((ext_vector_type(2)));
typedef float f32x2 __attribute__((ext_vector_type(2)));
typedef float f32x4 __attribute__((ext_vector_type(4)));
typedef float f32x16 __attribute__((ext_vector_type(16)));
typedef short bf16x8 __attribute__((ext_vector_type(8)));
typedef short s16x4 __attribute__((ext_vector_type(4)));
typedef __bf16 bf16x2_t __attribute__((ext_vector_type(2)));
typedef GAS unsigned gu32;
#define RLX_AGENT __ATOMIC_RELAXED, __HIP_MEMORY_SCOPE_AGENT
#define LDS_WAIT() asm volatile("s_waitcnt lgkmcnt(0)" ::: "memory")
#define VM_WAIT() asm volatile("s_waitcnt vmcnt(0)" ::: "memory")

__device__ __forceinline__ unsigned cvtpk(float lo, float hi) { f32x2 v = {lo, hi}; bf16x2_t b = __builtin_convertvector(v, bf16x2_t); return __builtin_bit_cast(unsigned, b); }
__device__ __forceinline__ float bflo(unsigned w) { return __uint_as_float(w << 16); }
__device__ __forceinline__ float bfhi(unsigned w) { return __uint_as_float(w & 0xffff0000u); }
__device__ __forceinline__ float bf1(bf16 b) { return __uint_as_float((unsigned)b << 16); }
__device__ __forceinline__ float fast_rcp(float x) { return __builtin_amdgcn_rcpf(x); }
__device__ __forceinline__ float fast_exp2(float x) { return __builtin_amdgcn_exp2f(x); }
__device__ __forceinline__ float sigmoid_f(float x) { return fast_rcp(1.0f + fast_exp2(-LOG2E * x)); }
__device__ __forceinline__ float gelu_f(float x) { const float u = x * (0.7978845608028654f + 0.035677408136300125f * x * x); return x * fast_rcp(1.0f + fast_exp2(-2.0f * LOG2E * u)); }
__device__ __forceinline__ float silu_f(float x) { return x * sigmoid_f(x); }
__device__ __forceinline__ float wave_sum(float v) {
#pragma unroll
    for (int o = 1; o < 64; o <<= 1) v += __shfl_xor(v, o);
    return v;
}
__device__ __forceinline__ float wave_max(float v) {
#pragma unroll
    for (int o = 1; o < 64; o <<= 1) v = fmaxf(v, __shfl_xor(v, o));
    return v;
}
__device__ __forceinline__ int t5_bucket(int d) {
    if (d < 16) return d;
    int b = 16;
    b += d >= 19; b += d >= 21; b += d >= 24; b += d >= 27; b += d >= 31; b += d >= 35; b += d >= 40; b += d >= 46; b += d >= 52; b += d >= 59; b += d >= 67; b += d >= 77; b += d >= 87; b += d >= 99; b += d >= 113;
    return b;
}
namespace pg8 {
#define PG8_LAS __attribute__((address_space(3)))
typedef unsigned short bf16_t;
typedef short bf16x8 __attribute__((ext_vector_type(8)));
typedef float f32x4 __attribute__((ext_vector_type(4)));
typedef unsigned u32x4 __attribute__((ext_vector_type(4)));
constexpr int BM = 256, BK = 64, HALF = 128, HTB = HALF * BK * 2  , STAGE_BYTES = 8 * HTB, NXCD = 8, WGM = 8;

__host__ __device__ __forceinline__ int lds_byte(int r, int c) { const int st = (r >> 4) * 2 + (c >> 5), rr = r & 15, cc = c & 31, ob = rr * 64 + cc * 2; return st * 1024 + (ob ^ (((ob >> 9) & 1) << 5)); }
__host__ __device__ __forceinline__ void stage_rc(int b, int& R, int& C) { const int st = b / 1024, sb = b % 1024, swz = sb ^ (((sb >> 9) & 1) << 5); R = (st >> 1) * 16 + swz / 64; C = (st & 1) * 32 + (swz % 64) / 2; }
__host__ __device__ __forceinline__ int perm32(int rho) { const int n = rho >> 4, i = rho & 15; return 8 * (i >> 2) + 4 * n + (i & 3); }

struct Unit { int pm, pn; };
struct Gemm { const bf16_t* A; const bf16_t* Bt; int M, N, K; };

struct StaticOrder {
    int nM, nN, nwg, G, c;
    __host__ __device__ void init(int M, int N, int G_, int c_) { nM = M / BM; nN = N / BM; nwg = nM * nN; G = G_; c = c_; }
    __host__ __device__ bool next(int i, Unit& u) const {
        const long L = (long)i * G + c; if (L >= nwg) return false;
        int wgid = (int)L; { const int q = nwg / NXCD, r = nwg % NXCD, xcd = wgid % NXCD, off = wgid / NXCD; wgid = (xcd < r ? xcd * (q + 1) : r * (q + 1) + (xcd - r) * q) + off; }
        const int nig = WGM * nN, gid = wgid / nig, fm = gid * WGM, gsz = (nM - fm) < WGM ? (nM - fm) : WGM;
        u.pm = fm + ((wgid % nig) % gsz); u.pn = (wgid % nig) / gsz; return true;
    }
    __device__ __forceinline__ void a_ready(const Unit&) const {}
    __device__ __forceinline__ void done(const Unit&) const {}
};

__device__ __forceinline__ void store8(bf16_t* p, const f32x4 v0, const f32x4 v1) {
    u32x4 w; w.x = cvtpk(v0[0], v0[1]); w.y = cvtpk(v0[2], v0[3]); w.z = cvtpk(v1[0], v1[1]); w.w = cvtpk(v1[2], v1[3]); *(u32x4*)p = w;
}
struct EpiPlain {
    static constexpr bool PERM = true, AFTER_DRAIN = false;
    bf16_t* O; int ldc;
    __device__ __forceinline__ void operator()(const f32x4 (&acc)[2][2][4][2], const Unit& u, int wr, int wc, int fr, int fq) const {
        const int row0 = u.pm * BM + wr * 64 + fr, col0 = u.pn * BM + wc * 32 + 8 * fq;
#pragma unroll
        for (int ai = 0; ai < 2; ++ai)
#pragma unroll
            for (int m = 0; m < 4; ++m) { bf16_t* rowp = O + (size_t)(row0 + ai * HALF + m * 16) * ldc + col0;
#pragma unroll
                for (int bj = 0; bj < 2; ++bj) store8(rowp + bj * HALF, acc[ai][bj][m][0], acc[ai][bj][m][1]); }
    }
};
struct EpiZ {
    static constexpr bool PERM = true, AFTER_DRAIN = false;
    bf16_t* Z; float* out; f32x2* stat;
    __device__ __forceinline__ void operator()(const f32x4 (&acc)[2][2][4][2], const Unit& u, int wr, int wc, int fr, int fq) const {
        const int pn = u.pn, row0 = u.pm * BM + wr * 64 + fr, cw = wc * 32 + 8 * fq, col0 = pn * BM + cw;
        if (pn < 8) {
#pragma unroll
            for (int ai = 0; ai < 2; ++ai)
#pragma unroll
                for (int m = 0; m < 4; ++m) { bf16_t* rowp = Z + (size_t)(row0 + ai * HALF + m * 16) * DIN + col0;
#pragma unroll
                    for (int bj = 0; bj < 2; ++bj) store8(rowp + bj * HALF, acc[ai][bj][m][0] * QSCALE, acc[ai][bj][m][1] * QSCALE); }
        } else if (pn < 10) {
            const size_t o_p = (pn == 8) ? O_KP : O_VP, o_s = (pn == 8) ? O_KS : O_VS;
#pragma unroll
            for (int ai = 0; ai < 2; ++ai)
#pragma unroll
                for (int m = 0; m < 4; ++m) { const int lr = wr * 64 + m * 16 + fr; bf16_t* rowp = Z + (size_t)(row0 + ai * HALF + m * 16) * DIN + col0;
#pragma unroll
                    for (int bj = 0; bj < 2; ++bj) { const f32x4 v0 = acc[ai][bj][m][0], v1 = acc[ai][bj][m][1]; store8(rowp + bj * HALF, v0, v1);
                        if (ai == 1 && (u.pm == 31 || u.pm == 63)) { float* d = out + o_p + (size_t)((u.pm >> 5) * 128 + lr) * 256 + cw + bj * HALF; *(f32x4*)d = v0; *(f32x4*)(d + 4) = v1; }
                        if (ai == 0 && u.pm == 64) { float* d = out + o_s + (size_t)(lr * 128 + 127) * 256 + cw + bj * HALF; *(f32x4*)d = v0; *(f32x4*)(d + 4) = v1; } } }
        } else if (pn < 26) {
#pragma unroll
            for (int ai = 0; ai < 2; ++ai)
#pragma unroll
                for (int m = 0; m < 4; ++m) { const int row = row0 + ai * HALF + m * 16; bf16_t* rowp = Z + (size_t)row * DIN + col0; float s1 = 0.f, s2 = 0.f;
#pragma unroll
                    for (int bj = 0; bj < 2; ++bj) { f32x4 v0 = acc[ai][bj][m][0], v1 = acc[ai][bj][m][1];
#pragma unroll
                        for (int i = 0; i < 4; ++i) { v0[i] = gelu_f(v0[i]); v1[i] = gelu_f(v1[i]); s1 += v0[i] + v1[i]; s2 += v0[i] * v0[i] + v1[i] * v1[i]; }
                        store8(rowp + bj * HALF, v0, v1); }
                    if (pn >= 18) { s1 += __shfl_xor(s1, 16); s1 += __shfl_xor(s1, 32); s2 += __shfl_xor(s2, 16); s2 += __shfl_xor(s2, 32);
                        if (fq == 0) stat[(size_t)((pn - 18) * 4 + wc) * MPAD + row] = (f32x2){s1, s2}; } }
        } else {
#pragma unroll
            for (int ai = 0; ai < 2; ++ai)
#pragma unroll
                for (int m = 0; m < 4; ++m) { bf16_t* rowp = Z + (size_t)(row0 + ai * HALF + m * 16) * DIN + col0;
#pragma unroll
                    for (int bj = 0; bj < 2; ++bj) { f32x4 v0 = acc[ai][bj][m][0], v1 = acc[ai][bj][m][1];
#pragma unroll
                        for (int i = 0; i < 4; ++i) { v0[i] = sigmoid_f(v0[i]); v1[i] = sigmoid_f(v1[i]); }
                        store8(rowp + bj * HALF, v0, v1); } }
        }
    }
};
struct EpiGU {
    static constexpr bool PERM = true, AFTER_DRAIN = false;
    bf16_t* A; bf16_t* U; float* out;
    __device__ __forceinline__ void operator()(const f32x4 (&acc)[2][2][4][2], const Unit& u, int wr, int wc, int fr, int fq) const {
        const bool isa = u.pn < 22; const int row0 = u.pm * BM + wr * 64 + fr, col0 = (isa ? u.pn : u.pn - 22) * BM + wc * 32 + 8 * fq; bf16_t* base = isa ? A : U;
#pragma unroll
        for (int ai = 0; ai < 2; ++ai)
#pragma unroll
            for (int m = 0; m < 4; ++m) { const int lr = wr * 64 + m * 16 + fr; bf16_t* rowp = base + (size_t)(row0 + ai * HALF + m * 16) * DFF + col0;
#pragma unroll
                for (int bj = 0; bj < 2; ++bj) { const f32x4 v0 = acc[ai][bj][m][0], v1 = acc[ai][bj][m][1]; store8(rowp + bj * HALF, v0, v1);
                    if (isa && ai == 1 && lr >= 126 && (u.pm == 31 || u.pm == 63)) { float* d = out + O_CP + (size_t)((u.pm >> 5) * 2 + (lr - 126)) * DFF + col0 + bj * HALF; *(f32x4*)d = v0; *(f32x4*)(d + 4) = v1; }
                    if (isa && ai == 0 && u.pm == 64) { float* d = out + O_CS + (size_t)(lr * 2 + 1) * DFF + col0 + bj * HALF; *(f32x4*)d = v0; *(f32x4*)(d + 4) = v1; } } }
    }
};
template <class Epi, class Sched, bool ALIGN_EPI = false, bool SP2 = false>
__device__ __forceinline__ void gemm_phase(PG8_LAS unsigned char* lds, const Gemm g, const Sched& S, const Epi& E) {
    const int tid = threadIdx.x, wid = __builtin_amdgcn_readfirstlane(tid >> 6), lane = tid & 63, wr = wid >> 2, wc = wid & 3, fr = lane & 15, fq = lane >> 4;
    const int K = g.K, nt = K / BK;
    unsigned voffA[2], voffB[2];
#pragma unroll
    for (int i = 0; i < 2; ++i) { int R, C; stage_rc(tid * 16 + i * 8192, R, C); const int Rb = Epi::PERM ? ((R & ~31) + perm32(R & 31)) : R;
        voffA[i] = (unsigned)(R * K + C) * 2u; voffB[i] = (unsigned)(Rb * K + C) * 2u; }
    const size_t kstep = (size_t)(BK * 2);
    const size_t hstep = (size_t)HALF * K * 2;
    const size_t tstep = 2 * hstep;
    const unsigned ldsw = (unsigned)wid * 1024u;
    const int aoff = lds_byte(wr * 64 + fr, fq * 8), boff = lds_byte(wc * 32 + fr, fq * 8);
#define PG8_SA(b, h) (((b) * 2 + (h)) * HTB)
#define PG8_SB(b, h) ((4 + (b) * 2 + (h)) * HTB)
#define PG8_STAGE(bufoff, gbase, voff) do { _Pragma("unroll") for (int _i = 0; _i < 2; ++_i) \
        __builtin_amdgcn_global_load_lds((const unsigned*)((const char*)(gbase) + (voff)[_i]), (PG8_LAS unsigned*)(lds + (bufoff) + ldsw + _i * 8192), 16, 0, 0); } while (0)
#define PG8_LDA(dst, b, h) do { _Pragma("unroll") for (int m = 0; m < 4; ++m) _Pragma("unroll") for (int k = 0; k < 2; ++k) dst[m][k] = *(const PG8_LAS bf16x8*)(lds + PG8_SA(b, h) + aoff + m * 2048 + k * 1024); } while (0)
#define PG8_LDB(dst, b, h) do { _Pragma("unroll") for (int n = 0; n < 2; ++n) _Pragma("unroll") for (int k = 0; k < 2; ++k) dst[n][k] = *(const PG8_LAS bf16x8*)(lds + PG8_SB(b, h) + boff + n * 2048 + k * 1024); } while (0)
#define PG8_MMA(ai, bj, At, Bt) do { __builtin_amdgcn_s_setprio(1); _Pragma("unroll") for (int m = 0; m < 4; ++m) _Pragma("unroll") for (int n = 0; n < 2; ++n) _Pragma("unroll") for (int k = 0; k < 2; ++k) \
        acc[ai][bj][m][n] = __builtin_amdgcn_mfma_f32_16x16x32_bf16(Bt[n][k], At[m][k], acc[ai][bj][m][n], 0, 0, 0); __builtin_amdgcn_s_setprio(0); } while (0)
#define PG8_WAIT_V(n) asm volatile("s_waitcnt vmcnt(" #n ")" ::: "memory")
#define PG8_WAIT_L(n) asm volatile("s_waitcnt lgkmcnt(" #n ")" ::: "memory")
#define PG8_BAR __builtin_amdgcn_s_barrier()
#define PG8_SCHED __builtin_amdgcn_sched_barrier(0)
    Unit cur, nxt; int ui = 0;
    if (!S.next(0, cur)) return;
    f32x4 acc[2][2][4][2];
#pragma unroll
    for (int a = 0; a < 2; ++a)
#pragma unroll
        for (int b = 0; b < 2; ++b)
#pragma unroll
            for (int m = 0; m < 4; ++m)
#pragma unroll
                for (int n = 0; n < 2; ++n) acc[a][b][m][n] = (f32x4){0.f, 0.f, 0.f, 0.f};
    bf16x8 At[4][2], B0[2][2], B1[2][2];
    const char* cA = (const char*)g.A + (size_t)cur.pm * tstep; const char* cB = (const char*)g.Bt + (size_t)cur.pn * tstep;
    S.a_ready(cur);
    if constexpr (SP2) {
        PG8_STAGE(PG8_SB(0, 0), cB, voffB); PG8_STAGE(PG8_SB(0, 1), cB + hstep, voffB); PG8_STAGE(PG8_SA(0, 0), cA, voffA); PG8_STAGE(PG8_SA(0, 1), cA + hstep, voffA);
        if (wr == 1) PG8_BAR;
        PG8_WAIT_V(2); PG8_BAR;
        PG8_STAGE(PG8_SB(1, 0), cB + kstep, voffB); PG8_STAGE(PG8_SA(1, 0), cA + kstep, voffA); PG8_STAGE(PG8_SB(1, 1), cB + hstep + kstep, voffB);
        PG8_WAIT_V(6); PG8_BAR;
    } else {
        PG8_STAGE(PG8_SB(0, 0), cB, voffB); PG8_STAGE(PG8_SA(0, 0), cA, voffA); PG8_STAGE(PG8_SB(0, 1), cB + hstep, voffB); PG8_STAGE(PG8_SA(0, 1), cA + hstep, voffA);
        if (wr == 1) PG8_BAR;
        PG8_WAIT_V(4); PG8_BAR;
        PG8_STAGE(PG8_SB(1, 0), cB + kstep, voffB); PG8_STAGE(PG8_SA(1, 0), cA + kstep, voffA); PG8_STAGE(PG8_SB(1, 1), cB + hstep + kstep, voffB);
        PG8_WAIT_V(6); PG8_BAR;
    }
    for (;;) {
        const bool has_next = S.next(ui + 1, nxt);
        const char* nA = has_next ? (const char*)g.A + (size_t)nxt.pm * tstep : cA; const char* nB = has_next ? (const char*)g.Bt + (size_t)nxt.pn * tstep : cB;
        for (int t = 0; t < nt; t += 2) {
            const bool last = (t == nt - 2);
            const char* a1 = cA + (size_t)(t + 1) * kstep;
            const char* a2 = last ? nA : cA + (size_t)(t + 2) * kstep; const char* b2 = last ? nB : cB + (size_t)(t + 2) * kstep;
            const char* a3 = a2 + kstep; const char* b3 = b2 + kstep;
            if (last && has_next) S.a_ready(nxt);
            if constexpr (SP2) {
            PG8_LDB(B0, 0, 0); PG8_LDB(B1, 0, 1); PG8_SCHED; PG8_LDA(At, 0, 0); PG8_STAGE(PG8_SA(1, 1), a1 + hstep, voffA);
            PG8_WAIT_V(8); PG8_WAIT_L(0); PG8_BAR; PG8_MMA(0, 0, At, B0); PG8_MMA(0, 1, At, B1); PG8_BAR; PG8_SCHED;
            PG8_LDA(At, 0, 1); PG8_STAGE(PG8_SB(0, 0), b2, voffB); PG8_STAGE(PG8_SB(0, 1), b2 + hstep, voffB); PG8_STAGE(PG8_SA(0, 0), a2, voffA);
            PG8_WAIT_V(8); PG8_WAIT_L(0); PG8_BAR; PG8_MMA(1, 0, At, B0); PG8_MMA(1, 1, At, B1); PG8_BAR; PG8_SCHED;
            PG8_LDB(B0, 1, 0); PG8_LDB(B1, 1, 1); PG8_SCHED; PG8_LDA(At, 1, 0); PG8_STAGE(PG8_SA(0, 1), a2 + hstep, voffA);
            PG8_WAIT_V(8); PG8_WAIT_L(0); PG8_BAR; PG8_MMA(0, 0, At, B0); PG8_MMA(0, 1, At, B1); PG8_BAR; PG8_SCHED;
            PG8_LDA(At, 1, 1); PG8_STAGE(PG8_SB(1, 0), b3, voffB); PG8_STAGE(PG8_SB(1, 1), b3 + hstep, voffB); PG8_STAGE(PG8_SA(1, 0), a3, voffA);
            PG8_WAIT_V(8); PG8_WAIT_L(0); PG8_BAR; PG8_MMA(1, 0, At, B0); PG8_MMA(1, 1, At, B1); PG8_BAR; PG8_SCHED;
            } else {
            PG8_LDB(B0, 0, 0); PG8_SCHED; PG8_LDA(At, 0, 0); PG8_STAGE(PG8_SA(1, 1), a1 + hstep, voffA);
            PG8_WAIT_L(8); PG8_BAR; PG8_WAIT_L(0); PG8_MMA(0, 0, At, B0); PG8_BAR; PG8_SCHED;
            PG8_LDB(B1, 0, 1); PG8_STAGE(PG8_SB(0, 0), b2, voffB);
            PG8_BAR; PG8_WAIT_L(0); PG8_MMA(0, 1, At, B1); PG8_BAR;
            PG8_LDA(At, 0, 1); PG8_STAGE(PG8_SA(0, 0), a2, voffA);
            PG8_BAR; PG8_WAIT_L(0); PG8_MMA(1, 0, At, B0); PG8_BAR; PG8_SCHED;
            PG8_STAGE(PG8_SB(0, 1), b2 + hstep, voffB);
            PG8_WAIT_V(6); PG8_BAR; PG8_MMA(1, 1, At, B1); PG8_BAR;
            PG8_LDB(B0, 1, 0); PG8_SCHED; PG8_LDA(At, 1, 0); PG8_STAGE(PG8_SA(0, 1), a2 + hstep, voffA);
            PG8_WAIT_L(8); PG8_BAR; PG8_WAIT_L(0); PG8_MMA(0, 0, At, B0); PG8_BAR; PG8_SCHED;
            PG8_LDB(B1, 1, 1); PG8_STAGE(PG8_SB(1, 0), b3, voffB);
            PG8_BAR; PG8_WAIT_L(0); PG8_MMA(0, 1, At, B1); PG8_BAR;
            PG8_LDA(At, 1, 1); PG8_STAGE(PG8_SA(1, 0), a3, voffA);
            PG8_BAR; PG8_WAIT_L(0); PG8_MMA(1, 0, At, B0); PG8_BAR; PG8_SCHED;
            PG8_STAGE(PG8_SB(1, 1), b3 + hstep, voffB);
            PG8_WAIT_V(6); PG8_BAR; PG8_MMA(1, 1, At, B1); PG8_BAR;
            }
        }
        if constexpr (ALIGN_EPI) { if (wr == 0) PG8_BAR; }
        if constexpr (!Epi::AFTER_DRAIN) { E(acc, cur, wr, wc, fr, fq); S.done(cur); }
        if (!has_next) break;
#pragma unroll
        for (int a = 0; a < 2; ++a)
#pragma unroll
            for (int b = 0; b < 2; ++b)
#pragma unroll
                for (int m = 0; m < 4; ++m)
#pragma unroll
                    for (int n = 0; n < 2; ++n) acc[a][b][m][n] = (f32x4){0.f, 0.f, 0.f, 0.f};
        cur = nxt; cA = nA; cB = nB; ++ui;
        if constexpr (ALIGN_EPI) { if (wr == 1) PG8_BAR; }
    }
    PG8_WAIT_V(0);
    if constexpr (!ALIGN_EPI) { if (wr == 0) PG8_BAR; }
    PG8_BAR;
    if constexpr (Epi::AFTER_DRAIN) { E.fused(acc, cur, wr, wc, fr, fq, lds, wid, lane); S.done(cur); }
#undef PG8_SA
#undef PG8_SB
#undef PG8_STAGE
#undef PG8_LDA
#undef PG8_LDB
#undef PG8_MMA
#undef PG8_WAIT_V
#undef PG8_WAIT_L
#undef PG8_BAR
#undef PG8_SCHED
}
}

#ifndef PG8_SP2
#define PG8_SP2 true
#endif
#ifndef PG8_ALIGN
#define PG8_ALIGN true
#endif
#define XB_TMO      128
#define XB_XCNT(j)  (256  + 64 * (j))
#define XB_XSUB(j)  (1280 + 64 * (j))
#define XB_XGEN(j)  (2304 + 64 * (j))
#define XB_TOP      3328
#define XB_TOPGEN   3392
#define XCD_BAR_WORDS 3456
#define XB_SPIN_CAP (1u << 18)

__device__ __forceinline__ unsigned xb_ld(unsigned* p)              { return __hip_atomic_load(p, __ATOMIC_RELAXED, __HIP_MEMORY_SCOPE_AGENT); }
__device__ __forceinline__ unsigned xb_add(unsigned* p, unsigned v) { return __hip_atomic_fetch_add(p, v, __ATOMIC_RELAXED, __HIP_MEMORY_SCOPE_AGENT); }
__device__ __forceinline__ unsigned xb_xcc_id() { return (unsigned)__builtin_amdgcn_s_getreg((3 << 11) | 20) & 0xFu; }
#define XB_SPIN(cond, bar) do { unsigned _sp = 0; while (cond) { __builtin_amdgcn_s_sleep(1); \
    if ((++_sp & 255u) == 0u) { if (xb_ld(&(bar)[XB_TMO])) break; if (_sp > XB_SPIN_CAP) { atomicAdd(&(bar)[XB_TMO], 1u); break; } } } } while (0)

struct XcdBarrier {
    unsigned* bar; unsigned x;
    volatile LAS unsigned* st;
};

__device__ __forceinline__ XcdBarrier xcd_barrier_post(unsigned* bar, volatile LAS unsigned* st) {
    XcdBarrier b; b.bar = bar; b.x = xb_xcc_id(); b.st = st;
    if (threadIdx.x == 0) (void)xb_add(&bar[XB_XCNT(b.x)], 1u);
    return b;
}
__device__ __forceinline__ void xcd_barrier_complete(unsigned* bar, unsigned x, unsigned& nloc, unsigned& nx) {
    const unsigned G = gridDim.x * gridDim.y * gridDim.z;
    unsigned sum, cnt, mine, sp = 0u;
    for (;;) {
        sum = 0u; cnt = 0u; mine = 0u;
#pragma unroll
        for (unsigned j = 0; j < 16; ++j) { const unsigned c = xb_ld(&bar[XB_XCNT(j)]); sum += c; cnt += (c > 0u) ? 1u : 0u; mine = (j == x) ? c : mine; }
        if (sum == G) break;
        __builtin_amdgcn_s_sleep(1);
        if ((++sp & 255u) == 0u) { if (xb_ld(&bar[XB_TMO])) break; if (sp > XB_SPIN_CAP) { atomicAdd(&bar[XB_TMO], 1u); break; } }
    }
    nloc = mine > 0u ? mine : 1u; nx = cnt > 0u ? cnt : 1u;
}

__device__ __forceinline__ void xcd_barrier(const XcdBarrier& b) {
    asm volatile("s_waitcnt vmcnt(0)" ::: "memory");
    __syncthreads();
    if (threadIdx.x == 0) {
        unsigned* bar = b.bar;
        __builtin_amdgcn_s_waitcnt(0);
        unsigned nloc = b.st[0], nx = b.st[1];
        if (nloc == 0u) { xcd_barrier_complete(bar, b.x, nloc, nx); b.st[0] = nloc; b.st[1] = nx; }
        const unsigned old = xb_add(&bar[XB_XSUB(b.x)], 1u);
        const unsigned gen = old / nloc;
        if (old + 1u == (gen + 1u) * nloc) {
            __builtin_amdgcn_fence(__ATOMIC_RELEASE, "agent");
            asm volatile("s_waitcnt vmcnt(0)" ::: "memory");
            const unsigned og = xb_add(&bar[XB_TOP], 1u);
            const unsigned tg = og / nx;
            if (og + 1u == (tg + 1u) * nx) xb_add(&bar[XB_TOPGEN], 1u);
            else XB_SPIN(xb_ld(&bar[XB_TOPGEN]) == tg, bar);
            __builtin_amdgcn_fence(__ATOMIC_ACQUIRE, "agent");
            xb_add(&bar[XB_XGEN(b.x)], 1u);
            asm volatile("s_waitcnt vmcnt(0)" ::: "memory");
        } else {
            XB_SPIN(xb_ld(&bar[XB_XGEN(b.x)]) == gen, bar);
            __builtin_amdgcn_fence(__ATOMIC_ACQUIRE, "agent");
            asm volatile("s_waitcnt vmcnt(0)" ::: "memory");
        }
    }
    __syncthreads();
}

typedef short v4i16_t __attribute__((ext_vector_type(4)));
__device__ __forceinline__ s16x4 tr16(const LAS unsigned char* p) { return __builtin_bit_cast(s16x4, __builtin_amdgcn_ds_read_tr16_b64_v4i16((LAS v4i16_t*)p)); }
__device__ __forceinline__ bf16x8 cat8(s16x4 a, s16x4 b) { return (bf16x8){a[0], a[1], a[2], a[3], b[0], b[1], b[2], b[3]}; }
__device__ __forceinline__ int crow(int r, int hi) { return (r & 3) + 8 * (r >> 2) + 4 * hi; }
__device__ __forceinline__ f32x16 mfma32(bf16x8 a, bf16x8 b, f32x16 c) { return __builtin_amdgcn_mfma_f32_32x32x16_bf16(a, b, c, 0, 0, 0); }
__device__ __forceinline__ f32x4 mfma16(bf16x8 a, bf16x8 b, f32x4 c) { return __builtin_amdgcn_mfma_f32_16x16x32_bf16(a, b, c, 0, 0, 0); }
__device__ __forceinline__ v4u pack8(const float* v) { v4u w; w.x = cvtpk(v[0], v[1]); w.y = cvtpk(v[2], v[3]); w.z = cvtpk(v[4], v[5]); w.w = cvtpk(v[6], v[7]); return w; }
__device__ __forceinline__ void unpack8(v4u w, float* v) { v[0] = bflo(w.x); v[1] = bfhi(w.x); v[2] = bflo(w.y); v[3] = bfhi(w.y); v[4] = bflo(w.z); v[5] = bfhi(w.z); v[6] = bflo(w.w); v[7] = bfhi(w.w); }

__device__ __forceinline__ void p0_transpose_tile(const float* W, int K, int N, bf16* WT, int tile, int lane) {
    const int nblk = N >> 6, kb = tile / nblk, nb = tile - kb * nblk, nq = lane & 15, kq = lane >> 4;
    const float* src = W + (size_t)(64 * kb + 16 * kq) * N + 64 * nb + 4 * nq;
    f32x4 v[16];
#pragma unroll
    for (int i = 0; i < 16; ++i) v[i] = *(const f32x4*)(src + (size_t)i * N);
    bf16* dst = WT + (size_t)(64 * nb + 4 * nq) * K + 64 * kb + 16 * kq;
#pragma unroll
    for (int e = 0; e < 4; ++e) {
        v4u lo, hi;
        lo.x = cvtpk(v[0][e], v[1][e]); lo.y = cvtpk(v[2][e], v[3][e]); lo.z = cvtpk(v[4][e], v[5][e]); lo.w = cvtpk(v[6][e], v[7][e]);
        hi.x = cvtpk(v[8][e], v[9][e]); hi.y = cvtpk(v[10][e], v[11][e]); hi.z = cvtpk(v[12][e], v[13][e]); hi.w = cvtpk(v[14][e], v[15][e]);
        *(v4u*)(dst + (size_t)e * K) = lo; *(v4u*)(dst + (size_t)e * K + 8) = hi;
    }
}
__device__ __forceinline__ void p0_mod_item(LAS unsigned char* lds, const float* cp, const float* cs, const float* w_ada, const float* b_ada, float* MOD, int item, int tid, int lane, int wave) {
    const int n0 = 64 * item, nq = lane & 15, kg = lane >> 4;
    f32x4 acc[9][4];
#pragma unroll
    for (int rb = 0; rb < 9; ++rb)
#pragma unroll
        for (int e = 0; e < 4; ++e) acc[rb][e] = (f32x4){0.f, 0.f, 0.f, 0.f};
    for (int ks = 0; ks < 8; ++ks) {
        const int k0 = 256 * wave + 32 * ks + 8 * kg;
        f32x4 bv[8];
#pragma unroll
        for (int j = 0; j < 8; ++j) bv[j] = *(const f32x4*)(w_ada + (size_t)(k0 + j) * NMODC + n0 + 4 * nq);
        bf16x8 bfr[4];
#pragma unroll
        for (int e = 0; e < 4; ++e) { v4u w; w.x = cvtpk(bv[0][e], bv[1][e]); w.y = cvtpk(bv[2][e], bv[3][e]); w.z = cvtpk(bv[4][e], bv[5][e]); w.w = cvtpk(bv[6][e], bv[7][e]); bfr[e] = __builtin_bit_cast(bf16x8, w); }
#pragma unroll
        for (int rb = 0; rb < 9; ++rb) {
            const int r = 16 * rb + nq;
            v4u aw = (v4u){0u, 0u, 0u, 0u};
            if (r < NMODR) { const float* crow_ = (r < 2) ? cp + (size_t)r * DM : cs + (size_t)(r - 2) * DM;
                const f32x4 a0 = *(const f32x4*)(crow_ + k0), a1 = *(const f32x4*)(crow_ + k0 + 4);
                aw.x = cvtpk(silu_f(a0[0]), silu_f(a0[1])); aw.y = cvtpk(silu_f(a0[2]), silu_f(a0[3])); aw.z = cvtpk(silu_f(a1[0]), silu_f(a1[1])); aw.w = cvtpk(silu_f(a1[2]), silu_f(a1[3])); }
            const bf16x8 af = __builtin_bit_cast(bf16x8, aw);
#pragma unroll
            for (int e = 0; e < 4; ++e) acc[rb][e] = mfma16(af, bfr[e], acc[rb][e]);
        }
    }
    LAS float* RED = (LAS float*)lds;
    __syncthreads();
    for (int w = 0; w < 8; ++w) {
        if (wave == w) {
#pragma unroll
            for (int rb = 0; rb < 9; ++rb)
#pragma unroll
                for (int e = 0; e < 4; ++e)
#pragma unroll
                    for (int reg = 0; reg < 4; ++reg) { const int idx = (16 * rb + 4 * kg + reg) * 64 + 4 * nq + e; const float p = acc[rb][e][reg]; RED[idx] = (w == 0) ? p : RED[idx] + p; }
        }
        __syncthreads();
    }
    for (int idx = tid; idx < NMODR * 64; idx += 512) { const int r = idx >> 6, cc = idx & 63; MOD[(size_t)r * NMODC + n0 + cc] = RED[idx] + b_ada[n0 + cc]; }
    __syncthreads();
}

__device__ __forceinline__ int mod_row(int r) { return r < MPROMPT ? (r >> 13) : 2 + (r - MPROMPT); }

__device__ __forceinline__ void p1_rows(const float* xp, const float* xs, const float* gpre, const float* MOD, bf16* H, int gw, int NGW, int lane) {
    for (int r = gw; r < MPAD; r += NGW) {
        bf16* hrow = H + (size_t)r * DM + 8 * lane;
        if (r >= MTOK) {
#pragma unroll
            for (int j = 0; j < 4; ++j) *(v4u*)(hrow + 512 * j) = (v4u){0u, 0u, 0u, 0u};
            continue; }
        const float* xr = (r < MPROMPT ? xp + (size_t)r * DM : xs + (size_t)(r - MPROMPT) * DM) + 8 * lane;
        const float* mr = MOD + (size_t)mod_row(r) * NMODC + 8 * lane;
        f32x4 v[4][2]; float ss = 0.f;
#pragma unroll
        for (int j = 0; j < 4; ++j) { v[j][0] = *(const f32x4*)(xr + 512 * j); v[j][1] = *(const f32x4*)(xr + 512 * j + 4);
#pragma unroll
            for (int i = 0; i < 4; ++i) ss += v[j][0][i] * v[j][0][i] + v[j][1][i] * v[j][1][i]; }
        const float rstd = rsqrtf(wave_sum(ss) * (1.0f / DM) + EPS);
#pragma unroll
        for (int j = 0; j < 4; ++j) { float o[8];
#pragma unroll
            for (int q = 0; q < 2; ++q) { const f32x4 g = *(const f32x4*)(gpre + 8 * lane + 512 * j + 4 * q), sh = *(const f32x4*)(mr + 512 * j + 4 * q), sc = *(const f32x4*)(mr + DM + 512 * j + 4 * q);
#pragma unroll
                for (int i = 0; i < 4; ++i) o[4 * q + i] = v[j][q][i] * rstd * g[i] * (1.0f + sc[i]) + sh[i]; }
            *(v4u*)(hrow + 512 * j) = pack8(o); }
    }
}
__device__ __forceinline__ void p5_rows(const float* xp, const float* xs, const bf16* O, const float* gpost, const float* gpre, const float* MOD, float* out, bf16* H2, int gw, int NGW, int lane) {
    for (int r = gw; r < MPAD; r += NGW) {
        bf16* hrow = H2 + (size_t)r * DM + 8 * lane;
        if (r >= MTOK) {
#pragma unroll
            for (int j = 0; j < 4; ++j) *(v4u*)(hrow + 512 * j) = (v4u){0u, 0u, 0u, 0u};
            continue; }
        const float* xr = (r < MPROMPT ? xp + (size_t)r * DM : xs + (size_t)(r - MPROMPT) * DM) + 8 * lane;
        float* x1r = (r < MPROMPT ? out + O_YP + (size_t)r * DM : out + O_YS + (size_t)(r - MPROMPT) * DM) + 8 * lane;
        const float* mr = MOD + (size_t)mod_row(r) * NMODC + 8 * lane;
        const bf16* orow = O + (size_t)r * DM + 8 * lane;
        float ov[4][8]; float ss = 0.f;
#pragma unroll
        for (int j = 0; j < 4; ++j) { unpack8(*(const v4u*)(orow + 512 * j), ov[j]);
#pragma unroll
            for (int i = 0; i < 8; ++i) ss += ov[j][i] * ov[j][i]; }
        const float rstd_o = rsqrtf(wave_sum(ss) * (1.0f / DM) + EPS);
        float x1[4][8]; float s1 = 0.f;
#pragma unroll
        for (int j = 0; j < 4; ++j)
#pragma unroll
            for (int q = 0; q < 2; ++q) { const f32x4 xv = *(const f32x4*)(xr + 512 * j + 4 * q), g = *(const f32x4*)(gpost + 8 * lane + 512 * j + 4 * q), gt = *(const f32x4*)(mr + 2 * DM + 512 * j + 4 * q);
                f32x4 y;
#pragma unroll
                for (int i = 0; i < 4; ++i) { y[i] = xv[i] + gt[i] * (ov[j][4 * q + i] * rstd_o * g[i]); x1[j][4 * q + i] = y[i]; s1 += y[i] * y[i]; }
                *(f32x4*)(x1r + 512 * j + 4 * q) = y; }
        const float rstd_1 = rsqrtf(wave_sum(s1) * (1.0f / DM) + EPS);
#pragma unroll
        for (int j = 0; j < 4; ++j) { float o[8];
#pragma unroll
            for (int q = 0; q < 2; ++q) { const f32x4 g = *(const f32x4*)(gpre + 8 * lane + 512 * j + 4 * q), sh = *(const f32x4*)(mr + 3 * DM + 512 * j + 4 * q), sc = *(const f32x4*)(mr + 4 * DM + 512 * j + 4 * q);
#pragma unroll
                for (int i = 0; i < 4; ++i) o[4 * q + i] = x1[j][4 * q + i] * rstd_1 * g[i] * (1.0f + sc[i]) + sh[i]; }
            *(v4u*)(hrow + 512 * j) = pack8(o); }
    }
}
__device__ __forceinline__ void p9_rows(const bf16* YF, const float* gpost, const float* MOD, float* out, int gw, int NGW, int lane) {
    for (int r = gw; r < MTOK; r += NGW) {
        float* x1r = (r < MPROMPT ? out + O_YP + (size_t)r * DM : out + O_YS + (size_t)(r - MPROMPT) * DM) + 8 * lane;
        const float* mr = MOD + (size_t)mod_row(r) * NMODC + 8 * lane;
        const bf16* yrow = YF + (size_t)r * DM + 8 * lane;
        float yv[4][8]; float ss = 0.f;
#pragma unroll
        for (int j = 0; j < 4; ++j) { unpack8(*(const v4u*)(yrow + 512 * j), yv[j]);
#pragma unroll
            for (int i = 0; i < 8; ++i) ss += yv[j][i] * yv[j][i]; }
        const float rstd = rsqrtf(wave_sum(ss) * (1.0f / DM) + EPS);
#pragma unroll
        for (int j = 0; j < 4; ++j)
#pragma unroll
            for (int q = 0; q < 2; ++q) { const f32x4 xv = *(const f32x4*)(x1r + 512 * j + 4 * q), g = *(const f32x4*)(gpost + 8 * lane + 512 * j + 4 * q), gt = *(const f32x4*)(mr + 5 * DM + 512 * j + 4 * q);
                f32x4 y;
#pragma unroll
                for (int i = 0; i < 4; ++i) y[i] = xv[i] + gt[i] * (yv[j][4 * q + i] * rstd * g[i]);
                *(f32x4*)(x1r + 512 * j + 4 * q) = y; }
    }
}
__device__ __forceinline__ void p7_prompt(const bf16* A, bf16* U, const float* conv_w, const float* conv_b, int gw, int NGW, int lane) {
    for (int it = gw; it < 11 * (MPROMPT / 32); it += NGW) {
        const int rr = it / 11, cg = it - rr * 11, r0 = 32 * rr, c0 = 512 * cg + 8 * lane;
        float w0[8], w1[8], w2[8], bb[8], am2[8], am1[8];
#pragma unroll
        for (int q = 0; q < 2; ++q) { const f32x4 a = *(const f32x4*)(conv_w + c0 + 4 * q), b = *(const f32x4*)(conv_w + DFF + c0 + 4 * q), c = *(const f32x4*)(conv_w + 2 * DFF + c0 + 4 * q), d = *(const f32x4*)(conv_b + c0 + 4 * q);
#pragma unroll
            for (int i = 0; i < 4; ++i) { w0[4 * q + i] = a[i]; w1[4 * q + i] = b[i]; w2[4 * q + i] = c[i]; bb[4 * q + i] = d[i]; } }
        if ((r0 & (SEQ - 1)) == 0) {
#pragma unroll
            for (int i = 0; i < 8; ++i) { am2[i] = 0.f; am1[i] = 0.f; }
        } else { unpack8(*(const v4u*)(A + (size_t)(r0 - 2) * DFF + c0), am2); unpack8(*(const v4u*)(A + (size_t)(r0 - 1) * DFF + c0), am1); }
#pragma unroll 4
        for (int r = r0; r < r0 + 32; ++r) {
            float a[8], u[8], o[8];
            unpack8(*(const v4u*)(A + (size_t)r * DFF + c0), a); unpack8(*(const v4u*)(U + (size_t)r * DFF + c0), u);
#pragma unroll
            for (int i = 0; i < 8; ++i) { const float cv = bb[i] + w0[i] * am2[i] + w1[i] * am1[i] + w2[i] * a[i]; o[i] = gelu_f(cv) * u[i]; am2[i] = am1[i]; am1[i] = a[i]; }
            *(v4u*)(U + (size_t)r * DFF + c0) = pack8(o);
        }
    }
}
__device__ __forceinline__ void p7_sample(const bf16* A, bf16* U, const float* state, const float* conv_w, const float* conv_b, float* out, int gtid, int NGT) {
    for (int it = gtid; it < NSAMP * (DFF / 8); it += NGT) {
        const int sb = it / (DFF / 8), c0 = 8 * (it - sb * (DFF / 8)); const size_t row = (size_t)(MPROMPT + sb) * DFF + c0;
        float a[8], u[8], o[8];
        unpack8(*(const v4u*)(A + row), a); unpack8(*(const v4u*)(U + row), u);
#pragma unroll
        for (int q = 0; q < 2; ++q) { const f32x4 w0 = *(const f32x4*)(conv_w + c0 + 4 * q), w1 = *(const f32x4*)(conv_w + DFF + c0 + 4 * q), w2 = *(const f32x4*)(conv_w + 2 * DFF + c0 + 4 * q), bb = *(const f32x4*)(conv_b + c0 + 4 * q);
            const f32x4 s0 = *(const f32x4*)(state + (size_t)(sb * 2 + 0) * DFF + c0 + 4 * q), s1 = *(const f32x4*)(state + (size_t)(sb * 2 + 1) * DFF + c0 + 4 * q);
#pragma unroll
            for (int i = 0; i < 4; ++i) { const float cv = bb[i] + w0[i] * s0[i] + w1[i] * s1[i] + w2[i] * a[4 * q + i]; o[4 * q + i] = gelu_f(cv) * u[4 * q + i]; }
            *(f32x4*)(out + O_CS + (size_t)(sb * 2 + 0) * DFF + c0 + 4 * q) = s1; }
        *(v4u*)(U + row) = pack8(o);
    }
}
constexpr int MX_K = 0, MX_V = 32768, MX_VN = 65536, MX_STG = 98304, MX_TAB = 131072, MX_PART = MX_TAB + 1536, MX_END = MX_PART + 4096;
static_assert(MX_END <= MISC_OFF, "mixer LDS");
__device__ __forceinline__ void mixer_prompt_item(LAS unsigned char* lds, const bf16* __restrict__ Z, const f32x2* __restrict__ STAT, const bf16* __restrict__ TRIL, bf16* __restrict__ MERGED,
                                                  const float* __restrict__ sinks, const float* __restrict__ rel_bias, const float* __restrict__ lng, const float* __restrict__ lnb, const float* __restrict__ b_s,
                                                  int item, int tid, int lane, int wave) {
    asm volatile("" : "+v"(tid), "+v"(lane));
    const int g = item & 15, n = (item >> 4) & 63, b = item >> 10, kvh = g >> 2, R0 = b * SEQ + n * 128;
    LAS unsigned char* Kt = lds + MX_K; LAS unsigned char* Vt = lds + MX_V; LAS unsigned char* VNt = lds + MX_VN; LAS unsigned char* STG = lds + MX_STG + wave * 4096;
    LAS float* TAB = (LAS float*)(lds + MX_TAB); LAS f32x2* PART = (LAS f32x2*)(lds + MX_PART);
    const int hh = wave & 1, qb = wave >> 1, head = 2 * g + hh, ql = lane & 31, hi = lane >> 5;
    f32x2 st[8];
#pragma unroll
    for (int p = 0; p < 8; ++p) st[p] = STAT[(size_t)(8 * (tid >> 7) + p) * MPAD + R0 + (tid & 127)];
    v4u kreg[4], vreg[4], greg[4];
#pragma unroll
    for (int i = 0; i < 4; ++i) {
        const int q = tid + 512 * i, j = q >> 3, c = q & 7;
        if (n > 0 || j >= 128) { const bf16* src = Z + (size_t)(R0 - 128 + j) * DIN + 64 * kvh + 8 * c; kreg[i] = *(const v4u*)(src + CK); vreg[i] = *(const v4u*)(src + CV); }
    }
#pragma unroll
    for (int i = 0; i < 4; ++i) { const int q = tid + 512 * i, j = q >> 4, c = q & 15; greg[i] = *(const v4u*)(Z + (size_t)(R0 + j) * DIN + CG + 128 * g + 8 * c); }
    bf16x8 qf[4];
    { const bf16* qp = Z + (size_t)(R0 + 32 * qb + ql) * DIN + CQ + 64 * head + 8 * hi;
#pragma unroll
      for (int d0 = 0; d0 < 4; ++d0) qf[d0] = *(const bf16x8*)(qp + 16 * d0); }
    const float sk = sinks[head] * LOG2E;
    __syncthreads();
    { float s1 = 0.f, s2 = 0.f;
#pragma unroll
      for (int p = 0; p < 8; ++p) { s1 += st[p].x; s2 += st[p].y; }
      PART[tid] = (f32x2){s1, s2}; }
    if (tid < 384) {
        const int th = tid / 192, idx = tid - th * 192, dist = idx - 32;
        TAB[tid] = (dist >= 0 && dist <= 128) ? rel_bias[t5_bucket(dist) * 32 + 2 * g + th] * LOG2E : -1e30f;
    }
#pragma unroll
    for (int i = 0; i < 4; ++i) {
        const int q = tid + 512 * i, j = q >> 3, c = q & 7;
        if (n > 0 || j >= 128) {
            *(LAS v4u*)(Kt + j * 128 + ((c ^ ((j >> 1) & 7)) << 4)) = kreg[i];
            *(LAS v4u*)(Vt + (j >> 4) * 2048 + (c >> 2) * 1024 + ((j >> 3) & 1) * 512 + (j & 7) * 64 + (c & 3) * 16) = vreg[i];
        }
    }
    const int nsteps = 2 * (qb + 1);
    bf16x8 wf[8];
    { const bf16* wp = TRIL + ((size_t)g * 128 + 32 * qb + ql) * 128 + 8 * hi;
#pragma unroll
      for (int s = 0; s < 8; ++s) if (s < nsteps) wf[s] = *(const bf16x8*)(wp + 16 * s); }
    __syncthreads();
#pragma unroll
    for (int i = 0; i < 4; ++i) {
        const int q = tid + 512 * i, j = q >> 4, c = q & 15, ch = 128 * g + 8 * c;
        float v[8]; unpack8(greg[i], v);
        const f32x2 pa_ = PART[j], pb_ = PART[128 + j], pc_ = PART[256 + j], pd_ = PART[384 + j];
        const float mean = ((pa_.x + pb_.x) + (pc_.x + pd_.x)) * (1.0f / DM), var = ((pa_.y + pb_.y) + (pc_.y + pd_.y)) * (1.0f / DM) - mean * mean, rstd = rsqrtf(fmaxf(var, 0.f) + EPS);
#pragma unroll
        for (int qq = 0; qq < 2; ++qq) { const f32x4 gg = *(const f32x4*)(lng + ch + 4 * qq), bb = *(const f32x4*)(lnb + ch + 4 * qq);
#pragma unroll
            for (int k = 0; k < 4; ++k) v[4 * qq + k] = (v[4 * qq + k] - mean) * rstd * gg[k] + bb[k]; }
        *(LAS v4u*)(VNt + (j >> 4) * 4096 + (c >> 2) * 1024 + ((j >> 3) & 1) * 512 + (j & 7) * 64 + (c & 3) * 16) = pack8(v);
    }
    __syncthreads();
    const int tmin = (n == 0) ? (4 - qb) : 0;
    f32x16 p[5];
    int tboff = (hh * 192 + ql - 4 * hi + 5) * 4, kboff = (32 * qb + ql) * 128, swz = (ql >> 1) & 7;
    asm volatile("" : "+v"(tboff), "+v"(kboff), "+v"(swz));
    const LAS float* tb = (const LAS float*)((const LAS unsigned char*)TAB + tboff);
    const LAS unsigned char* kb0 = Kt + kboff;
#pragma unroll
    for (int t = 0; t < 5; ++t) {
        if (t >= tmin) {
            f32x16 acc = {};
#pragma unroll
            for (int d0 = 0; d0 < 4; ++d0) { const bf16x8 kf = *(const LAS bf16x8*)(kb0 + t * 4096 + (((2 * d0 + hi) ^ swz) << 4)); acc = mfma32(kf, qf[d0], acc); }
#pragma unroll
            for (int r = 0; r < 16; ++r) acc[r] += tb[155 - 32 * t - (r & 3) - 8 * (r >> 2)];
            p[t] = acc;
        } else {
#pragma unroll
            for (int r = 0; r < 16; ++r) p[t][r] = -1e30f;
        }
    }
    float m = -1e30f;
#pragma unroll
    for (int t = 0; t < 5; ++t)
#pragma unroll
        for (int r = 0; r < 16; ++r) m = fmaxf(m, p[t][r]);
    m = fmaxf(m, __shfl_xor(m, 32));
    m = fmaxf(m, sk);
    float sum = 0.f;
#pragma unroll
    for (int t = 0; t < 5; ++t)
#pragma unroll
        for (int r = 0; r < 16; ++r) { p[t][r] = fast_exp2(p[t][r] - m); sum += p[t][r]; }
    sum += __shfl_xor(sum, 32);
    const float inv = 1.0f / (sum + fast_exp2(sk - m));
    v4u mga[4], mgb[4], mu[4]; float bsv[4];
#pragma unroll
    for (int i = 0; i < 4; ++i) { const bf16* zr = Z + (size_t)(R0 + 32 * qb + 8 * i + (lane >> 3)) * DIN + 128 * g + 64 * hh + 8 * (lane & 7);
        mga[i] = *(const v4u*)(zr + CGA); mgb[i] = *(const v4u*)(zr + CGB); mu[i] = *(const v4u*)(zr + CU); bsv[i] = b_s[g * 128 + 32 * qb + 8 * i + (lane >> 3)]; }
    f32x16 o[2] = {{}, {}}, sg[2] = {{}, {}};
    int vlane = (4 * hi + ((lane & 15) >> 2)) * 64 + ((lane >> 4) & 1) * 32 + (lane & 3) * 8 + 2 * qb * 2048;
    asm volatile("" : "+v"(vlane));
#pragma unroll
    for (int t = 0; t < 5; ++t) {
        if (t >= tmin) {
#pragma unroll
            for (int s = 0; s < 2; ++s) {
                v4u pw; pw.x = cvtpk(p[t][8 * s + 0] * inv, p[t][8 * s + 1] * inv); pw.y = cvtpk(p[t][8 * s + 2] * inv, p[t][8 * s + 3] * inv);
                pw.z = cvtpk(p[t][8 * s + 4] * inv, p[t][8 * s + 5] * inv); pw.w = cvtpk(p[t][8 * s + 6] * inv, p[t][8 * s + 7] * inv);
                const bf16x8 pa = __builtin_bit_cast(bf16x8, pw);
                const LAS unsigned char* vp = Vt + (2 * t + s) * 2048 + vlane;
#pragma unroll
                for (int dh = 0; dh < 2; ++dh) { const bf16x8 vf = cat8(tr16(vp + dh * 1024), tr16(vp + dh * 1024 + 512)); o[dh] = mfma32(pa, vf, o[dh]); }
            }
        }
    }
    { int nlane = hi * 512 + ((lane & 15) >> 2) * 64 + ((lane >> 4) & 1) * 32 + (lane & 3) * 8 + (2 * hh) * 1024;
      asm volatile("" : "+v"(nlane));
#pragma unroll
      for (int s = 0; s < 8; ++s) {
          if (s < nsteps) {
              const LAS unsigned char* np = VNt + s * 4096 + nlane;
#pragma unroll
              for (int dh = 0; dh < 2; ++dh) { const bf16x8 vf = cat8(tr16(np + dh * 1024), tr16(np + dh * 1024 + 256)); sg[dh] = mfma32(wf[s], vf, sg[dh]); }
          }
      } }
    v4u t1[4], t2[4];
    int swoff = (4 * hi) * 128 + ql * 2, sroff = (lane >> 3) * 128 + (lane & 7) * 16;
    asm volatile("" : "+v"(swoff), "+v"(sroff));
    LAS unsigned char* stw = STG + swoff; const LAS unsigned char* str_ = STG + sroff;
#pragma unroll
    for (int dh = 0; dh < 2; ++dh)
#pragma unroll
        for (int r = 0; r < 16; ++r) *(LAS bf16*)(stw + ((r & 3) + 8 * (r >> 2)) * 128 + 64 * dh) = (bf16)(cvtpk(o[dh][r], 0.f) & 0xffffu);
    LDS_WAIT();
#pragma unroll
    for (int i = 0; i < 4; ++i) t1[i] = *(const LAS v4u*)(str_ + i * 1024);
    LDS_WAIT();
#pragma unroll
    for (int dh = 0; dh < 2; ++dh)
#pragma unroll
        for (int r = 0; r < 16; ++r) *(LAS bf16*)(stw + ((r & 3) + 8 * (r >> 2)) * 128 + 64 * dh) = (bf16)(cvtpk(sg[dh][r], 0.f) & 0xffffu);
    LDS_WAIT();
#pragma unroll
    for (int i = 0; i < 4; ++i) t2[i] = *(const LAS v4u*)(str_ + i * 1024);
    LDS_WAIT();
#pragma unroll
    for (int i = 0; i < 4; ++i) {
        const size_t grow = (size_t)(R0 + 32 * qb + 8 * i + (lane >> 3)); const int ch = 128 * g + 64 * hh + 8 * (lane & 7);
        float a[8], s[8], ga[8], gb[8], u[8], o8[8];
        unpack8(t1[i], a); unpack8(t2[i], s); unpack8(mga[i], ga); unpack8(mgb[i], gb); unpack8(mu[i], u);
#pragma unroll
        for (int k = 0; k < 8; ++k) o8[k] = ga[k] * a[k] + gb[k] * (u[k] * (s[k] + bsv[i]));
        *(v4u*)(MERGED + grow * DM + ch) = pack8(o8);
    }
}
constexpr int SM_K = 0, SM_V = 33792, SM_Q = SM_V + 129 * 64 * 4, SM_S = SM_Q + 2048, SM_R = SM_S + 8 * 132 * 4, SM_END = SM_R + 64;
static_assert(SM_K + 129 * 65 * 4 <= SM_V && SM_END <= RING_BYTES, "sample mixer LDS");
__device__ __forceinline__ void mixer_sample_item(LAS unsigned char* lds, const bf16* __restrict__ Z, bf16* __restrict__ MERGED, const float* __restrict__ cache_k, const float* __restrict__ cache_v,
                                                  const float* __restrict__ sinks, const float* __restrict__ rel_bias, const float* __restrict__ lng, const float* __restrict__ lnb,
                                                  const float* __restrict__ w_s, const float* __restrict__ b_s, float* __restrict__ out, int item, int tid, int lane, int wave) {
    asm volatile("" : "+v"(tid), "+v"(lane));
    const int kvh = item & 3, sb = item >> 2; const size_t zrow = (size_t)(MPROMPT + sb) * DIN;
    LAS float* KS = (LAS float*)(lds + SM_K); LAS float* VS = (LAS float*)(lds + SM_V); LAS float* QS = (LAS float*)(lds + SM_Q); LAS float* SC = (LAS float*)(lds + SM_S); LAS float* RED = (LAS float*)(lds + SM_R);
    const int head = 8 * kvh + wave, ch = 64 * head + lane, grp = ch >> 7;
    float kc[16], vc[16];
#pragma unroll
    for (int i = 0; i < 16; ++i) { const size_t ci = ((size_t)(sb * 128 + 8 * i + wave) * 4 + kvh) * 64 + lane; kc[i] = cache_k[ci]; vc[i] = cache_v[ci]; }
    const float knew = bf1(Z[zrow + CK + 64 * kvh + lane]), vnew = bf1(Z[zrow + CV + 64 * kvh + lane]);
    const float qv = bf1(Z[zrow + CQ + 64 * head + lane]);
    const v2u gvw = *(const v2u*)(Z + zrow + CG + 4 * tid);
    const float gvc = bf1(Z[zrow + CG + ch]), uc = bf1(Z[zrow + CU + ch]), gac = bf1(Z[zrow + CGA + ch]), gbc = bf1(Z[zrow + CGB + ch]);
    const float lg = lng[ch], lb = lnb[ch], ws0 = w_s[(size_t)grp * 128 * 128], bs0 = b_s[grp * 128], sk = sinks[head] * LOG2E;
    __syncthreads();
#pragma unroll
    for (int i = 0; i < 16; ++i) { const int j = 8 * i + wave; KS[j * 65 + lane] = kc[i]; VS[j * 64 + lane] = vc[i];
        if (j >= 1) { const size_t co = ((size_t)(sb * 128 + j - 1) * 4 + kvh) * 64 + lane; out[O_KS + co] = kc[i]; out[O_VS + co] = vc[i]; } }
    if (wave == 0) { KS[128 * 65 + lane] = knew; VS[128 * 64 + lane] = vnew; }
    QS[tid] = qv;
    { const float g0 = bflo(gvw.x), g1 = bfhi(gvw.x), g2 = bflo(gvw.y), g3 = bfhi(gvw.y);
      const float a = wave_sum((g0 + g1) + (g2 + g3)), q = wave_sum((g0 * g0 + g1 * g1) + (g2 * g2 + g3 * g3));
      if (lane == 0) { RED[wave] = a; RED[8 + wave] = q; } }
    __syncthreads();
    for (int e = tid; e < 8 * 129; e += 512) {
        const int h8 = e / 129, j = e - 129 * h8; float dot = 0.f;
#pragma unroll 16
        for (int d = 0; d < 64; ++d) dot += QS[h8 * 64 + d] * KS[j * 65 + d];
        SC[h8 * 132 + j] = dot + rel_bias[t5_bucket(128 - j) * 32 + 8 * kvh + h8] * LOG2E;
    }
    __syncthreads();
    { const float s0 = SC[wave * 132 + lane], s1 = SC[wave * 132 + 64 + lane], s2 = (lane == 0) ? SC[wave * 132 + 128] : -1e30f;
      const float m = fmaxf(wave_max(fmaxf(fmaxf(s0, s1), s2)), sk);
      const float e0 = fast_exp2(s0 - m), e1 = fast_exp2(s1 - m), e2 = fast_exp2(s2 - m);
      const float inv = 1.0f / (wave_sum(e0 + e1 + e2) + fast_exp2(sk - m));
      SC[wave * 132 + lane] = e0 * inv; SC[wave * 132 + 64 + lane] = e1 * inv; if (lane == 0) SC[wave * 132 + 128] = e2 * inv; }
    LDS_WAIT();
    float ya = 0.f;
#pragma unroll 3
    for (int j = 0; j < 129; ++j) ya += SC[wave * 132 + j] * VS[j * 64 + lane];
    float s1 = 0.f, s2 = 0.f;
#pragma unroll
    for (int w = 0; w < 8; ++w) { s1 += RED[w]; s2 += RED[8 + w]; }
    const float mean = s1 * (1.0f / DM), var = s2 * (1.0f / DM) - mean * mean, rstd = rsqrtf(fmaxf(var, 0.f) + EPS);
    const float vn = (gvc - mean) * rstd * lg + lb;
    out[O_SG + (size_t)sb * DM + ch] = vn;
    const float mg = gac * ya + gbc * (uc * (ws0 * vn + bs0));
    MERGED[(size_t)(MPROMPT + sb) * DM + ch] = (bf16)(cvtpk(mg, 0.f) & 0xffffu);
}
constexpr int NWAVES = 8;
constexpr int CW_BAR = 4096;
static_assert((CW_BAR + XCD_BAR_WORDS) * 4 <= (int)CTL_ZERO_BYTES, "control words inside the memset region");
constexpr int N_PHASES = 10;
struct Args { const float* in[26]; float* out; unsigned char* ws; int ph_lo, ph_hi; };

__global__ void __launch_bounds__(NWAVES * 64, 2) fwd_kernel(Args args) {
    extern __shared__ __attribute__((aligned(16))) unsigned char lds_raw[];
    LAS unsigned char* lds = (LAS unsigned char*)lds_raw;
    volatile LAS unsigned* MISC = (volatile LAS unsigned*)(lds + MISC_OFF);
    const int tid = threadIdx.x, lane = tid & 63, wave = __builtin_amdgcn_readfirstlane(tid >> 6);
    const int G = gridDim.x, bx = blockIdx.x, vcu = (G % 8 == 0) ? (bx % 8) * (G / 8) + bx / 8 : bx;
    const int gw = vcu * NWAVES + wave, NGW = G * NWAVES;
    unsigned char* ws = args.ws; float* out = args.out;
    gu32* ctl = (gu32*)(ws + WS_CTL);
    float* MOD = (float*)(ws + WS_MOD); f32x2* STAT = (f32x2*)(ws + WS_STAT); bf16* TRIL = (bf16*)(ws + WS_TRIL);
    bf16* WO_T = (bf16*)(ws + WS_WO); bf16* WGU_T = (bf16*)(ws + WS_WGU); bf16* WD_T = (bf16*)(ws + WS_WD); bf16* WIN_T = (bf16*)(ws + WS_WIN);
    bf16* Zb = (bf16*)(ws + WS_Z); bf16* Ob = (bf16*)(ws + WS_O); bf16* ABUF = (bf16*)(ws + WS_ABUF); bf16* UBUF = (bf16*)(ws + WS_UBUF); bf16* H2 = (bf16*)(ws + WS_H2); bf16* YF = (bf16*)(ws + WS_YF);
    bf16* Hb = (bf16*)out;
    for (int u = tid; u < 32; u += NWAVES * 64) MISC[u] = 0u;
    __syncthreads();
    const int lo = args.ph_lo, hi = args.ph_hi;
    const bool one_launch = (hi - lo) > 1;
    XcdBarrier bar; bar.bar = (unsigned*)(ctl + CW_BAR); bar.x = 0; bar.st = nullptr;
    if (one_launch) bar = xcd_barrier_post((unsigned*)(ctl + CW_BAR), MISC + 8);
#define IN(k) (lo <= (k) && (k) < hi)
#ifndef PROBE_PHASE
#define PROBE_PHASE -1
#endif
    unsigned long long pt0 = 0ull, pt1 = 0ull;
#define SEAM(k) do { if (IN(k) && IN((k) + 1)) xcd_barrier(bar); if (PROBE_PHASE == (k) + 1) pt0 = __builtin_amdgcn_s_memrealtime(); if (PROBE_PHASE == (k)) pt1 = __builtin_amdgcn_s_memrealtime(); } while (0)
    if (PROBE_PHASE == 0) pt0 = __builtin_amdgcn_s_memrealtime();

    if (IN(0)) {
        if (bx < NMODC / 64) p0_mod_item(lds, args.in[2], args.in[3], args.in[7], args.in[8], MOD, bx, tid, lane, wave);
        constexpr int T_IN = 32 * 168, T_O = 32 * 32, T_G = 32 * 88, T_D = 88 * 32, T_ALL = T_IN + T_O + 2 * T_G + T_D;
        for (int it = gw; it < T_ALL; it += NGW) {
            int r = it;
            if (r < T_IN) { p0_transpose_tile(args.in[13], DM, DIN, WIN_T, r, lane); continue; } r -= T_IN;
            if (r < T_O) { p0_transpose_tile(args.in[14], DM, DM, WO_T, r, lane); continue; } r -= T_O;
            if (r < T_G) { p0_transpose_tile(args.in[22], DM, DFF, WGU_T, r, lane); continue; } r -= T_G;
            if (r < T_G) { p0_transpose_tile(args.in[21], DM, DFF, WGU_T + (size_t)DFF * DM, r, lane); continue; } r -= T_G;
            p0_transpose_tile(args.in[25], DFF, DM, WD_T, r, lane);
        }
        { const float* w_s = args.in[19];
          for (int it = vcu * 512 + tid; it < 16 * 128 * 128 / 8; it += G * 512) { const int e0 = 8 * it, j0 = e0 & 127, i = (e0 >> 7) & 127;
              const f32x4 a = *(const f32x4*)(w_s + e0), b = *(const f32x4*)(w_s + e0 + 4); float v[8];
#pragma unroll
              for (int k = 0; k < 4; ++k) { v[k] = (j0 + k <= i) ? a[k] : 0.f; v[4 + k] = (j0 + 4 + k <= i) ? b[k] : 0.f; }
              *(v4u*)(TRIL + e0) = pack8(v); } }
    }
    SEAM(0);
    if (IN(1)) p1_rows(args.in[0], args.in[1], args.in[9], MOD, Hb, gw, NGW, lane);
    SEAM(1);
    if (IN(2)) {
        pg8::Gemm g{Hb, WIN_T, MPAD, DIN, DM}; pg8::StaticOrder S; S.init(MPAD, DIN, G, bx);
        pg8::EpiZ E{Zb, out, STAT};
        pg8::gemm_phase<pg8::EpiZ, pg8::StaticOrder, PG8_ALIGN, PG8_SP2>(lds, g, S, E);
    }
    SEAM(2);
    if (IN(3)) {
        for (int it = vcu; it < 2048; it += G) mixer_prompt_item(lds, Zb, STAT, TRIL, Hb, args.in[15], args.in[16], args.in[17], args.in[18], args.in[20], it, tid, lane, wave);
        for (int it = vcu; it < 512; it += G) mixer_sample_item(lds, Zb, Hb, args.in[4], args.in[5], args.in[15], args.in[16], args.in[17], args.in[18], args.in[19], args.in[20], out, it, tid, lane, wave);
    }
    SEAM(3);
    if (IN(4)) {
        pg8::Gemm g{Hb, WO_T, MPAD, DM, DM}; pg8::StaticOrder S; S.init(MPAD, DM, G, bx);
        pg8::EpiPlain E{Ob, DM};
        pg8::gemm_phase<pg8::EpiPlain, pg8::StaticOrder, PG8_ALIGN, PG8_SP2>(lds, g, S, E);
    }
    SEAM(4);
    if (IN(5)) p5_rows(args.in[0], args.in[1], Ob, args.in[10], args.in[11], MOD, out, H2, gw, NGW, lane);
    SEAM(5);
    if (IN(6)) {
        pg8::Gemm g{H2, WGU_T, MPAD, 2 * DFF, DM}; pg8::StaticOrder S; S.init(MPAD, 2 * DFF, G, bx);
        pg8::EpiGU E{ABUF, UBUF, out};
        pg8::gemm_phase<pg8::EpiGU, pg8::StaticOrder, PG8_ALIGN, PG8_SP2>(lds, g, S, E);
    }
    SEAM(6);
    if (IN(7)) {
        p7_prompt(ABUF, UBUF, args.in[23], args.in[24], gw, NGW, lane);
        p7_sample(ABUF, UBUF, args.in[6], args.in[23], args.in[24], out, vcu * 512 + tid, G * 512);
    }
    SEAM(7);
    if (IN(8)) {
        pg8::Gemm g{UBUF, WD_T, MPAD, DM, DFF}; pg8::StaticOrder S; S.init(MPAD, DM, G, bx);
        pg8::EpiPlain E{YF, DM};
        pg8::gemm_phase<pg8::EpiPlain, pg8::StaticOrder, PG8_ALIGN, PG8_SP2>(lds, g, S, E);
    }
    SEAM(8);
    if (IN(9)) p9_rows(YF, args.in[12], MOD, out, gw, NGW, lane);
    if (PROBE_PHASE >= 0) { if (PROBE_PHASE == 9) pt1 = __builtin_amdgcn_s_memrealtime();
        if (bx == 0 && tid == 0) { const unsigned long long te = __builtin_amdgcn_s_memrealtime(), dl = 4ull * (pt1 - pt0); while (__builtin_amdgcn_s_memrealtime() - te < dl) __builtin_amdgcn_s_sleep(32); } }
#undef IN
#undef SEAM
}

#ifndef MK_ONE_LAUNCH
#define MK_ONE_LAUNCH 1
#endif
extern "C" void kernel_launch(void* const* d_in, const int* in_sizes, int n_in, void* d_out, int out_size, void* d_ws, size_t ws_size, hipStream_t stream) {
    static int grid = 0;
    if (grid == 0) {
        if (n_in != 26 || in_sizes[0] != MPROMPT * DM || out_size != (int)O_END || ws_size < WS_END) {
            fprintf(stderr, "kernel_launch: unexpected problem shape (n_in %d, in0 %d, out %d, ws %zu); nothing launched\n", n_in, n_in > 0 ? in_sizes[0] : -1, out_size, ws_size); grid = -1; return; }
        int dev = 0, cus = 0, per_cu = 0;
        if (hipGetDevice(&dev) != hipSuccess || hipDeviceGetAttribute(&cus, hipDeviceAttributeMultiprocessorCount, dev) != hipSuccess) { grid = -1; return; }
        if (hipFuncSetAttribute((const void*)fwd_kernel, hipFuncAttributeMaxDynamicSharedMemorySize, LDS_BYTES) != hipSuccess) { fprintf(stderr, "kernel_launch: hipFuncSetAttribute failed\n"); grid = -1; return; }
        if (hipOccupancyMaxActiveBlocksPerMultiprocessor(&per_cu, (const void*)fwd_kernel, NWAVES * 64, LDS_BYTES) != hipSuccess || per_cu < 1) { fprintf(stderr, "kernel_launch: occupancy query says %d blocks per CU; nothing launched\n", per_cu); (void)hipGetLastError(); grid = -1; return; }
        grid = cus;
    }
    if (grid < 0) return;
    if (hipMemsetAsync((char*)d_ws + WS_CTL, 0, CTL_ZERO_BYTES, stream) != hipSuccess) return;
    Args a{};
    for (int i = 0; i < 26; ++i) a.in[i] = (const float*)d_in[i];
    a.out = (float*)d_out; a.ws = (unsigned char*)d_ws;
#if MK_ONE_LAUNCH
    a.ph_lo = 0; a.ph_hi = N_PHASES;
    void* kargs[] = {&a};
    hipError_t e = hipLaunchCooperativeKernel((const void*)fwd_kernel, dim3(grid), dim3(NWAVES * 64), kargs, LDS_BYTES, stream);
    if (e != hipSuccess) fprintf(stderr, "kernel_launch: cooperative launch failed: %s (grid %d)\n", hipGetErrorString(e), grid);
#else
    for (int p = 0; p < N_PHASES; ++p) { a.ph_lo = p; a.ph_hi = p + 1; hipLaunchKernelGGL(fwd_kernel, dim3(grid), dim3(NWAVES * 64), LDS_BYTES, stream, a); }
#endif
}
```

```cpp
#include <hip/hip_runtime.h>
#include <cstdio>
#include <cstdint>

constexpr int DM = 2048, SEQ = 8192, NBATCH = 2, MPROMPT = NBATCH * SEQ, NSAMP = 128, MTOK = MPROMPT + NSAMP, MPAD = 16640;
constexpr int DIN = 10752, DFF = 5632, NMODC = 12288, NMODR = 130;
constexpr int CQ = 0, CK = 2048, CV = 2304, CU = 2560, CG = 4608, CGA = 6656, CGB = 8704;
constexpr float EPS = 1e-6f, LOG2E = 1.4426950408889634f, QSCALE = 0.125f * 1.4426950408889634f;
constexpr size_t O_YP = 0, O_YS = 33554432, O_KP = 33816576, O_VP = 33882112, O_CP = 33947648, O_KS = 33970176, O_VS = 38164480, O_CS = 42358784, O_SG = 43800576, O_END = 44062720;

constexpr size_t KiB = 1024, MiB = 1u << 20;
constexpr size_t WS_CTL = 0, CTL_ZERO_BYTES = 64 * KiB;
constexpr size_t WS_MOD = 1 * MiB;
constexpr size_t WS_STAT = WS_MOD + 6656 * KiB;
constexpr size_t WS_TRIL = WS_STAT + 4352 * KiB;
constexpr size_t WS_WO = WS_TRIL + 512 * KiB;
constexpr size_t WS_WGU = WS_WO + 8 * MiB;
constexpr size_t WS_WD = WS_WGU + 44 * MiB;
constexpr size_t WS_ARENA = WS_WD + 22 * MiB;
constexpr size_t WS_WIN = WS_ARENA;
constexpr size_t WS_Z = WS_ARENA + 42 * MiB;
constexpr size_t WS_O = WS_ARENA;
constexpr size_t WS_ABUF = WS_ARENA;
constexpr size_t WS_UBUF = WS_ABUF + (size_t)MPAD * DFF * 2;
constexpr size_t WS_H2 = WS_UBUF + (size_t)MPAD * DFF * 2;
constexpr size_t WS_YF = WS_ABUF;
constexpr size_t WS_SLAB = WS_ARENA + 128 * MiB;
constexpr size_t WS_END = WS_H2 + (size_t)MPAD * DM * 2;
static_assert(WS_MOD + (size_t)NMODR * NMODC * 4 <= WS_STAT && WS_STAT + (size_t)32 * MPAD * 8 <= WS_TRIL, "ws map");
static_assert(WS_Z + (size_t)MPAD * DIN * 2 <= 512 * MiB && WS_END <= 512 * MiB, "ws map exceeds 512 MiB");

constexpr int RING_BYTES = 131072;
constexpr int MISC_OFF = 143360;
constexpr int LDS_BYTES = 147456;

#define GAS __attribute__((address_space(1)))
#define LAS __attribute__((address_space(3)))
typedef unsigned short bf16;
typedef unsigned v4u __attribute__((ext_vector_type(4)));
typedef unsigned v2u __attribute__((ext_vector_type(2)));
typedef float f32x2 __attribute__((ext_vector_type(2)));
typedef float f32x4 __attribute__((ext_vector_type(4)));
typedef float f32x16 __attribute__((ext_vector_type(16)));
typedef short bf16x8 __attribute__((ext_vector_type(8)));
typedef short s16x4 __attribute__((ext_vector_type(4)));
typedef __bf16 bf16x2_t __attribute__((ext_vector_type(2)));
typedef GAS unsigned gu32;
#define RLX_AGENT __ATOMIC_RELAXED, __HIP_MEMORY_SCOPE_AGENT
#define LDS_WAIT() asm volatile("s_waitcnt lgkmcnt(0)" ::: "memory")
#define VM_WAIT() asm volatile("s_waitcnt vmcnt(0)" ::: "memory")

__device__ __forceinline__ unsigned cvtpk(float lo, float hi) { f32x2 v = {lo, hi}; bf16x2_t b = __builtin_convertvector(v, bf16x2_t); return __builtin_bit_cast(unsigned, b); }
__device__ __forceinline__ float bflo(unsigned w) { return __uint_as_float(w << 16); }
__device__ __forceinline__ float bfhi(unsigned w) { return __uint_as_float(w & 0xffff0000u); }
__device__ __forceinline__ float bf1(bf16 b) { return __uint_as_float((unsigned)b << 16); }
__device__ __forceinline__ float fast_rcp(float x) { return __builtin_amdgcn_rcpf(x); }
__device__ __forceinline__ float fast_exp2(float x) { return __builtin_amdgcn_exp2f(x); }
__device__ __forceinline__ float sigmoid_f(float x) { return fast_rcp(1.0f + fast_exp2(-LOG2E * x)); }
__device__ __forceinline__ float gelu_f(float x) { const float u = x * (0.7978845608028654f + 0.035677408136300125f * x * x); return x * fast_rcp(1.0f + fast_exp2(-2.0f * LOG2E * u)); }
__device__ __forceinline__ float silu_f(float x) { return x * sigmoid_f(x); }
__device__ __forceinline__ float wave_sum(float v) {
#pragma unroll
    for (int o = 1; o < 64; o <<= 1) v += __shfl_xor(v, o);
    return v;
}
__device__ __forceinline__ float wave_max(float v) {
#pragma unroll
    for (int o = 1; o < 64; o <<= 1) v = fmaxf(v, __shfl_xor(v, o));
    return v;
}
__device__ __forceinline__ int t5_bucket(int d) {
    if (d < 16) return d;
    int b = 16;
    b += d >= 19; b += d >= 21; b += d >= 24; b += d >= 27; b += d >= 31; b += d >= 35; b += d >= 40; b += d >= 46; b += d >= 52; b += d >= 59; b += d >= 67; b += d >= 77; b += d >= 87; b += d >= 99; b += d >= 113;
    return b;
}
namespace pg8 {
#define PG8_LAS __attribute__((address_space(3)))
typedef unsigned short bf16_t;
typedef short bf16x8 __attribute__((ext_vector_type(8)));
typedef float f32x4 __attribute__((ext_vector_type(4)));
typedef unsigned u32x4 __attribute__((ext_vector_type(4)));
constexpr int BM = 256, BK = 64, HALF = 128, HTB = HALF * BK * 2  , STAGE_BYTES = 8 * HTB, NXCD = 8, WGM = 8;

__host__ __device__ __forceinline__ int lds_byte(int r, int c) { const int st = (r >> 4) * 2 + (c >> 5), rr = r & 15, cc = c & 31, ob = rr * 64 + cc * 2; return st * 1024 + (ob ^ (((ob >> 9) & 1) << 5)); }
__host__ __device__ __forceinline__ void stage_rc(int b, int& R, int& C) { const int st = b / 1024, sb = b % 1024, swz = sb ^ (((sb >> 9) & 1) << 5); R = (st >> 1) * 16 + swz / 64; C = (st & 1) * 32 + (swz % 64) / 2; }
__host__ __device__ __forceinline__ int perm32(int rho) { const int n = rho >> 4, i = rho & 15; return 8 * (i >> 2) + 4 * n + (i & 3); }

struct Unit { int pm, pn; };
struct Gemm { const bf16_t* A; const bf16_t* Bt; int M, N, K; };

struct StaticOrder {
    int nM, nN, nwg, G, c;
    __host__ __device__ void init(int M, int N, int G_, int c_) { nM = M / BM; nN = N / BM; nwg = nM * nN; G = G_; c = c_; }
    __host__ __device__ bool next(int i, Unit& u) const {
        const long L = (long)i * G + c; if (L >= nwg) return false;
        int wgid = (int)L; { const int q = nwg / NXCD, r = nwg % NXCD, xcd = wgid % NXCD, off = wgid / NXCD; wgid = (xcd < r ? xcd * (q + 1) : r * (q + 1) + (xcd - r) * q) + off; }
        const int nig = WGM * nN, gid = wgid / nig, fm = gid * WGM, gsz = (nM - fm) < WGM ? (nM - fm) : WGM;
        u.pm = fm + ((wgid % nig) % gsz); u.pn = (wgid % nig) / gsz; return true;
    }
    __device__ __forceinline__ void a_ready(const Unit&) const {}
    __device__ __forceinline__ void done(const Unit&) const {}
};

__device__ __forceinline__ void store8(bf16_t* p, const f32x4 v0, const f32x4 v1) {
    u32x4 w; w.x = cvtpk(v0[0], v0[1]); w.y = cvtpk(v0[2], v0[3]); w.z = cvtpk(v1[0], v1[1]); w.w = cvtpk(v1[2], v1[3]); *(u32x4*)p = w;
}
__device__ __forceinline__ void store4(bf16_t* p, const f32x4 v) { v2u w; w.x = cvtpk(v[0], v[1]); w.y = cvtpk(v[2], v[3]); *(v2u*)p = w; }
struct EpiPlain {
    static constexpr bool PERM = true, AFTER_DRAIN = false;
    bf16_t* O; int ldc;
    float* slab;
    __device__ __forceinline__ void small(int srow, int col, const f32x4 v, int sl) const { *(f32x4*)(slab + ((size_t)sl * NSAMP + srow) * ldc + col) = v; }
    __device__ __forceinline__ void operator()(const f32x4 (&acc)[2][2][4][2], const Unit& u, int wr, int wc, int fr, int fq) const {
        const int row0 = u.pm * BM + wr * 64 + fr, col0 = u.pn * BM + wc * 32 + 8 * fq;
#pragma unroll
        for (int ai = 0; ai < 2; ++ai)
#pragma unroll
            for (int m = 0; m < 4; ++m) { bf16_t* rowp = O + (size_t)(row0 + ai * HALF + m * 16) * ldc + col0;
#pragma unroll
                for (int bj = 0; bj < 2; ++bj) store8(rowp + bj * HALF, acc[ai][bj][m][0], acc[ai][bj][m][1]); }
    }
};
struct EpiZ {
    static constexpr bool PERM = true, AFTER_DRAIN = false;
    bf16_t* Z; float* out; f32x2* stat;
    __device__ __forceinline__ void small(int srow, int col, f32x4 v, int) const {
        if (col < CK) v = v * QSCALE;
        else if (col < CU) { float* d = out + (col < CV ? O_KS + (size_t)(srow * 128 + 127) * 256 + (col - CK) : O_VS + (size_t)(srow * 128 + 127) * 256 + (col - CV)); *(f32x4*)d = v; }
        else if (col < CGA) {
#pragma unroll
            for (int i = 0; i < 4; ++i) v[i] = gelu_f(v[i]);
        } else {
#pragma unroll
            for (int i = 0; i < 4; ++i) v[i] = sigmoid_f(v[i]);
        }
        store4(Z + (size_t)(MPROMPT + srow) * DIN + col, v);
    }
    __device__ __forceinline__ void operator()(const f32x4 (&acc)[2][2][4][2], const Unit& u, int wr, int wc, int fr, int fq) const {
        const int pn = u.pn, row0 = u.pm * BM + wr * 64 + fr, cw = wc * 32 + 8 * fq, col0 = pn * BM + cw;
        if (pn < 8) {
#pragma unroll
            for (int ai = 0; ai < 2; ++ai)
#pragma unroll
                for (int m = 0; m < 4; ++m) { bf16_t* rowp = Z + (size_t)(row0 + ai * HALF + m * 16) * DIN + col0;
#pragma unroll
                    for (int bj = 0; bj < 2; ++bj) store8(rowp + bj * HALF, acc[ai][bj][m][0] * QSCALE, acc[ai][bj][m][1] * QSCALE); }
        } else if (pn < 10) {
            const size_t o_p = (pn == 8) ? O_KP : O_VP, o_s = (pn == 8) ? O_KS : O_VS;
#pragma unroll
            for (int ai = 0; ai < 2; ++ai)
#pragma unroll
                for (int m = 0; m < 4; ++m) { const int lr = wr * 64 + m * 16 + fr; bf16_t* rowp = Z + (size_t)(row0 + ai * HALF + m * 16) * DIN + col0;
#pragma unroll
                    for (int bj = 0; bj < 2; ++bj) { const f32x4 v0 = acc[ai][bj][m][0], v1 = acc[ai][bj][m][1]; store8(rowp + bj * HALF, v0, v1);
                        if (ai == 1 && (u.pm == 31 || u.pm == 63)) { float* d = out + o_p + (size_t)((u.pm >> 5) * 128 + lr) * 256 + cw + bj * HALF; *(f32x4*)d = v0; *(f32x4*)(d + 4) = v1; }
                        if (ai == 0 && u.pm == 64) { float* d = out + o_s + (size_t)(lr * 128 + 127) * 256 + cw + bj * HALF; *(f32x4*)d = v0; *(f32x4*)(d + 4) = v1; } } }
        } else if (pn < 26) {
#pragma unroll
            for (int ai = 0; ai < 2; ++ai)
#pragma unroll
                for (int m = 0; m < 4; ++m) { const int row = row0 + ai * HALF + m * 16; bf16_t* rowp = Z + (size_t)row * DIN + col0; float s1 = 0.f, s2 = 0.f;
#pragma unroll
                    for (int bj = 0; bj < 2; ++bj) { f32x4 v0 = acc[ai][bj][m][0], v1 = acc[ai][bj][m][1];
#pragma unroll
                        for (int i = 0; i < 4; ++i) { v0[i] = gelu_f(v0[i]); v1[i] = gelu_f(v1[i]); s1 += v0[i] + v1[i]; s2 += v0[i] * v0[i] + v1[i] * v1[i]; }
                        store8(rowp + bj * HALF, v0, v1); }
                    if (pn >= 18) { s1 += __shfl_xor(s1, 16); s1 += __shfl_xor(s1, 32); s2 += __shfl_xor(s2, 16); s2 += __shfl_xor(s2, 32);
                        if (fq == 0) stat[(size_t)((pn - 18) * 4 + wc) * MPAD + row] = (f32x2){s1, s2}; } }
        } else {
#pragma unroll
            for (int ai = 0; ai < 2; ++ai)
#pragma unroll
                for (int m = 0; m < 4; ++m) { bf16_t* rowp = Z + (size_t)(row0 + ai * HALF + m * 16) * DIN + col0;
#pragma unroll
                    for (int bj = 0; bj < 2; ++bj) { f32x4 v0 = acc[ai][bj][m][0], v1 = acc[ai][bj][m][1];
#pragma unroll
                        for (int i = 0; i < 4; ++i) { v0[i] = sigmoid_f(v0[i]); v1[i] = sigmoid_f(v1[i]); }
                        store8(rowp + bj * HALF, v0, v1); } }
        }
    }
};
struct EpiGU {
    static constexpr bool PERM = true, AFTER_DRAIN = false;
    bf16_t* A; bf16_t* U; float* out;
    __device__ __forceinline__ void small(int srow, int col, const f32x4 v, int) const {
        if (col < DFF) { *(f32x4*)(out + O_CS + (size_t)(srow * 2 + 1) * DFF + col) = v; store4(A + (size_t)(MPROMPT + srow) * DFF + col, v); }
        else store4(U + (size_t)(MPROMPT + srow) * DFF + (col - DFF), v);
    }
    __device__ __forceinline__ void operator()(const f32x4 (&acc)[2][2][4][2], const Unit& u, int wr, int wc, int fr, int fq) const {
        const bool isa = u.pn < 22; const int row0 = u.pm * BM + wr * 64 + fr, col0 = (isa ? u.pn : u.pn - 22) * BM + wc * 32 + 8 * fq; bf16_t* base = isa ? A : U;
#pragma unroll
        for (int ai = 0; ai < 2; ++ai)
#pragma unroll
            for (int m = 0; m < 4; ++m) { const int lr = wr * 64 + m * 16 + fr; bf16_t* rowp = base + (size_t)(row0 + ai * HALF + m * 16) * DFF + col0;
#pragma unroll
                for (int bj = 0; bj < 2; ++bj) { const f32x4 v0 = acc[ai][bj][m][0], v1 = acc[ai][bj][m][1]; store8(rowp + bj * HALF, v0, v1);
                    if (isa && ai == 1 && lr >= 126 && (u.pm == 31 || u.pm == 63)) { float* d = out + O_CP + (size_t)((u.pm >> 5) * 2 + (lr - 126)) * DFF + col0 + bj * HALF; *(f32x4*)d = v0; *(f32x4*)(d + 4) = v1; }
                    if (isa && ai == 0 && u.pm == 64) { float* d = out + O_CS + (size_t)(lr * 2 + 1) * DFF + col0 + bj * HALF; *(f32x4*)d = v0; *(f32x4*)(d + 4) = v1; } } }
    }
};
template <class Epi, class Sched, bool ALIGN_EPI = false, bool SP2 = false>
__device__ __forceinline__ void gemm_phase(PG8_LAS unsigned char* lds, const Gemm g, const Sched& S, const Epi& E) {
    const int tid = threadIdx.x, wid = __builtin_amdgcn_readfirstlane(tid >> 6), lane = tid & 63, wr = wid >> 2, wc = wid & 3, fr = lane & 15, fq = lane >> 4;
    const int K = g.K, nt = K / BK;
    unsigned voffA[2], voffB[2];
#pragma unroll
    for (int i = 0; i < 2; ++i) { int R, C; stage_rc(tid * 16 + i * 8192, R, C); const int Rb = Epi::PERM ? ((R & ~31) + perm32(R & 31)) : R;
        voffA[i] = (unsigned)(R * K + C) * 2u; voffB[i] = (unsigned)(Rb * K + C) * 2u; }
    const size_t kstep = (size_t)(BK * 2);
    const size_t hstep = (size_t)HALF * K * 2;
    const size_t tstep = 2 * hstep;
    const unsigned ldsw = (unsigned)wid * 1024u;
    const int aoff = lds_byte(wr * 64 + fr, fq * 8), boff = lds_byte(wc * 32 + fr, fq * 8);
#define PG8_SA(b, h) (((b) * 2 + (h)) * HTB)
#define PG8_SB(b, h) ((4 + (b) * 2 + (h)) * HTB)
#define PG8_STAGE(bufoff, gbase, voff) do { _Pragma("unroll") for (int _i = 0; _i < 2; ++_i) \
        __builtin_amdgcn_global_load_lds((const unsigned*)((const char*)(gbase) + (voff)[_i]), (PG8_LAS unsigned*)(lds + (bufoff) + ldsw + _i * 8192), 16, 0, 0); } while (0)
#define PG8_LDA(dst, b, h) do { _Pragma("unroll") for (int m = 0; m < 4; ++m) _Pragma("unroll") for (int k = 0; k < 2; ++k) dst[m][k] = *(const PG8_LAS bf16x8*)(lds + PG8_SA(b, h) + aoff + m * 2048 + k * 1024); } while (0)
#define PG8_LDB(dst, b, h) do { _Pragma("unroll") for (int n = 0; n < 2; ++n) _Pragma("unroll") for (int k = 0; k < 2; ++k) dst[n][k] = *(const PG8_LAS bf16x8*)(lds + PG8_SB(b, h) + boff + n * 2048 + k * 1024); } while (0)
#define PG8_MMA(ai, bj, At, Bt) do { __builtin_amdgcn_s_setprio(1); _Pragma("unroll") for (int m = 0; m < 4; ++m) _Pragma("unroll") for (int n = 0; n < 2; ++n) _Pragma("unroll") for (int k = 0; k < 2; ++k) \
        acc[ai][bj][m][n] = __builtin_amdgcn_mfma_f32_16x16x32_bf16(Bt[n][k], At[m][k], acc[ai][bj][m][n], 0, 0, 0); __builtin_amdgcn_s_setprio(0); } while (0)
#define PG8_WAIT_V(n) asm volatile("s_waitcnt vmcnt(" #n ")" ::: "memory")
#define PG8_WAIT_L(n) asm volatile("s_waitcnt lgkmcnt(" #n ")" ::: "memory")
#define PG8_BAR __builtin_amdgcn_s_barrier()
#define PG8_SCHED __builtin_amdgcn_sched_barrier(0)
    Unit cur, nxt; int ui = 0;
    if (!S.next(0, cur)) return;
    f32x4 acc[2][2][4][2];
#pragma unroll
    for (int a = 0; a < 2; ++a)
#pragma unroll
        for (int b = 0; b < 2; ++b)
#pragma unroll
            for (int m = 0; m < 4; ++m)
#pragma unroll
                for (int n = 0; n < 2; ++n) acc[a][b][m][n] = (f32x4){0.f, 0.f, 0.f, 0.f};
    bf16x8 At[4][2], B0[2][2], B1[2][2];
    const char* cA = (const char*)g.A + (size_t)cur.pm * tstep; const char* cB = (const char*)g.Bt + (size_t)cur.pn * tstep;
    S.a_ready(cur);
    if constexpr (SP2) {
        PG8_STAGE(PG8_SB(0, 0), cB, voffB); PG8_STAGE(PG8_SB(0, 1), cB + hstep, voffB); PG8_STAGE(PG8_SA(0, 0), cA, voffA); PG8_STAGE(PG8_SA(0, 1), cA + hstep, voffA);
        if (wr == 1) PG8_BAR;
        PG8_WAIT_V(2); PG8_BAR;
        PG8_STAGE(PG8_SB(1, 0), cB + kstep, voffB); PG8_STAGE(PG8_SA(1, 0), cA + kstep, voffA); PG8_STAGE(PG8_SB(1, 1), cB + hstep + kstep, voffB);
        PG8_WAIT_V(6); PG8_BAR;
    } else {
        PG8_STAGE(PG8_SB(0, 0), cB, voffB); PG8_STAGE(PG8_SA(0, 0), cA, voffA); PG8_STAGE(PG8_SB(0, 1), cB + hstep, voffB); PG8_STAGE(PG8_SA(0, 1), cA + hstep, voffA);
        if (wr == 1) PG8_BAR;
        PG8_WAIT_V(4); PG8_BAR;
        PG8_STAGE(PG8_SB(1, 0), cB + kstep, voffB); PG8_STAGE(PG8_SA(1, 0), cA + kstep, voffA); PG8_STAGE(PG8_SB(1, 1), cB + hstep + kstep, voffB);
        PG8_WAIT_V(6); PG8_BAR;
    }
    for (;;) {
        const bool has_next = S.next(ui + 1, nxt);
        const char* nA = has_next ? (const char*)g.A + (size_t)nxt.pm * tstep : cA; const char* nB = has_next ? (const char*)g.Bt + (size_t)nxt.pn * tstep : cB;
        for (int t = 0; t < nt; t += 2) {
            const bool last = (t == nt - 2);
            const char* a1 = cA + (size_t)(t + 1) * kstep;
            const char* a2 = last ? nA : cA + (size_t)(t + 2) * kstep; const char* b2 = last ? nB : cB + (size_t)(t + 2) * kstep;
            const char* a3 = a2 + kstep; const char* b3 = b2 + kstep;
            if (last && has_next) S.a_ready(nxt);
            if constexpr (SP2) {
            PG8_LDB(B0, 0, 0); PG8_LDB(B1, 0, 1); PG8_SCHED; PG8_LDA(At, 0, 0); PG8_STAGE(PG8_SA(1, 1), a1 + hstep, voffA);
            PG8_WAIT_V(8); PG8_WAIT_L(0); PG8_BAR; PG8_MMA(0, 0, At, B0); PG8_MMA(0, 1, At, B1); PG8_BAR; PG8_SCHED;
            PG8_LDA(At, 0, 1); PG8_STAGE(PG8_SB(0, 0), b2, voffB); PG8_STAGE(PG8_SB(0, 1), b2 + hstep, voffB); PG8_STAGE(PG8_SA(0, 0), a2, voffA);
            PG8_WAIT_V(8); PG8_WAIT_L(0); PG8_BAR; PG8_MMA(1, 0, At, B0); PG8_MMA(1, 1, At, B1); PG8_BAR; PG8_SCHED;
            PG8_LDB(B0, 1, 0); PG8_LDB(B1, 1, 1); PG8_SCHED; PG8_LDA(At, 1, 0); PG8_STAGE(PG8_SA(0, 1), a2 + hstep, voffA);
            PG8_WAIT_V(8); PG8_WAIT_L(0); PG8_BAR; PG8_MMA(0, 0, At, B0); PG8_MMA(0, 1, At, B1); PG8_BAR; PG8_SCHED;
            PG8_LDA(At, 1, 1); PG8_STAGE(PG8_SB(1, 0), b3, voffB); PG8_STAGE(PG8_SB(1, 1), b3 + hstep, voffB); PG8_STAGE(PG8_SA(1, 0), a3, voffA);
            PG8_WAIT_V(8); PG8_WAIT_L(0); PG8_BAR; PG8_MMA(1, 0, At, B0); PG8_MMA(1, 1, At, B1); PG8_BAR; PG8_SCHED;
            } else {
            PG8_LDB(B0, 0, 0); PG8_SCHED; PG8_LDA(At, 0, 0); PG8_STAGE(PG8_SA(1, 1), a1 + hstep, voffA);
            PG8_WAIT_L(8); PG8_BAR; PG8_WAIT_L(0); PG8_MMA(0, 0, At, B0); PG8_BAR; PG8_SCHED;
            PG8_LDB(B1, 0, 1); PG8_STAGE(PG8_SB(0, 0), b2, voffB);
            PG8_BAR; PG8_WAIT_L(0); PG8_MMA(0, 1, At, B1); PG8_BAR;
            PG8_LDA(At, 0, 1); PG8_STAGE(PG8_SA(0, 0), a2, voffA);
            PG8_BAR; PG8_WAIT_L(0); PG8_MMA(1, 0, At, B0); PG8_BAR; PG8_SCHED;
            PG8_STAGE(PG8_SB(0, 1), b2 + hstep, voffB);
            PG8_WAIT_V(6); PG8_BAR; PG8_MMA(1, 1, At, B1); PG8_BAR;
            PG8_LDB(B0, 1, 0); PG8_SCHED; PG8_LDA(At, 1, 0); PG8_STAGE(PG8_SA(0, 1), a2 + hstep, voffA);
            PG8_WAIT_L(8); PG8_BAR; PG8_WAIT_L(0); PG8_MMA(0, 0, At, B0); PG8_BAR; PG8_SCHED;
            PG8_LDB(B1, 1, 1); PG8_STAGE(PG8_SB(1, 0), b3, voffB);
            PG8_BAR; PG8_WAIT_L(0); PG8_MMA(0, 1, At, B1); PG8_BAR;
            PG8_LDA(At, 1, 1); PG8_STAGE(PG8_SA(1, 0), a3, voffA);
            PG8_BAR; PG8_WAIT_L(0); PG8_MMA(1, 0, At, B0); PG8_BAR; PG8_SCHED;
            PG8_STAGE(PG8_SB(1, 1), b3 + hstep, voffB);
            PG8_WAIT_V(6); PG8_BAR; PG8_MMA(1, 1, At, B1); PG8_BAR;
            }
        }
        if constexpr (ALIGN_EPI) { if (wr == 0) PG8_BAR; }
        if constexpr (!Epi::AFTER_DRAIN) { E(acc, cur, wr, wc, fr, fq); S.done(cur); }
        if (!has_next) break;
#pragma unroll
        for (int a = 0; a < 2; ++a)
#pragma unroll
            for (int b = 0; b < 2; ++b)
#pragma unroll
                for (int m = 0; m < 4; ++m)
#pragma unroll
                    for (int n = 0; n < 2; ++n) acc[a][b][m][n] = (f32x4){0.f, 0.f, 0.f, 0.f};
        cur = nxt; cA = nA; cB = nB; ++ui;
        if constexpr (ALIGN_EPI) { if (wr == 1) PG8_BAR; }
    }
    PG8_WAIT_V(0);
    if constexpr (!ALIGN_EPI) { if (wr == 0) PG8_BAR; }
    PG8_BAR;
    if constexpr (Epi::AFTER_DRAIN) { E.fused(acc, cur, wr, wc, fr, fq, lds, wid, lane); S.done(cur); }
#undef PG8_SA
#undef PG8_SB
#undef PG8_STAGE
#undef PG8_LDA
#undef PG8_LDB
#undef PG8_MMA
#undef PG8_WAIT_V
#undef PG8_WAIT_L
#undef PG8_BAR
#undef PG8_SCHED
}
}

#ifndef PG8_SP2
#define PG8_SP2 true
#endif
#ifndef PG8_ALIGN
#define PG8_ALIGN true
#endif
#define XB_TMO      128
#define XB_XCNT(j)  (256  + 64 * (j))
#define XB_XSUB(j)  (1280 + 64 * (j))
#define XB_XGEN(j)  (2304 + 64 * (j))
#define XB_TOP      3328
#define XB_TOPGEN   3392
#define XCD_BAR_WORDS 3456
#define XB_SPIN_CAP (1u << 18)

__device__ __forceinline__ unsigned xb_ld(unsigned* p)              { return __hip_atomic_load(p, __ATOMIC_RELAXED, __HIP_MEMORY_SCOPE_AGENT); }
__device__ __forceinline__ unsigned xb_add(unsigned* p, unsigned v) { return __hip_atomic_fetch_add(p, v, __ATOMIC_RELAXED, __HIP_MEMORY_SCOPE_AGENT); }
__device__ __forceinline__ unsigned xb_xcc_id() { return (unsigned)__builtin_amdgcn_s_getreg((3 << 11) | 20) & 0xFu; }
#define XB_SPIN(cond, bar) do { unsigned _sp = 0; while (cond) { __builtin_amdgcn_s_sleep(1); \
    if ((++_sp & 255u) == 0u) { if (xb_ld(&(bar)[XB_TMO])) break; if (_sp > XB_SPIN_CAP) { atomicAdd(&(bar)[XB_TMO], 1u); break; } } } } while (0)

struct XcdBarrier {
    unsigned* bar; unsigned x;
    volatile LAS unsigned* st;
};

__device__ __forceinline__ XcdBarrier xcd_barrier_post(unsigned* bar, volatile LAS unsigned* st) {
    XcdBarrier b; b.bar = bar; b.x = xb_xcc_id(); b.st = st;
    if (threadIdx.x == 0) (void)xb_add(&bar[XB_XCNT(b.x)], 1u);
    return b;
}
__device__ __forceinline__ void xcd_barrier_complete(unsigned* bar, unsigned x, unsigned& nloc, unsigned& nx) {
    const unsigned G = gridDim.x * gridDim.y * gridDim.z;
    unsigned sum, cnt, mine, sp = 0u;
    for (;;) {
        sum = 0u; cnt = 0u; mine = 0u;
#pragma unroll
        for (unsigned j = 0; j < 16; ++j) { const unsigned c = xb_ld(&bar[XB_XCNT(j)]); sum += c; cnt += (c > 0u) ? 1u : 0u; mine = (j == x) ? c : mine; }
        if (sum == G) break;
        __builtin_amdgcn_s_sleep(1);
        if ((++sp & 255u) == 0u) { if (xb_ld(&bar[XB_TMO])) break; if (sp > XB_SPIN_CAP) { atomicAdd(&bar[XB_TMO], 1u); break; } }
    }
    nloc = mine > 0u ? mine : 1u; nx = cnt > 0u ? cnt : 1u;
}

__device__ __forceinline__ void xcd_barrier(const XcdBarrier& b) {
    asm volatile("s_waitcnt vmcnt(0)" ::: "memory");
    __syncthreads();
    if (threadIdx.x == 0) {
        unsigned* bar = b.bar;
        __builtin_amdgcn_s_waitcnt(0);
        unsigned nloc = b.st[0], nx = b.st[1];
        if (nloc == 0u) { xcd_barrier_complete(bar, b.x, nloc, nx); b.st[0] = nloc; b.st[1] = nx; }
        const unsigned old = xb_add(&bar[XB_XSUB(b.x)], 1u);
        const unsigned gen = old / nloc;
        if (old + 1u == (gen + 1u) * nloc) {
            __builtin_amdgcn_fence(__ATOMIC_RELEASE, "agent");
            asm volatile("s_waitcnt vmcnt(0)" ::: "memory");
            const unsigned og = xb_add(&bar[XB_TOP], 1u);
            const unsigned tg = og / nx;
            if (og + 1u == (tg + 1u) * nx) xb_add(&bar[XB_TOPGEN], 1u);
            else XB_SPIN(xb_ld(&bar[XB_TOPGEN]) == tg, bar);
            __builtin_amdgcn_fence(__ATOMIC_ACQUIRE, "agent");
            xb_add(&bar[XB_XGEN(b.x)], 1u);
            asm volatile("s_waitcnt vmcnt(0)" ::: "memory");
        } else {
            XB_SPIN(xb_ld(&bar[XB_XGEN(b.x)]) == gen, bar);
            __builtin_amdgcn_fence(__ATOMIC_ACQUIRE, "agent");
            asm volatile("s_waitcnt vmcnt(0)" ::: "memory");
        }
    }
    __syncthreads();
}

constexpr int SK_KS_O = 4, SK_KS_D = 11;
typedef short v4i16_t __attribute__((ext_vector_type(4)));
__device__ __forceinline__ s16x4 tr16(const LAS unsigned char* p) { return __builtin_bit_cast(s16x4, __builtin_amdgcn_ds_read_tr16_b64_v4i16((LAS v4i16_t*)p)); }
__device__ __forceinline__ bf16x8 cat8(s16x4 a, s16x4 b) { return (bf16x8){a[0], a[1], a[2], a[3], b[0], b[1], b[2], b[3]}; }
__device__ __forceinline__ int crow(int r, int hi) { return (r & 3) + 8 * (r >> 2) + 4 * hi; }
__device__ __forceinline__ f32x16 mfma32(bf16x8 a, bf16x8 b, f32x16 c) { return __builtin_amdgcn_mfma_f32_32x32x16_bf16(a, b, c, 0, 0, 0); }
__device__ __forceinline__ f32x4 mfma16(bf16x8 a, bf16x8 b, f32x4 c) { return __builtin_amdgcn_mfma_f32_16x16x32_bf16(a, b, c, 0, 0, 0); }
__device__ __forceinline__ v4u pack8(const float* v) { v4u w; w.x = cvtpk(v[0], v[1]); w.y = cvtpk(v[2], v[3]); w.z = cvtpk(v[4], v[5]); w.w = cvtpk(v[6], v[7]); return w; }
__device__ __forceinline__ void unpack8(v4u w, float* v) { v[0] = bflo(w.x); v[1] = bfhi(w.x); v[2] = bflo(w.y); v[3] = bfhi(w.y); v[4] = bflo(w.z); v[5] = bfhi(w.z); v[6] = bflo(w.w); v[7] = bfhi(w.w); }

__device__ __forceinline__ void p0_transpose_tile(const float* W, int K, int N, bf16* WT, int tile, int lane) {
    const int nblk = N >> 6, kb = tile / nblk, nb = tile - kb * nblk, nq = lane & 15, kq = lane >> 4;
    const float* src = W + (size_t)(64 * kb + 16 * kq) * N + 64 * nb + 4 * nq;
    f32x4 v[16];
#pragma unroll
    for (int i = 0; i < 16; ++i) v[i] = *(const f32x4*)(src + (size_t)i * N);
    bf16* dst = WT + (size_t)(64 * nb + 4 * nq) * K + 64 * kb + 16 * kq;
#pragma unroll
    for (int e = 0; e < 4; ++e) {
        v4u lo, hi;
        lo.x = cvtpk(v[0][e], v[1][e]); lo.y = cvtpk(v[2][e], v[3][e]); lo.z = cvtpk(v[4][e], v[5][e]); lo.w = cvtpk(v[6][e], v[7][e]);
        hi.x = cvtpk(v[8][e], v[9][e]); hi.y = cvtpk(v[10][e], v[11][e]); hi.z = cvtpk(v[12][e], v[13][e]); hi.w = cvtpk(v[14][e], v[15][e]);
        *(v4u*)(dst + (size_t)e * K) = lo; *(v4u*)(dst + (size_t)e * K + 8) = hi;
    }
}
__device__ __forceinline__ void p0_mod_item(LAS unsigned char* lds, const float* cp, const float* cs, const float* w_ada, const float* b_ada, float* MOD, int item, int tid, int lane, int wave) {
    const int n0 = 64 * item, nq = lane & 15, kg = lane >> 4;
    f32x4 acc[9][4];
#pragma unroll
    for (int rb = 0; rb < 9; ++rb)
#pragma unroll
        for (int e = 0; e < 4; ++e) acc[rb][e] = (f32x4){0.f, 0.f, 0.f, 0.f};
    for (int ks = 0; ks < 8; ++ks) {
        const int k0 = 256 * wave + 32 * ks + 8 * kg;
        f32x4 bv[8];
#pragma unroll
        for (int j = 0; j < 8; ++j) bv[j] = *(const f32x4*)(w_ada + (size_t)(k0 + j) * NMODC + n0 + 4 * nq);
        bf16x8 bfr[4];
#pragma unroll
        for (int e = 0; e < 4; ++e) { v4u w; w.x = cvtpk(bv[0][e], bv[1][e]); w.y = cvtpk(bv[2][e], bv[3][e]); w.z = cvtpk(bv[4][e], bv[5][e]); w.w = cvtpk(bv[6][e], bv[7][e]); bfr[e] = __builtin_bit_cast(bf16x8, w); }
#pragma unroll
        for (int rb = 0; rb < 9; ++rb) {
            const int r = 16 * rb + nq;
            v4u aw = (v4u){0u, 0u, 0u, 0u};
            if (r < NMODR) { const float* crow_ = (r < 2) ? cp + (size_t)r * DM : cs + (size_t)(r - 2) * DM;
                const f32x4 a0 = *(const f32x4*)(crow_ + k0), a1 = *(const f32x4*)(crow_ + k0 + 4);
                aw.x = cvtpk(silu_f(a0[0]), silu_f(a0[1])); aw.y = cvtpk(silu_f(a0[2]), silu_f(a0[3])); aw.z = cvtpk(silu_f(a1[0]), silu_f(a1[1])); aw.w = cvtpk(silu_f(a1[2]), silu_f(a1[3])); }
            const bf16x8 af = __builtin_bit_cast(bf16x8, aw);
#pragma unroll
            for (int e = 0; e < 4; ++e) acc[rb][e] = mfma16(af, bfr[e], acc[rb][e]);
        }
    }
    LAS float* RED = (LAS float*)lds;
    __syncthreads();
    for (int w = 0; w < 8; ++w) {
        if (wave == w) {
#pragma unroll
            for (int rb = 0; rb < 9; ++rb)
#pragma unroll
                for (int e = 0; e < 4; ++e)
#pragma unroll
                    for (int reg = 0; reg < 4; ++reg) { const int idx = (16 * rb + 4 * kg + reg) * 64 + 4 * nq + e; const float p = acc[rb][e][reg]; RED[idx] = (w == 0) ? p : RED[idx] + p; }
        }
        __syncthreads();
    }
    for (int idx = tid; idx < NMODR * 64; idx += 512) { const int r = idx >> 6, cc = idx & 63; MOD[(size_t)r * NMODC + n0 + cc] = RED[idx] + b_ada[n0 + cc]; }
    __syncthreads();
}

__device__ __forceinline__ int mod_row(int r) { return r < MPROMPT ? (r >> 13) : 2 + (r - MPROMPT); }

__device__ __forceinline__ void lds_fill_vec(LAS float* dst, const float* __restrict__ src, int tid) { *(LAS f32x4*)(dst + 4 * tid) = *(const f32x4*)(src + 4 * tid); }
__device__ __forceinline__ f32x4 ldsv(const LAS float* v, int lane, int j, int q) { return *(const LAS f32x4*)(v + 8 * lane + 512 * j + 4 * q); }
__device__ __forceinline__ void load_row_f32(f32x4 (&d)[4][2], const float* __restrict__ p) {
#pragma unroll
    for (int j = 0; j < 4; ++j) { d[j][0] = *(const f32x4*)(p + 512 * j); d[j][1] = *(const f32x4*)(p + 512 * j + 4); } }
__device__ __forceinline__ void load_row_bf16(v4u (&d)[4], const bf16* __restrict__ p) {
#pragma unroll
    for (int j = 0; j < 4; ++j) d[j] = *(const v4u*)(p + 512 * j); }
__device__ __forceinline__ void p1_rows(LAS unsigned char* lds, const float* __restrict__ xp, const float* __restrict__ xs, const float* __restrict__ gpre, const float* __restrict__ MOD, bf16* __restrict__ H, int gw, int NGW, int tid, int lane) {
    LAS float* G = (LAS float*)lds; LAS float* SH = G + 2048; LAS float* SC = SH + 4096;
    lds_fill_vec(G, gpre, tid); lds_fill_vec(SH, MOD, tid); lds_fill_vec(SH + 2048, MOD + NMODC, tid); lds_fill_vec(SC, MOD + DM, tid); lds_fill_vec(SC + 2048, MOD + NMODC + DM, tid);
    __syncthreads();
    f32x4 nx[4][2];
    if (gw < MPROMPT) load_row_f32(nx, xp + (size_t)gw * DM + 8 * lane);
    for (int r = gw; r < MPROMPT; r += NGW) {
        f32x4 v[4][2];
#pragma unroll
        for (int j = 0; j < 4; ++j) { v[j][0] = nx[j][0]; v[j][1] = nx[j][1]; }
        if (r + NGW < MPROMPT) load_row_f32(nx, xp + (size_t)(r + NGW) * DM + 8 * lane);
        const int b = r >> 13; float ss = 0.f;
#pragma unroll
        for (int j = 0; j < 4; ++j)
#pragma unroll
            for (int i = 0; i < 4; ++i) ss += v[j][0][i] * v[j][0][i] + v[j][1][i] * v[j][1][i];
        const float rstd = rsqrtf(wave_sum(ss) * (1.0f / DM) + EPS);
        bf16* hrow = H + (size_t)r * DM + 8 * lane;
#pragma unroll
        for (int j = 0; j < 4; ++j) { float o[8];
#pragma unroll
            for (int q = 0; q < 2; ++q) { const f32x4 g = ldsv(G, lane, j, q), sh = ldsv(SH + 2048 * b, lane, j, q), sc = ldsv(SC + 2048 * b, lane, j, q);
#pragma unroll
                for (int i = 0; i < 4; ++i) o[4 * q + i] = v[j][q][i] * rstd * g[i] * (1.0f + sc[i]) + sh[i]; }
            *(v4u*)(hrow + 512 * j) = pack8(o); }
    }
    for (int r = MPROMPT + gw; r < MPAD; r += NGW) {
        bf16* hrow = H + (size_t)r * DM + 8 * lane;
        if (r >= MTOK) {
#pragma unroll
            for (int j = 0; j < 4; ++j) *(v4u*)(hrow + 512 * j) = (v4u){0u, 0u, 0u, 0u};
            continue; }
        f32x4 v[4][2]; load_row_f32(v, xs + (size_t)(r - MPROMPT) * DM + 8 * lane);
        const float* mr = MOD + (size_t)mod_row(r) * NMODC + 8 * lane; float ss = 0.f;
#pragma unroll
        for (int j = 0; j < 4; ++j)
#pragma unroll
            for (int i = 0; i < 4; ++i) ss += v[j][0][i] * v[j][0][i] + v[j][1][i] * v[j][1][i];
        const float rstd = rsqrtf(wave_sum(ss) * (1.0f / DM) + EPS);
#pragma unroll
        for (int j = 0; j < 4; ++j) { float o[8];
#pragma unroll
            for (int q = 0; q < 2; ++q) { const f32x4 g = ldsv(G, lane, j, q), sh = *(const f32x4*)(mr + 512 * j + 4 * q), sc = *(const f32x4*)(mr + DM + 512 * j + 4 * q);
#pragma unroll
                for (int i = 0; i < 4; ++i) o[4 * q + i] = v[j][q][i] * rstd * g[i] * (1.0f + sc[i]) + sh[i]; }
            *(v4u*)(hrow + 512 * j) = pack8(o); }
    }
    __syncthreads();
}
template <bool LDSMOD>
__device__ __forceinline__ void p5_finish(const float (&ov)[4][8], const f32x4 (&xv)[4][2], const LAS float* GP, const LAS float* GPRE, const LAS float* GT, const LAS float* SHF, const LAS float* SCF,
                                          const float* __restrict__ mr, float* __restrict__ x1r, bf16* __restrict__ hrow, int lane) {
    float ss = 0.f;
#pragma unroll
    for (int j = 0; j < 4; ++j)
#pragma unroll
        for (int i = 0; i < 8; ++i) ss += ov[j][i] * ov[j][i];
    const float rstd_o = rsqrtf(wave_sum(ss) * (1.0f / DM) + EPS);
    float x1[4][8]; float s1 = 0.f;
#pragma unroll
    for (int j = 0; j < 4; ++j)
#pragma unroll
        for (int q = 0; q < 2; ++q) { const f32x4 gp = ldsv(GP, lane, j, q), gt = LDSMOD ? ldsv(GT, lane, j, q) : *(const f32x4*)(mr + 2 * DM + 512 * j + 4 * q); f32x4 y;
#pragma unroll
            for (int i = 0; i < 4; ++i) { y[i] = xv[j][q][i] + gt[i] * (ov[j][4 * q + i] * rstd_o * gp[i]); x1[j][4 * q + i] = y[i]; s1 += y[i] * y[i]; }
            *(f32x4*)(x1r + 512 * j + 4 * q) = y; }
    const float rstd_1 = rsqrtf(wave_sum(s1) * (1.0f / DM) + EPS);
#pragma unroll
    for (int j = 0; j < 4; ++j) { float o[8];
#pragma unroll
        for (int q = 0; q < 2; ++q) { const f32x4 g = ldsv(GPRE, lane, j, q), sh = LDSMOD ? ldsv(SHF, lane, j, q) : *(const f32x4*)(mr + 3 * DM + 512 * j + 4 * q), sc = LDSMOD ? ldsv(SCF, lane, j, q) : *(const f32x4*)(mr + 4 * DM + 512 * j + 4 * q);
#pragma unroll
            for (int i = 0; i < 4; ++i) o[4 * q + i] = x1[j][4 * q + i] * rstd_1 * g[i] * (1.0f + sc[i]) + sh[i]; }
        *(v4u*)(hrow + 512 * j) = pack8(o); }
}
__device__ __forceinline__ void p5_rows(LAS unsigned char* lds, const float* __restrict__ xp, const float* __restrict__ xs, const bf16* __restrict__ O, const float* __restrict__ OS  ,
                                        const float* __restrict__ gpost, const float* __restrict__ gpre, const float* __restrict__ MOD, float* __restrict__ out, bf16* __restrict__ H2, int gw, int NGW, int tid, int lane) {
    LAS float* GP = (LAS float*)lds; LAS float* GPRE = GP + 2048; LAS float* GT = GPRE + 2048; LAS float* SHF = GT + 4096; LAS float* SCF = SHF + 4096;
    lds_fill_vec(GP, gpost, tid); lds_fill_vec(GPRE, gpre, tid);
#pragma unroll
    for (int b = 0; b < 2; ++b) { lds_fill_vec(GT + 2048 * b, MOD + b * NMODC + 2 * DM, tid); lds_fill_vec(SHF + 2048 * b, MOD + b * NMODC + 3 * DM, tid); lds_fill_vec(SCF + 2048 * b, MOD + b * NMODC + 4 * DM, tid); }
    __syncthreads();
    v4u no[4]; f32x4 nx[4][2];
    if (gw < MPROMPT) { load_row_bf16(no, O + (size_t)gw * DM + 8 * lane); load_row_f32(nx, xp + (size_t)gw * DM + 8 * lane); }
    for (int r = gw; r < MPROMPT; r += NGW) {
        float ov[4][8]; f32x4 xv[4][2];
#pragma unroll
        for (int j = 0; j < 4; ++j) { unpack8(no[j], ov[j]); xv[j][0] = nx[j][0]; xv[j][1] = nx[j][1]; }
        if (r + NGW < MPROMPT) { load_row_bf16(no, O + (size_t)(r + NGW) * DM + 8 * lane); load_row_f32(nx, xp + (size_t)(r + NGW) * DM + 8 * lane); }
        const int b = r >> 13;
        p5_finish<true>(ov, xv, GP, GPRE, GT + 2048 * b, SHF + 2048 * b, SCF + 2048 * b, nullptr, out + O_YP + (size_t)r * DM + 8 * lane, H2 + (size_t)r * DM + 8 * lane, lane);
    }
    for (int r = MPROMPT + gw; r < MPAD; r += NGW) {
        bf16* hrow = H2 + (size_t)r * DM + 8 * lane;
        if (r >= MTOK) {
#pragma unroll
            for (int j = 0; j < 4; ++j) *(v4u*)(hrow + 512 * j) = (v4u){0u, 0u, 0u, 0u};
            continue; }
        const int sr_ = r - MPROMPT; const float* sr = OS + (size_t)sr_ * DM + 8 * lane;
        float ov[4][8]; f32x4 xv[4][2]; load_row_f32(xv, xs + (size_t)sr_ * DM + 8 * lane);
#pragma unroll
        for (int j = 0; j < 4; ++j)
#pragma unroll
            for (int q = 0; q < 2; ++q) { f32x4 a = *(const f32x4*)(sr + 512 * j + 4 * q);
#pragma unroll
                for (int s = 1; s < SK_KS_O; ++s) a += *(const f32x4*)(sr + (size_t)s * NSAMP * DM + 512 * j + 4 * q);
#pragma unroll
                for (int i = 0; i < 4; ++i) ov[j][4 * q + i] = a[i]; }
        p5_finish<false>(ov, xv, GP, GPRE, nullptr, nullptr, nullptr, MOD + (size_t)mod_row(r) * NMODC + 8 * lane, out + O_YS + (size_t)sr_ * DM + 8 * lane, hrow, lane);
    }
    __syncthreads();
}
template <bool LDSMOD>
__device__ __forceinline__ void p9_finish(const float (&yv)[4][8], const f32x4 (&xv)[4][2], const LAS float* GP, const LAS float* GT, const float* __restrict__ mr, float* __restrict__ x1r, int lane) {
    float ss = 0.f;
#pragma unroll
    for (int j = 0; j < 4; ++j)
#pragma unroll
        for (int i = 0; i < 8; ++i) ss += yv[j][i] * yv[j][i];
    const float rstd = rsqrtf(wave_sum(ss) * (1.0f / DM) + EPS);
#pragma unroll
    for (int j = 0; j < 4; ++j)
#pragma unroll
        for (int q = 0; q < 2; ++q) { const f32x4 gp = ldsv(GP, lane, j, q), gt = LDSMOD ? ldsv(GT, lane, j, q) : *(const f32x4*)(mr + 5 * DM + 512 * j + 4 * q); f32x4 y;
#pragma unroll
            for (int i = 0; i < 4; ++i) y[i] = xv[j][q][i] + gt[i] * (yv[j][4 * q + i] * rstd * gp[i]);
            *(f32x4*)(x1r + 512 * j + 4 * q) = y; }
}
__device__ __forceinline__ void p9_rows(LAS unsigned char* lds, const bf16* __restrict__ YF, const float* __restrict__ YS  , const float* __restrict__ gpost, const float* __restrict__ MOD, float* out, int gw, int NGW, int tid, int lane) {
    LAS float* GP = (LAS float*)lds; LAS float* GT = GP + 2048;
    lds_fill_vec(GP, gpost, tid); lds_fill_vec(GT, MOD + 5 * DM, tid); lds_fill_vec(GT + 2048, MOD + NMODC + 5 * DM, tid);
    __syncthreads();
    v4u ny[4]; f32x4 nx[4][2];
    if (gw < MPROMPT) { load_row_bf16(ny, YF + (size_t)gw * DM + 8 * lane); load_row_f32(nx, out + O_YP + (size_t)gw * DM + 8 * lane); }
    for (int r = gw; r < MPROMPT; r += NGW) {
        float yv[4][8]; f32x4 xv[4][2];
#pragma unroll
        for (int j = 0; j < 4; ++j) { unpack8(ny[j], yv[j]); xv[j][0] = nx[j][0]; xv[j][1] = nx[j][1]; }
        if (r + NGW < MPROMPT) { load_row_bf16(ny, YF + (size_t)(r + NGW) * DM + 8 * lane); load_row_f32(nx, out + O_YP + (size_t)(r + NGW) * DM + 8 * lane); }
        p9_finish<true>(yv, xv, GP, GT + 2048 * (r >> 13), nullptr, out + O_YP + (size_t)r * DM + 8 * lane, lane);
    }
    for (int r = MPROMPT + gw; r < MTOK; r += NGW) {
        const int sr_ = r - MPROMPT; const float* sr = YS + (size_t)sr_ * DM + 8 * lane; float* x1r = out + O_YS + (size_t)sr_ * DM + 8 * lane;
        float yv[4][8]; f32x4 xv[4][2]; load_row_f32(xv, x1r);
#pragma unroll
        for (int j = 0; j < 4; ++j)
#pragma unroll
            for (int q = 0; q < 2; ++q) { f32x4 a = *(const f32x4*)(sr + 512 * j + 4 * q);
                for (int s = 1; s < SK_KS_D; ++s) a += *(const f32x4*)(sr + (size_t)s * NSAMP * DM + 512 * j + 4 * q);
#pragma unroll
                for (int i = 0; i < 4; ++i) yv[j][4 * q + i] = a[i]; }
        p9_finish<false>(yv, xv, GP, nullptr, MOD + (size_t)mod_row(r) * NMODC + 8 * lane, x1r, lane);
    }
}
__device__ __forceinline__ void p7_prompt(const bf16* A, bf16* U, const float* conv_w, const float* conv_b, int gw, int NGW, int lane) {
    for (int it = gw; it < 11 * (MPROMPT / 32); it += NGW) {
        const int rr = it / 11, cg = it - rr * 11, r0 = 32 * rr, c0 = 512 * cg + 8 * lane;
        float w0[8], w1[8], w2[8], bb[8], am2[8], am1[8];
#pragma unroll
        for (int q = 0; q < 2; ++q) { const f32x4 a = *(const f32x4*)(conv_w + c0 + 4 * q), b = *(const f32x4*)(conv_w + DFF + c0 + 4 * q), c = *(const f32x4*)(conv_w + 2 * DFF + c0 + 4 * q), d = *(const f32x4*)(conv_b + c0 + 4 * q);
#pragma unroll
            for (int i = 0; i < 4; ++i) { w0[4 * q + i] = a[i]; w1[4 * q + i] = b[i]; w2[4 * q + i] = c[i]; bb[4 * q + i] = d[i]; } }
        if ((r0 & (SEQ - 1)) == 0) {
#pragma unroll
            for (int i = 0; i < 8; ++i) { am2[i] = 0.f; am1[i] = 0.f; }
        } else { unpack8(*(const v4u*)(A + (size_t)(r0 - 2) * DFF + c0), am2); unpack8(*(const v4u*)(A + (size_t)(r0 - 1) * DFF + c0), am1); }
#pragma unroll 4
        for (int r = r0; r < r0 + 32; ++r) {
            float a[8], u[8], o[8];
            unpack8(*(const v4u*)(A + (size_t)r * DFF + c0), a); unpack8(*(const v4u*)(U + (size_t)r * DFF + c0), u);
#pragma unroll
            for (int i = 0; i < 8; ++i) { const float cv = bb[i] + w0[i] * am2[i] + w1[i] * am1[i] + w2[i] * a[i]; o[i] = gelu_f(cv) * u[i]; am2[i] = am1[i]; am1[i] = a[i]; }
            *(v4u*)(U + (size_t)r * DFF + c0) = pack8(o);
        }
    }
}
__device__ __forceinline__ void p7_sample(const bf16* A, bf16* U, const float* state, const float* conv_w, const float* conv_b, float* out, int gtid, int NGT) {
    for (int it = gtid; it < NSAMP * (DFF / 8); it += NGT) {
        const int sb = it / (DFF / 8), c0 = 8 * (it - sb * (DFF / 8)); const size_t row = (size_t)(MPROMPT + sb) * DFF + c0;
        float a[8], u[8], o[8];
        unpack8(*(const v4u*)(A + row), a); unpack8(*(const v4u*)(U + row), u);
#pragma unroll
        for (int q = 0; q < 2; ++q) { const f32x4 w0 = *(const f32x4*)(conv_w + c0 + 4 * q), w1 = *(const f32x4*)(conv_w + DFF + c0 + 4 * q), w2 = *(const f32x4*)(conv_w + 2 * DFF + c0 + 4 * q), bb = *(const f32x4*)(conv_b + c0 + 4 * q);
            const f32x4 s0 = *(const f32x4*)(state + (size_t)(sb * 2 + 0) * DFF + c0 + 4 * q), s1 = *(const f32x4*)(state + (size_t)(sb * 2 + 1) * DFF + c0 + 4 * q);
#pragma unroll
            for (int i = 0; i < 4; ++i) { const float cv = bb[i] + w0[i] * s0[i] + w1[i] * s1[i] + w2[i] * a[4 * q + i]; o[4 * q + i] = gelu_f(cv) * u[4 * q + i]; }
            *(f32x4*)(out + O_CS + (size_t)(sb * 2 + 0) * DFF + c0 + 4 * q) = s1; }
        *(v4u*)(U + row) = pack8(o);
    }
}

constexpr int SK_ROWB = 528, SK_BUF = 64 * SK_ROWB;
template <class Epi>
__device__ __forceinline__ void skinny_phase(LAS unsigned char* lds, const bf16* __restrict__ As, const bf16* __restrict__ Bt, int N, int K, int KS, const Epi& E, int it0, int stride, int tid_, int lane_, int wave) {
    const int ncb = N >> 6, nitems = ncb * 2 * KS, nchunks = (K / KS) >> 8;
    for (int it = it0; it < nitems; it += stride) {
        int tid = tid_, lane = lane_; asm volatile("" : "+v"(tid), "+v"(lane));
        const int sl = it / (ncb * 2), r2 = it - sl * (ncb * 2), cb = r2 >> 1, rh = r2 & 1, n0 = cb * 64 + 16 * (wave & 3), kbeg = sl * (K / KS);
        const bf16* Ap = As + (size_t)(64 * rh + (tid >> 5)) * K + kbeg + 8 * (tid & 31);
        const bf16* Bp = Bt + (size_t)(n0 + (lane & 15)) * K + kbeg + 8 * (lane >> 4);
        LAS unsigned char* wdst = lds + (tid >> 5) * SK_ROWB + (tid & 31) * 16;
        const LAS unsigned char* rsrc = lds + (32 * (wave >> 2) + (lane & 15)) * SK_ROWB + (lane >> 4) * 16;
        f32x4 acc[2];
#pragma unroll
        for (int rb = 0; rb < 2; ++rb) acc[rb] = (f32x4){0.f, 0.f, 0.f, 0.f};
        v4u areg[4]; bf16x8 bnext[8];
#pragma unroll
        for (int i = 0; i < 4; ++i) areg[i] = *(const v4u*)(Ap + (size_t)(16 * i) * K);
#pragma unroll
        for (int ks = 0; ks < 8; ++ks) bnext[ks] = *(const bf16x8*)(Bp + 32 * ks);
        __syncthreads();
#pragma unroll
        for (int i = 0; i < 4; ++i) *(LAS v4u*)(wdst + 16 * i * SK_ROWB) = areg[i];
        for (int kc = 0; kc < nchunks; ++kc) {
            __syncthreads();
            bf16x8 bcur[8];
#pragma unroll
            for (int ks = 0; ks < 8; ++ks) bcur[ks] = bnext[ks];
            const bool more = kc + 1 < nchunks;
            if (more) {
#pragma unroll
                for (int i = 0; i < 4; ++i) areg[i] = *(const v4u*)(Ap + (size_t)(16 * i) * K + 256 * (kc + 1));
#pragma unroll
                for (int ks = 0; ks < 8; ++ks) bnext[ks] = *(const bf16x8*)(Bp + 256 * (kc + 1) + 32 * ks);
            }
            const LAS unsigned char* rb_ = rsrc + (kc & 1) * SK_BUF;
#pragma unroll
            for (int ks = 0; ks < 8; ++ks)
#pragma unroll
                for (int rb = 0; rb < 2; ++rb) { const bf16x8 af = *(const LAS bf16x8*)(rb_ + rb * 16 * SK_ROWB + ks * 64); acc[rb] = mfma16(bcur[ks], af, acc[rb]); }
            if (more) {
                LAS unsigned char* wd = wdst + ((kc + 1) & 1) * SK_BUF;
#pragma unroll
                for (int i = 0; i < 4; ++i) *(LAS v4u*)(wd + 16 * i * SK_ROWB) = areg[i];
            }
        }
#pragma unroll
        for (int rb = 0; rb < 2; ++rb) E.small(64 * rh + 32 * (wave >> 2) + 16 * rb + (lane & 15), n0 + 4 * (lane >> 4), acc[rb], sl);
    }
}
__device__ __forceinline__ void skinny_share(int nwg, int G, int c, int& it0, int& stride) { const int rem = nwg % G; if (rem == 0) { it0 = c; stride = G; } else if (c >= rem) { it0 = c - rem; stride = G - rem; } else { it0 = 1 << 30; stride = 1; } }
constexpr int MX_K = 0, MX_V = 32768, MX_VN = 65536, MX_STG = 98304, MX_TAB = 131072, MX_PART = MX_TAB + 1536, MX_END = MX_PART + 4096;
static_assert(MX_END <= MISC_OFF, "mixer LDS");
__device__ __forceinline__ void mixer_prompt_item(LAS unsigned char* lds, const bf16* __restrict__ Z, const f32x2* __restrict__ STAT, const bf16* __restrict__ TRIL, bf16* __restrict__ MERGED,
                                                  const float* __restrict__ sinks, const float* __restrict__ rel_bias, const float* __restrict__ lng, const float* __restrict__ lnb, const float* __restrict__ b_s,
                                                  int item, int tid, int lane, int wave) {
    asm volatile("" : "+v"(tid), "+v"(lane));
    const int g = item & 15, n = (item >> 4) & 63, b = item >> 10, kvh = g >> 2, R0 = b * SEQ + n * 128;
    LAS unsigned char* Kt = lds + MX_K; LAS unsigned char* Vt = lds + MX_V; LAS unsigned char* VNt = lds + MX_VN; LAS unsigned char* STG = lds + MX_STG + wave * 4096;
    LAS float* TAB = (LAS float*)(lds + MX_TAB); LAS f32x2* PART = (LAS f32x2*)(lds + MX_PART);
    const int hh = wave & 1, qb = wave >> 1, head = 2 * g + hh, ql = lane & 31, hi = lane >> 5;
    f32x2 st[8];
#pragma unroll
    for (int p = 0; p < 8; ++p) st[p] = STAT[(size_t)(8 * (tid >> 7) + p) * MPAD + R0 + (tid & 127)];
    v4u kreg[4], vreg[4], greg[4];
#pragma unroll
    for (int i = 0; i < 4; ++i) {
        const int q = tid + 512 * i, j = q >> 3, c = q & 7;
        if (n > 0 || j >= 128) { const bf16* src = Z + (size_t)(R0 - 128 + j) * DIN + 64 * kvh + 8 * c; kreg[i] = *(const v4u*)(src + CK); vreg[i] = *(const v4u*)(src + CV); }
    }
#pragma unroll
    for (int i = 0; i < 4; ++i) { const int q = tid + 512 * i, j = q >> 4, c = q & 15; greg[i] = *(const v4u*)(Z + (size_t)(R0 + j) * DIN + CG + 128 * g + 8 * c); }
    bf16x8 qf[4];
    { const bf16* qp = Z + (size_t)(R0 + 32 * qb + ql) * DIN + CQ + 64 * head + 8 * hi;
#pragma unroll
      for (int d0 = 0; d0 < 4; ++d0) qf[d0] = *(const bf16x8*)(qp + 16 * d0); }
    const float sk = sinks[head] * LOG2E;
    __syncthreads();
    { float s1 = 0.f, s2 = 0.f;
#pragma unroll
      for (int p = 0; p < 8; ++p) { s1 += st[p].x; s2 += st[p].y; }
      PART[tid] = (f32x2){s1, s2}; }
    if (tid < 384) {
        const int th = tid / 192, idx = tid - th * 192, dist = idx - 32;
        TAB[tid] = (dist >= 0 && dist <= 128) ? rel_bias[t5_bucket(dist) * 32 + 2 * g + th] * LOG2E : -1e30f;
    }
#pragma unroll
    for (int i = 0; i < 4; ++i) {
        const int q = tid + 512 * i, j = q >> 3, c = q & 7;
        if (n > 0 || j >= 128) {
            *(LAS v4u*)(Kt + j * 128 + ((c ^ ((j >> 1) & 7)) << 4)) = kreg[i];
            *(LAS v4u*)(Vt + (j >> 4) * 2048 + (c >> 2) * 1024 + ((j >> 3) & 1) * 512 + (j & 7) * 64 + (c & 3) * 16) = vreg[i];
        }
    }
    const int nsteps = 2 * (qb + 1);
    bf16x8 wf[8];
    { const bf16* wp = TRIL + ((size_t)g * 128 + 32 * qb + ql) * 128 + 8 * hi;
#pragma unroll
      for (int s = 0; s < 8; ++s) if (s < nsteps) wf[s] = *(const bf16x8*)(wp + 16 * s); }
    __syncthreads();
#pragma unroll
    for (int i = 0; i < 4; ++i) {
        const int q = tid + 512 * i, j = q >> 4, c = q & 15, ch = 128 * g + 8 * c;
        float v[8]; unpack8(greg[i], v);
        const f32x2 pa_ = PART[j], pb_ = PART[128 + j], pc_ = PART[256 + j], pd_ = PART[384 + j];
        const float mean = ((pa_.x + pb_.x) + (pc_.x + pd_.x)) * (1.0f / DM), var = ((pa_.y + pb_.y) + (pc_.y + pd_.y)) * (1.0f / DM) - mean * mean, rstd = rsqrtf(fmaxf(var, 0.f) + EPS);
#pragma unroll
        for (int qq = 0; qq < 2; ++qq) { const f32x4 gg = *(const f32x4*)(lng + ch + 4 * qq), bb = *(const f32x4*)(lnb + ch + 4 * qq);
#pragma unroll
            for (int k = 0; k < 4; ++k) v[4 * qq + k] = (v[4 * qq + k] - mean) * rstd * gg[k] + bb[k]; }
        *(LAS v4u*)(VNt + (j >> 4) * 4096 + (c >> 2) * 1024 + ((j >> 3) & 1) * 512 + (j & 7) * 64 + (c & 3) * 16) = pack8(v);
    }
    __syncthreads();
    const int tmin = (n == 0) ? (4 - qb) : 0;
    f32x16 p[5];
    int tboff = (hh * 192 + ql - 4 * hi + 5) * 4, kboff = (32 * qb + ql) * 128, swz = (ql >> 1) & 7;
    asm volatile("" : "+v"(tboff), "+v"(kboff), "+v"(swz));
    const LAS float* tb = (const LAS float*)((const LAS unsigned char*)TAB + tboff);
    const LAS unsigned char* kb0 = Kt + kboff;
#pragma unroll
    for (int t = 0; t < 5; ++t) {
        if (t >= tmin) {
            f32x16 acc = {};
#pragma unroll
            for (int d0 = 0; d0 < 4; ++d0) { const bf16x8 kf = *(const LAS bf16x8*)(kb0 + t * 4096 + (((2 * d0 + hi) ^ swz) << 4)); acc = mfma32(kf, qf[d0], acc); }
#pragma unroll
            for (int r = 0; r < 16; ++r) acc[r] += tb[155 - 32 * t - (r & 3) - 8 * (r >> 2)];
            p[t] = acc;
        } else {
#pragma unroll
            for (int r = 0; r < 16; ++r) p[t][r] = -1e30f;
        }
    }
    float m = -1e30f;
#pragma unroll
    for (int t = 0; t < 5; ++t)
#pragma unroll
        for (int r = 0; r < 16; ++r) m = fmaxf(m, p[t][r]);
    m = fmaxf(m, __shfl_xor(m, 32));
    m = fmaxf(m, sk);
    float sum = 0.f;
#pragma unroll
    for (int t = 0; t < 5; ++t)
#pragma unroll
        for (int r = 0; r < 16; ++r) { p[t][r] = fast_exp2(p[t][r] - m); sum += p[t][r]; }
    sum += __shfl_xor(sum, 32);
    const float inv = 1.0f / (sum + fast_exp2(sk - m));
    v4u mga[4], mgb[4], mu[4]; float bsv[4];
#pragma unroll
    for (int i = 0; i < 4; ++i) { const bf16* zr = Z + (size_t)(R0 + 32 * qb + 8 * i + (lane >> 3)) * DIN + 128 * g + 64 * hh + 8 * (lane & 7);
        mga[i] = *(const v4u*)(zr + CGA); mgb[i] = *(const v4u*)(zr + CGB); mu[i] = *(const v4u*)(zr + CU); bsv[i] = b_s[g * 128 + 32 * qb + 8 * i + (lane >> 3)]; }
    f32x16 o[2] = {{}, {}}, sg[2] = {{}, {}};
    int vlane = (4 * hi + ((lane & 15) >> 2)) * 64 + ((lane >> 4) & 1) * 32 + (lane & 3) * 8 + 2 * qb * 2048;
    asm volatile("" : "+v"(vlane));
#pragma unroll
    for (int t = 0; t < 5; ++t) {
        if (t >= tmin) {
#pragma unroll
            for (int s = 0; s < 2; ++s) {
                v4u pw; pw.x = cvtpk(p[t][8 * s + 0] * inv, p[t][8 * s + 1] * inv); pw.y = cvtpk(p[t][8 * s + 2] * inv, p[t][8 * s + 3] * inv);
                pw.z = cvtpk(p[t][8 * s + 4] * inv, p[t][8 * s + 5] * inv); pw.w = cvtpk(p[t][8 * s + 6] * inv, p[t][8 * s + 7] * inv);
                const bf16x8 pa = __builtin_bit_cast(bf16x8, pw);
                const LAS unsigned char* vp = Vt + (2 * t + s) * 2048 + vlane;
#pragma unroll
                for (int dh = 0; dh < 2; ++dh) { const bf16x8 vf = cat8(tr16(vp + dh * 1024), tr16(vp + dh * 1024 + 512)); o[dh] = mfma32(pa, vf, o[dh]); }
            }
        }
    }
    { int nlane = hi * 512 + ((lane & 15) >> 2) * 64 + ((lane >> 4) & 1) * 32 + (lane & 3) * 8 + (2 * hh) * 1024;
      asm volatile("" : "+v"(nlane));
#pragma unroll
      for (int s = 0; s < 8; ++s) {
          if (s < nsteps) {
              const LAS unsigned char* np = VNt + s * 4096 + nlane;
#pragma unroll
              for (int dh = 0; dh < 2; ++dh) { const bf16x8 vf = cat8(tr16(np + dh * 1024), tr16(np + dh * 1024 + 256)); sg[dh] = mfma32(wf[s], vf, sg[dh]); }
          }
      } }
    v4u t1[4], t2[4];
    int swoff = (4 * hi) * 128 + ql * 2, sroff = (lane >> 3) * 128 + (lane & 7) * 16;
    asm volatile("" : "+v"(swoff), "+v"(sroff));
    LAS unsigned char* stw = STG + swoff; const LAS unsigned char* str_ = STG + sroff;
#pragma unroll
    for (int dh = 0; dh < 2; ++dh)
#pragma unroll
        for (int r = 0; r < 16; ++r) *(LAS bf16*)(stw + ((r & 3) + 8 * (r >> 2)) * 128 + 64 * dh) = (bf16)(cvtpk(o[dh][r], 0.f) & 0xffffu);
    LDS_WAIT();
#pragma unroll
    for (int i = 0; i < 4; ++i) t1[i] = *(const LAS v4u*)(str_ + i * 1024);
    LDS_WAIT();
#pragma unroll
    for (int dh = 0; dh < 2; ++dh)
#pragma unroll
        for (int r = 0; r < 16; ++r) *(LAS bf16*)(stw + ((r & 3) + 8 * (r >> 2)) * 128 + 64 * dh) = (bf16)(cvtpk(sg[dh][r], 0.f) & 0xffffu);
    LDS_WAIT();
#pragma unroll
    for (int i = 0; i < 4; ++i) t2[i] = *(const LAS v4u*)(str_ + i * 1024);
    LDS_WAIT();
#pragma unroll
    for (int i = 0; i < 4; ++i) {
        const size_t grow = (size_t)(R0 + 32 * qb + 8 * i + (lane >> 3)); const int ch = 128 * g + 64 * hh + 8 * (lane & 7);
        float a[8], s[8], ga[8], gb[8], u[8], o8[8];
        unpack8(t1[i], a); unpack8(t2[i], s); unpack8(mga[i], ga); unpack8(mgb[i], gb); unpack8(mu[i], u);
#pragma unroll
        for (int k = 0; k < 8; ++k) o8[k] = ga[k] * a[k] + gb[k] * (u[k] * (s[k] + bsv[i]));
        *(v4u*)(MERGED + grow * DM + ch) = pack8(o8);
    }
}
constexpr int SM_K = 0, SM_V = 33792, SM_Q = SM_V + 129 * 64 * 4, SM_S = SM_Q + 2048, SM_R = SM_S + 8 * 132 * 4, SM_END = SM_R + 64;
static_assert(SM_K + 129 * 65 * 4 <= SM_V && SM_END <= RING_BYTES, "sample mixer LDS");
__device__ __forceinline__ void mixer_sample_item(LAS unsigned char* lds, const bf16* __restrict__ Z, bf16* __restrict__ MERGED, const float* __restrict__ cache_k, const float* __restrict__ cache_v,
                                                  const float* __restrict__ sinks, const float* __restrict__ rel_bias, const float* __restrict__ lng, const float* __restrict__ lnb,
                                                  const float* __restrict__ w_s, const float* __restrict__ b_s, float* __restrict__ out, int item, int tid, int lane, int wave) {
    asm volatile("" : "+v"(tid), "+v"(lane));
    const int kvh = item & 3, sb = item >> 2; const size_t zrow = (size_t)(MPROMPT + sb) * DIN;
    LAS float* KS = (LAS float*)(lds + SM_K); LAS float* VS = (LAS float*)(lds + SM_V); LAS float* QS = (LAS float*)(lds + SM_Q); LAS float* SC = (LAS float*)(lds + SM_S); LAS float* RED = (LAS float*)(lds + SM_R);
    const int head = 8 * kvh + wave, ch = 64 * head + lane, grp = ch >> 7;
    float kc[16], vc[16];
#pragma unroll
    for (int i = 0; i < 16; ++i) { const size_t ci = ((size_t)(sb * 128 + 8 * i + wave) * 4 + kvh) * 64 + lane; kc[i] = cache_k[ci]; vc[i] = cache_v[ci]; }
    const float knew = bf1(Z[zrow + CK + 64 * kvh + lane]), vnew = bf1(Z[zrow + CV + 64 * kvh + lane]);
    const float qv = bf1(Z[zrow + CQ + 64 * head + lane]);
    const v2u gvw = *(const v2u*)(Z + zrow + CG + 4 * tid);
    const float gvc = bf1(Z[zrow + CG + ch]), uc = bf1(Z[zrow + CU + ch]), gac = bf1(Z[zrow + CGA + ch]), gbc = bf1(Z[zrow + CGB + ch]);
    const float lg = lng[ch], lb = lnb[ch], ws0 = w_s[(size_t)grp * 128 * 128], bs0 = b_s[grp * 128], sk = sinks[head] * LOG2E;
    __syncthreads();
#pragma unroll
    for (int i = 0; i < 16; ++i) { const int j = 8 * i + wave; KS[j * 65 + lane] = kc[i]; VS[j * 64 + lane] = vc[i];
        if (j >= 1) { const size_t co = ((size_t)(sb * 128 + j - 1) * 4 + kvh) * 64 + lane; out[O_KS + co] = kc[i]; out[O_VS + co] = vc[i]; } }
    if (wave == 0) { KS[128 * 65 + lane] = knew; VS[128 * 64 + lane] = vnew; }
    QS[tid] = qv;
    { const float g0 = bflo(gvw.x), g1 = bfhi(gvw.x), g2 = bflo(gvw.y), g3 = bfhi(gvw.y);
      const float a = wave_sum((g0 + g1) + (g2 + g3)), q = wave_sum((g0 * g0 + g1 * g1) + (g2 * g2 + g3 * g3));
      if (lane == 0) { RED[wave] = a; RED[8 + wave] = q; } }
    __syncthreads();
    for (int e = tid; e < 8 * 129; e += 512) {
        const int h8 = e / 129, j = e - 129 * h8; float dot = 0.f;
#pragma unroll 16
        for (int d = 0; d < 64; ++d) dot += QS[h8 * 64 + d] * KS[j * 65 + d];
        SC[h8 * 132 + j] = dot + rel_bias[t5_bucket(128 - j) * 32 + 8 * kvh + h8] * LOG2E;
    }
    __syncthreads();
    { const float s0 = SC[wave * 132 + lane], s1 = SC[wave * 132 + 64 + lane], s2 = (lane == 0) ? SC[wave * 132 + 128] : -1e30f;
      const float m = fmaxf(wave_max(fmaxf(fmaxf(s0, s1), s2)), sk);
      const float e0 = fast_exp2(s0 - m), e1 = fast_exp2(s1 - m), e2 = fast_exp2(s2 - m);
      const float inv = 1.0f / (wave_sum(e0 + e1 + e2) + fast_exp2(sk - m));
      SC[wave * 132 + lane] = e0 * inv; SC[wave * 132 + 64 + lane] = e1 * inv; if (lane == 0) SC[wave * 132 + 128] = e2 * inv; }
    LDS_WAIT();
    float ya = 0.f;
#pragma unroll 3
    for (int j = 0; j < 129; ++j) ya += SC[wave * 132 + j] * VS[j * 64 + lane];
    float s1 = 0.f, s2 = 0.f;
#pragma unroll
    for (int w = 0; w < 8; ++w) { s1 += RED[w]; s2 += RED[8 + w]; }
    const float mean = s1 * (1.0f / DM), var = s2 * (1.0f / DM) - mean * mean, rstd = rsqrtf(fmaxf(var, 0.f) + EPS);
    const float vn = (gvc - mean) * rstd * lg + lb;
    out[O_SG + (size_t)sb * DM + ch] = vn;
    const float mg = gac * ya + gbc * (uc * (ws0 * vn + bs0));
    MERGED[(size_t)(MPROMPT + sb) * DM + ch] = (bf16)(cvtpk(mg, 0.f) & 0xffffu);
}
constexpr int NWAVES = 8, G_NOM = 256;
constexpr int CW_BAR = 4096;
static_assert((CW_BAR + XCD_BAR_WORDS) * 4 <= (int)CTL_ZERO_BYTES, "control words inside the memset region");
constexpr int N_PHASES = 10;
struct Args { const float* in[26]; float* out; unsigned char* ws; int ph_lo, ph_hi; };

__global__ void __launch_bounds__(NWAVES * 64, 2) fwd_kernel(Args args) {
    extern __shared__ __attribute__((aligned(16))) unsigned char lds_raw[];
    LAS unsigned char* lds = (LAS unsigned char*)lds_raw;
    volatile LAS unsigned* MISC = (volatile LAS unsigned*)(lds + MISC_OFF);
    const int tid = threadIdx.x, lane = tid & 63, wave = __builtin_amdgcn_readfirstlane(tid >> 6);
    const int G = gridDim.x, bx = blockIdx.x, vcu = (G % 8 == 0) ? (bx % 8) * (G / 8) + bx / 8 : bx;
    const int gw = vcu * NWAVES + wave, NGW = G * NWAVES;
    unsigned char* ws = args.ws; float* out = args.out;
    gu32* ctl = (gu32*)(ws + WS_CTL);
    float* MOD = (float*)(ws + WS_MOD); f32x2* STAT = (f32x2*)(ws + WS_STAT); bf16* TRIL = (bf16*)(ws + WS_TRIL);
    bf16* WO_T = (bf16*)(ws + WS_WO); bf16* WGU_T = (bf16*)(ws + WS_WGU); bf16* WD_T = (bf16*)(ws + WS_WD); bf16* WIN_T = (bf16*)(ws + WS_WIN);
    bf16* Zb = (bf16*)(ws + WS_Z); bf16* Ob = (bf16*)(ws + WS_O); bf16* ABUF = (bf16*)(ws + WS_ABUF); bf16* UBUF = (bf16*)(ws + WS_UBUF); bf16* H2 = (bf16*)(ws + WS_H2); bf16* YF = (bf16*)(ws + WS_YF);
    float* SLAB = (float*)(ws + WS_SLAB);
    bf16* Hb = (bf16*)out;
    for (int u = tid; u < 32; u += NWAVES * 64) MISC[u] = 0u;
    __syncthreads();
    const int lo = args.ph_lo, hi = args.ph_hi;
    const bool one_launch = (hi - lo) > 1;
    XcdBarrier bar; bar.bar = (unsigned*)(ctl + CW_BAR); bar.x = 0; bar.st = nullptr;
    if (one_launch) bar = xcd_barrier_post((unsigned*)(ctl + CW_BAR), MISC + 8);
#define IN(k) (lo <= (k) && (k) < hi)
#ifndef PROBE_PHASE
#define PROBE_PHASE -1
#endif
    unsigned long long pt0 = 0ull, pt1 = 0ull;
#define SEAM(k) do { if (IN(k) && IN((k) + 1)) xcd_barrier(bar); if (PROBE_PHASE == (k) + 1) pt0 = __builtin_amdgcn_s_memrealtime(); if (PROBE_PHASE == (k)) pt1 = __builtin_amdgcn_s_memrealtime(); } while (0)
    if (PROBE_PHASE == 0) pt0 = __builtin_amdgcn_s_memrealtime();

    if (IN(0)) {
        if (bx < NMODC / 64) p0_mod_item(lds, args.in[2], args.in[3], args.in[7], args.in[8], MOD, bx, tid, lane, wave);
        constexpr int T_IN = 32 * 168, T_O = 32 * 32, T_G = 32 * 88, T_D = 88 * 32, T_ALL = T_IN + T_O + 2 * T_G + T_D;
        constexpr int NMB = NMODC / 64, T_HEAD = (G_NOM - NMB) * NWAVES * 2;
        const bool head_ok = (G > NMB);
        for (int pass = 0; pass < 2; ++pass) {
            int it, step, end;
            if (pass == 0) { if (!head_ok || bx < NMB) continue; it = (bx - NMB) * NWAVES + wave; step = (G - NMB) * NWAVES; end = T_HEAD; }
            else { it = (head_ok ? T_HEAD : 0) + gw; step = NGW; end = T_ALL; }
            for (; it < end; it += step) {
                int r = it;
                if (r < T_IN) { p0_transpose_tile(args.in[13], DM, DIN, WIN_T, r, lane); continue; } r -= T_IN;
                if (r < T_O) { p0_transpose_tile(args.in[14], DM, DM, WO_T, r, lane); continue; } r -= T_O;
                if (r < T_G) { p0_transpose_tile(args.in[22], DM, DFF, WGU_T, r, lane); continue; } r -= T_G;
                if (r < T_G) { p0_transpose_tile(args.in[21], DM, DFF, WGU_T + (size_t)DFF * DM, r, lane); continue; } r -= T_G;
                p0_transpose_tile(args.in[25], DFF, DM, WD_T, r, lane);
            }
        }
        { const float* w_s = args.in[19];
          for (int it = vcu * 512 + tid; it < 16 * 128 * 128 / 8; it += G * 512) { const int e0 = 8 * it, j0 = e0 & 127, i = (e0 >> 7) & 127;
              const f32x4 a = *(const f32x4*)(w_s + e0), b = *(const f32x4*)(w_s + e0 + 4); float v[8];
#pragma unroll
              for (int k = 0; k < 4; ++k) { v[k] = (j0 + k <= i) ? a[k] : 0.f; v[4 + k] = (j0 + 4 + k <= i) ? b[k] : 0.f; }
              *(v4u*)(TRIL + e0) = pack8(v); } }
    }
    SEAM(0);
    if (IN(1)) p1_rows(lds, args.in[0], args.in[1], args.in[9], MOD, Hb, gw, NGW, tid, lane);
    SEAM(1);
    if (IN(2)) {
        pg8::Gemm g{Hb, WIN_T, MPROMPT, DIN, DM}; pg8::StaticOrder S; S.init(MPROMPT, DIN, G, bx);
        pg8::EpiZ E{Zb, out, STAT};
        pg8::gemm_phase<pg8::EpiZ, pg8::StaticOrder, PG8_ALIGN, PG8_SP2>(lds, g, S, E);
        int it0, stride; skinny_share(S.nwg, G, bx, it0, stride);
        skinny_phase(lds, Hb + (size_t)MPROMPT * DM, WIN_T, DIN, DM, 1, E, it0, stride, tid, lane, wave);
    }
    SEAM(2);
    if (IN(3)) {
        for (int it = vcu; it < 2048; it += G) mixer_prompt_item(lds, Zb, STAT, TRIL, Hb, args.in[15], args.in[16], args.in[17], args.in[18], args.in[20], it, tid, lane, wave);
        for (int it = vcu; it < 512; it += G) mixer_sample_item(lds, Zb, Hb, args.in[4], args.in[5], args.in[15], args.in[16], args.in[17], args.in[18], args.in[19], args.in[20], out, it, tid, lane, wave);
    }
    SEAM(3);
    if (IN(4)) {
        pg8::Gemm g{Hb, WO_T, MPROMPT, DM, DM}; pg8::StaticOrder S; S.init(MPROMPT, DM, G, bx);
        pg8::EpiPlain E{Ob, DM, SLAB};
        pg8::gemm_phase<pg8::EpiPlain, pg8::StaticOrder, PG8_ALIGN, PG8_SP2>(lds, g, S, E);
        int it0, stride; skinny_share(S.nwg, G, bx, it0, stride);
        skinny_phase(lds, Hb + (size_t)MPROMPT * DM, WO_T, DM, DM, SK_KS_O, E, it0, stride, tid, lane, wave);
    }
    SEAM(4);
    if (IN(5)) p5_rows(lds, args.in[0], args.in[1], Ob, SLAB, args.in[10], args.in[11], MOD, out, H2, gw, NGW, tid, lane);
    SEAM(5);
    if (IN(6)) {
        pg8::Gemm g{H2, WGU_T, MPROMPT, 2 * DFF, DM}; pg8::StaticOrder S; S.init(MPROMPT, 2 * DFF, G, bx);
        pg8::EpiGU E{ABUF, UBUF, out};
        pg8::gemm_phase<pg8::EpiGU, pg8::StaticOrder, PG8_ALIGN, PG8_SP2>(lds, g, S, E);
        int it0, stride; skinny_share(S.nwg, G, bx, it0, stride);
        skinny_phase(lds, H2 + (size_t)MPROMPT * DM, WGU_T, 2 * DFF, DM, 1, E, it0, stride, tid, lane, wave);
    }
    SEAM(6);
    if (IN(7)) {
        p7_prompt(ABUF, UBUF, args.in[23], args.in[24], gw, NGW, lane);
        p7_sample(ABUF, UBUF, args.in[6], args.in[23], args.in[24], out, vcu * 512 + tid, G * 512);
    }
    SEAM(7);
    if (IN(8)) {
        pg8::Gemm g{UBUF, WD_T, MPROMPT, DM, DFF}; pg8::StaticOrder S; S.init(MPROMPT, DM, G, bx);
        pg8::EpiPlain E{YF, DM, SLAB};
        pg8::gemm_phase<pg8::EpiPlain, pg8::StaticOrder, PG8_ALIGN, PG8_SP2>(lds, g, S, E);
        int it0, stride; skinny_share(S.nwg, G, bx, it0, stride);
        skinny_phase(lds, UBUF + (size_t)MPROMPT * DFF, WD_T, DM, DFF, SK_KS_D, E, it0, stride, tid, lane, wave);
    }
    SEAM(8);
    if (IN(9)) p9_rows(lds, YF, SLAB, args.in[12], MOD, out, gw, NGW, tid, lane);
    if (PROBE_PHASE >= 0) { if (PROBE_PHASE == 9) pt1 = __builtin_amdgcn_s_memrealtime();
        if (bx == 0 && tid == 0) { const unsigned long long te = __builtin_amdgcn_s_memrealtime(), dl = 4ull * (pt1 - pt0); while (__builtin_amdgcn_s_memrealtime() - te < dl) __builtin_amdgcn_s_sleep(32); } }
#undef IN
#undef SEAM
}

#ifndef MK_ONE_LAUNCH
#define MK_ONE_LAUNCH 1
#endif
extern "C" void kernel_launch(void* const* d_in, const int* in_sizes, int n_in, void* d_out, int out_size, void* d_ws, size_t ws_size, hipStream_t stream) {
    static int grid = 0;
    if (grid == 0) {
        if (n_in != 26 || in_sizes[0] != MPROMPT * DM || out_size != (int)O_END || ws_size < WS_END) {
            fprintf(stderr, "kernel_launch: unexpected problem shape (n_in %d, in0 %d, out %d, ws %zu); nothing launched\n", n_in, n_in > 0 ? in_sizes[0] : -1, out_size, ws_size); grid = -1; return; }
        int dev = 0, cus = 0, per_cu = 0;
        if (hipGetDevice(&dev) != hipSuccess || hipDeviceGetAttribute(&cus, hipDeviceAttributeMultiprocessorCount, dev) != hipSuccess) { grid = -1; return; }
        if (hipFuncSetAttribute((const void*)fwd_kernel, hipFuncAttributeMaxDynamicSharedMemorySize, LDS_BYTES) != hipSuccess) { fprintf(stderr, "kernel_launch: hipFuncSetAttribute failed\n"); grid = -1; return; }
        if (hipOccupancyMaxActiveBlocksPerMultiprocessor(&per_cu, (const void*)fwd_kernel, NWAVES * 64, LDS_BYTES) != hipSuccess || per_cu < 1) { fprintf(stderr, "kernel_launch: occupancy query says %d blocks per CU; nothing launched\n", per_cu); (void)hipGetLastError(); grid = -1; return; }
        grid = cus;
    }
    if (grid < 0) return;
    if (hipMemsetAsync((char*)d_ws + WS_CTL, 0, CTL_ZERO_BYTES, stream) != hipSuccess) return;
    Args a{};
    for (int i = 0; i < 26; ++i) a.in[i] = (const float*)d_in[i];
    a.out = (float*)d_out; a.ws = (unsigned char*)d_ws;
#if MK_ONE_LAUNCH
    a.ph_lo = 0; a.ph_hi = N_PHASES;
    void* kargs[] = {&a};
    hipError_t e = hipLaunchCooperativeKernel((const void*)fwd_kernel, dim3(grid), dim3(NWAVES * 64), kargs, LDS_BYTES, stream);
    if (e != hipSuccess) fprintf(stderr, "kernel_launch: cooperative launch failed: %s (grid %d)\n", hipGetErrorString(e), grid);
#else
    for (int p = 0; p < N_PHASES; ++p) { a.ph_lo = p; a.ph_hi = p + 1; hipLaunchKernelGGL(fwd_kernel, dim3(grid), dim3(NWAVES * 64), LDS_BYTES, stream, a); }
#endif
}
```

```cpp
#include <hip/hip_runtime.h>
#include <cstdio>
#include <cstdint>

constexpr int DM = 2048, SEQ = 8192, NBATCH = 2, MPROMPT = NBATCH * SEQ, NSAMP = 128, MTOK = MPROMPT + NSAMP, MPAD = 16640;
constexpr int DIN = 10752, DFF = 5632, NMODC = 12288, NMODR = 130;
constexpr int CQ = 0, CK = 2048, CV = 2304, CU = 2560, CG = 4608, CGA = 6656, CGB = 8704;
constexpr float EPS = 1e-6f, LOG2E = 1.4426950408889634f, QSCALE = 0.125f * 1.4426950408889634f;
constexpr size_t O_YP = 0, O_YS = 33554432, O_KP = 33816576, O_VP = 33882112, O_CP = 33947648, O_KS = 33970176, O_VS = 38164480, O_CS = 42358784, O_SG = 43800576, O_END = 44062720;

constexpr size_t KiB = 1024, MiB = 1u << 20;
constexpr size_t WS_CTL = 0, CTL_ZERO_BYTES = 64 * KiB;
constexpr size_t WS_MOD = 1 * MiB;
constexpr size_t WS_STAT = WS_MOD + 6656 * KiB;
constexpr size_t WS_TRIL = WS_STAT + 4352 * KiB;
constexpr size_t WS_WO = WS_TRIL + 512 * KiB;
constexpr size_t WS_WGU = WS_WO + 8 * MiB;
constexpr size_t WS_WD = WS_WGU + 44 * MiB;
constexpr size_t WS_ARENA = WS_WD + 22 * MiB;
constexpr size_t WS_WIN = WS_ARENA;
constexpr size_t WS_Z = WS_ARENA + 42 * MiB;
constexpr size_t WS_O = WS_ARENA;
constexpr size_t WS_ABUF = WS_ARENA;
constexpr size_t WS_UBUF = WS_ABUF + (size_t)MPAD * DFF * 2;
constexpr size_t WS_H2 = WS_UBUF + (size_t)MPAD * DFF * 2;
constexpr size_t WS_YF = WS_ABUF;
constexpr size_t WS_SLAB = WS_ARENA + 128 * MiB;
constexpr size_t WS_SLABGU = WS_STAT;
constexpr size_t WS_END = WS_H2 + (size_t)MPAD * DM * 2;
static_assert(WS_MOD + (size_t)NMODR * NMODC * 4 <= WS_STAT && WS_STAT + (size_t)32 * MPAD * 8 <= WS_TRIL, "ws map");
static_assert(WS_Z + (size_t)MPAD * DIN * 2 <= 512 * MiB && WS_END <= 512 * MiB, "ws map exceeds 512 MiB");
static_assert(WS_SLABGU + (size_t)4 * NSAMP * 2 * DFF * 2 <= WS_WGU && WS_SLAB + (size_t)22 * NSAMP * DM * 4 <= WS_UBUF, "slab regions");

constexpr int RING_BYTES = 131072;
constexpr int MISC_OFF = 143360;
constexpr int LDS_BYTES = 147456;

#define GAS __attribute__((address_space(1)))
#define LAS __attribute__((address_space(3)))
typedef unsigned short bf16;
typedef unsigned v4u __attribute__((ext_vector_type(4)));
typedef unsigned v2u __attribute__((ext_vector_type(2)));
typedef float f32x2 __attribute__((ext_vector_type(2)));
typedef float f32x4 __attribute__((ext_vector_type(4)));
typedef float f32x16 __attribute__((ext_vector_type(16)));
typedef short bf16x8 __attribute__((ext_vector_type(8)));
typedef short s16x4 __attribute__((ext_vector_type(4)));
typedef __bf16 bf16x2_t __attribute__((ext_vector_type(2)));
typedef GAS unsigned gu32;
#define RLX_AGENT __ATOMIC_RELAXED, __HIP_MEMORY_SCOPE_AGENT
#define LDS_WAIT() asm volatile("s_waitcnt lgkmcnt(0)" ::: "memory")
#define VM_WAIT() asm volatile("s_waitcnt vmcnt(0)" ::: "memory")

__device__ __forceinline__ unsigned cvtpk(float lo, float hi) { f32x2 v = {lo, hi}; bf16x2_t b = __builtin_convertvector(v, bf16x2_t); return __builtin_bit_cast(unsigned, b); }
__device__ __forceinline__ float bflo(unsigned w) { return __uint_as_float(w << 16); }
__device__ __forceinline__ float bfhi(unsigned w) { return __uint_as_float(w & 0xffff0000u); }
__device__ __forceinline__ float bf1(bf16 b) { return __uint_as_float((unsigned)b << 16); }
__device__ __forceinline__ float fast_rcp(float x) { return __builtin_amdgcn_rcpf(x); }
__device__ __forceinline__ float fast_exp2(float x) { return __builtin_amdgcn_exp2f(x); }
__device__ __forceinline__ float sigmoid_f(float x) { return fast_rcp(1.0f + fast_exp2(-LOG2E * x)); }
__device__ __forceinline__ float gelu_f(float x) { const float u = x * (0.7978845608028654f + 0.035677408136300125f * x * x); return x * fast_rcp(1.0f + fast_exp2(-2.0f * LOG2E * u)); }
__device__ __forceinline__ float silu_f(float x) { return x * sigmoid_f(x); }
__device__ __forceinline__ float wave_sum(float v) {
#pragma unroll
    for (int o = 1; o < 64; o <<= 1) v += __shfl_xor(v, o);
    return v;
}
__device__ __forceinline__ float wave_max(float v) {
#pragma unroll
    for (int o = 1; o < 64; o <<= 1) v = fmaxf(v, __shfl_xor(v, o));
    return v;
}
__device__ __forceinline__ int t5_bucket(int d) {
    if (d < 16) return d;
    int b = 16;
    b += d >= 19; b += d >= 21; b += d >= 24; b += d >= 27; b += d >= 31; b += d >= 35; b += d >= 40; b += d >= 46; b += d >= 52; b += d >= 59; b += d >= 67; b += d >= 77; b += d >= 87; b += d >= 99; b += d >= 113;
    return b;
}
namespace pg8 {
#define PG8_LAS __attribute__((address_space(3)))
typedef unsigned short bf16_t;
typedef short bf16x8 __attribute__((ext_vector_type(8)));
typedef float f32x4 __attribute__((ext_vector_type(4)));
typedef unsigned u32x4 __attribute__((ext_vector_type(4)));
constexpr int BM = 256, BK = 64, HALF = 128, HTB = HALF * BK * 2  , STAGE_BYTES = 8 * HTB, NXCD = 8, WGM = 8;

__host__ __device__ __forceinline__ int lds_byte(int r, int c) { const int st = (r >> 4) * 2 + (c >> 5), rr = r & 15, cc = c & 31, ob = rr * 64 + cc * 2; return st * 1024 + (ob ^ (((ob >> 9) & 1) << 5)); }
__host__ __device__ __forceinline__ void stage_rc(int b, int& R, int& C) { const int st = b / 1024, sb = b % 1024, swz = sb ^ (((sb >> 9) & 1) << 5); R = (st >> 1) * 16 + swz / 64; C = (st & 1) * 32 + (swz % 64) / 2; }
__host__ __device__ __forceinline__ int perm32(int rho) { const int n = rho >> 4, i = rho & 15; return 8 * (i >> 2) + 4 * n + (i & 3); }

struct Unit { int pm, pn, kt0, nt, sl; };
struct Gemm { const bf16_t* A; const bf16_t* Bt; int M, N, K; };

struct StaticOrder {
    int nM, nN, nwg, G, c;
    __host__ __device__ void init(int M, int N, int G_, int c_) { nM = M / BM; nN = N / BM; nwg = nM * nN; G = G_; c = c_; }
    __host__ __device__ bool next(int i, Unit& u) const {
        const long L = (long)i * G + c; if (L >= nwg) return false;
        int wgid = (int)L; { const int q = nwg / NXCD, r = nwg % NXCD, xcd = wgid % NXCD, off = wgid / NXCD; wgid = (xcd < r ? xcd * (q + 1) : r * (q + 1) + (xcd - r) * q) + off; }
        const int nig = WGM * nN, gid = wgid / nig, fm = gid * WGM, gsz = (nM - fm) < WGM ? (nM - fm) : WGM;
        u.pm = fm + ((wgid % nig) % gsz); u.pn = (wgid % nig) / gsz; return true;
    }
    __device__ __forceinline__ void a_ready(const Unit&) const {}
    __device__ __forceinline__ void done(const Unit&) const {}
};
struct SplitOrder {
    int nM, nN, nwg, G, c, KT, KS;
    __host__ __device__ void init(int M, int N, int K, int KS_, int G_, int c_) { nM = M / BM; nN = N / BM; nwg = nM * nN; G = G_; c = c_; KT = K / BK; KS = KS_; }
    __host__ __device__ bool next(int i, Unit& u) const {
        const long L = (long)i * G + c; const bool mainu = L < nwg; const long Ls = L - nwg; const bool samp = !mainu && Ls < (long)nN * KS;
        int wgid = mainu ? (int)L : 0; { const int q = nwg / NXCD, r = nwg % NXCD, xcd = wgid % NXCD, off = wgid / NXCD; wgid = (xcd < r ? xcd * (q + 1) : r * (q + 1) + (xcd - r) * q) + off; }
        const int nig = WGM * nN, gid = wgid / nig, fm = gid * WGM, gsz = (nM - fm) < WGM ? (nM - fm) : WGM;
        const int pm_main = fm + ((wgid % nig) % gsz), pn_main = (wgid % nig) / gsz;
        const int idx = samp ? (int)Ls : 0, ks = idx / nN, ntS = KT / KS;
        u.pm = mainu ? pm_main : nM; u.pn = mainu ? pn_main : idx - ks * nN; u.nt = mainu ? KT : ntS; u.kt0 = mainu ? 0 : ks * ntS; u.sl = (mainu || KS == 1) ? -1 : ks;
        return mainu || samp;
    }
    __device__ __forceinline__ void a_ready(const Unit&) const {}
    __device__ __forceinline__ void done(const Unit&) const {}
};

__device__ __forceinline__ void store8(bf16_t* p, const f32x4 v0, const f32x4 v1) {
    u32x4 w; w.x = cvtpk(v0[0], v0[1]); w.y = cvtpk(v0[2], v0[3]); w.z = cvtpk(v1[0], v1[1]); w.w = cvtpk(v1[2], v1[3]); *(u32x4*)p = w;
}
__device__ __forceinline__ void store4(bf16_t* p, const f32x4 v) { v2u w; w.x = cvtpk(v[0], v[1]); w.y = cvtpk(v[2], v[3]); *(v2u*)p = w; }
struct EpiPlain {
    static constexpr bool PERM = true, AFTER_DRAIN = false;
    bf16_t* O; int ldc;
    float* slab;
    __device__ __forceinline__ void small(int srow, int col, const f32x4 v, int sl) const { *(f32x4*)(slab + ((size_t)sl * NSAMP + srow) * ldc + col) = v; }
    __device__ __forceinline__ void operator()(const f32x4 (&acc)[2][2][4][2], const Unit& u, int wr, int wc, int fr, int fq) const {
        const int row0 = u.pm * BM + wr * 64 + fr, col0 = u.pn * BM + wc * 32 + 8 * fq;
        if (u.sl >= 0) {
#pragma unroll
            for (int m = 0; m < 4; ++m) { float* rowp = slab + ((size_t)u.sl * NSAMP + wr * 64 + m * 16 + fr) * ldc + col0;
#pragma unroll
                for (int bj = 0; bj < 2; ++bj) { *(f32x4*)(rowp + bj * HALF) = acc[0][bj][m][0]; *(f32x4*)(rowp + bj * HALF + 4) = acc[0][bj][m][1]; } }
            return; }
#pragma unroll
        for (int ai = 0; ai < 2; ++ai)
#pragma unroll
            for (int m = 0; m < 4; ++m) { bf16_t* rowp = O + (size_t)(row0 + ai * HALF + m * 16) * ldc + col0;
#pragma unroll
                for (int bj = 0; bj < 2; ++bj) store8(rowp + bj * HALF, acc[ai][bj][m][0], acc[ai][bj][m][1]); }
    }
};
struct EpiZ {
    static constexpr bool PERM = true, AFTER_DRAIN = false;
    bf16_t* Z; float* out; f32x2* stat;
    __device__ __forceinline__ void small(int srow, int col, f32x4 v, int) const {
        if (col < CK) v = v * QSCALE;
        else if (col < CU) { float* d = out + (col < CV ? O_KS + (size_t)(srow * 128 + 127) * 256 + (col - CK) : O_VS + (size_t)(srow * 128 + 127) * 256 + (col - CV)); *(f32x4*)d = v; }
        else if (col < CGA) {
#pragma unroll
            for (int i = 0; i < 4; ++i) v[i] = gelu_f(v[i]);
        } else {
#pragma unroll
            for (int i = 0; i < 4; ++i) v[i] = sigmoid_f(v[i]);
        }
        store4(Z + (size_t)(MPROMPT + srow) * DIN + col, v);
    }
    __device__ __forceinline__ void operator()(const f32x4 (&acc)[2][2][4][2], const Unit& u, int wr, int wc, int fr, int fq) const {
        const int pn = u.pn, row0 = u.pm * BM + wr * 64 + fr, cw = wc * 32 + 8 * fq, col0 = pn * BM + cw;
        if (pn < 8) {
#pragma unroll
            for (int ai = 0; ai < 2; ++ai)
#pragma unroll
                for (int m = 0; m < 4; ++m) { bf16_t* rowp = Z + (size_t)(row0 + ai * HALF + m * 16) * DIN + col0;
#pragma unroll
                    for (int bj = 0; bj < 2; ++bj) store8(rowp + bj * HALF, acc[ai][bj][m][0] * QSCALE, acc[ai][bj][m][1] * QSCALE); }
        } else if (pn < 10) {
            const size_t o_p = (pn == 8) ? O_KP : O_VP, o_s = (pn == 8) ? O_KS : O_VS;
#pragma unroll
            for (int ai = 0; ai < 2; ++ai)
#pragma unroll
                for (int m = 0; m < 4; ++m) { const int lr = wr * 64 + m * 16 + fr; bf16_t* rowp = Z + (size_t)(row0 + ai * HALF + m * 16) * DIN + col0;
#pragma unroll
                    for (int bj = 0; bj < 2; ++bj) { const f32x4 v0 = acc[ai][bj][m][0], v1 = acc[ai][bj][m][1]; store8(rowp + bj * HALF, v0, v1);
                        if (ai == 1 && (u.pm == 31 || u.pm == 63)) { float* d = out + o_p + (size_t)((u.pm >> 5) * 128 + lr) * 256 + cw + bj * HALF; *(f32x4*)d = v0; *(f32x4*)(d + 4) = v1; }
                        if (ai == 0 && u.pm == 64) { float* d = out + o_s + (size_t)(lr * 128 + 127) * 256 + cw + bj * HALF; *(f32x4*)d = v0; *(f32x4*)(d + 4) = v1; } } }
        } else if (pn < 26) {
#pragma unroll
            for (int ai = 0; ai < 2; ++ai)
#pragma unroll
                for (int m = 0; m < 4; ++m) { const int row = row0 + ai * HALF + m * 16; bf16_t* rowp = Z + (size_t)row * DIN + col0; float s1 = 0.f, s2 = 0.f;
#pragma unroll
                    for (int bj = 0; bj < 2; ++bj) { f32x4 v0 = acc[ai][bj][m][0], v1 = acc[ai][bj][m][1];
#pragma unroll
                        for (int i = 0; i < 4; ++i) { v0[i] = gelu_f(v0[i]); v1[i] = gelu_f(v1[i]); s1 += v0[i] + v1[i]; s2 += v0[i] * v0[i] + v1[i] * v1[i]; }
                        store8(rowp + bj * HALF, v0, v1); }
                    if (pn >= 18) { s1 += __shfl_xor(s1, 16); s1 += __shfl_xor(s1, 32); s2 += __shfl_xor(s2, 16); s2 += __shfl_xor(s2, 32);
                        if (fq == 0) stat[(size_t)((pn - 18) * 4 + wc) * MPAD + row] = (f32x2){s1, s2}; } }
        } else {
#pragma unroll
            for (int ai = 0; ai < 2; ++ai)
#pragma unroll
                for (int m = 0; m < 4; ++m) { bf16_t* rowp = Z + (size_t)(row0 + ai * HALF + m * 16) * DIN + col0;
#pragma unroll
                    for (int bj = 0; bj < 2; ++bj) { f32x4 v0 = acc[ai][bj][m][0], v1 = acc[ai][bj][m][1];
#pragma unroll
                        for (int i = 0; i < 4; ++i) { v0[i] = sigmoid_f(v0[i]); v1[i] = sigmoid_f(v1[i]); }
                        store8(rowp + bj * HALF, v0, v1); } }
        }
    }
};
struct EpiGU {
    static constexpr bool PERM = true, AFTER_DRAIN = false;
    bf16_t* A; bf16_t* U; float* out; bf16_t* slab;
    __device__ __forceinline__ void small(int srow, int col, const f32x4 v, int) const {
        if (col < DFF) { *(f32x4*)(out + O_CS + (size_t)(srow * 2 + 1) * DFF + col) = v; store4(A + (size_t)(MPROMPT + srow) * DFF + col, v); }
        else store4(U + (size_t)(MPROMPT + srow) * DFF + (col - DFF), v);
    }
    __device__ __forceinline__ void operator()(const f32x4 (&acc)[2][2][4][2], const Unit& u, int wr, int wc, int fr, int fq) const {
        if (u.sl >= 0) {
#pragma unroll
            for (int m = 0; m < 4; ++m) { bf16_t* rowp = slab + ((size_t)u.sl * NSAMP + wr * 64 + m * 16 + fr) * (2 * DFF) + u.pn * BM + wc * 32 + 8 * fq;
#pragma unroll
                for (int bj = 0; bj < 2; ++bj) store8(rowp + bj * HALF, acc[0][bj][m][0], acc[0][bj][m][1]); }
            return; }
        const bool isa = u.pn < 22; const int row0 = u.pm * BM + wr * 64 + fr, col0 = (isa ? u.pn : u.pn - 22) * BM + wc * 32 + 8 * fq; bf16_t* base = isa ? A : U;
#pragma unroll
        for (int ai = 0; ai < 2; ++ai)
#pragma unroll
            for (int m = 0; m < 4; ++m) { const int lr = wr * 64 + m * 16 + fr; bf16_t* rowp = base + (size_t)(row0 + ai * HALF + m * 16) * DFF + col0;
#pragma unroll
                for (int bj = 0; bj < 2; ++bj) { const f32x4 v0 = acc[ai][bj][m][0], v1 = acc[ai][bj][m][1]; store8(rowp + bj * HALF, v0, v1);
                    if (isa && ai == 1 && lr >= 126 && (u.pm == 31 || u.pm == 63)) { float* d = out + O_CP + (size_t)((u.pm >> 5) * 2 + (lr - 126)) * DFF + col0 + bj * HALF; *(f32x4*)d = v0; *(f32x4*)(d + 4) = v1; }
                    if (isa && ai == 0 && u.pm == 64) { float* d = out + O_CS + (size_t)(lr * 2 + 1) * DFF + col0 + bj * HALF; *(f32x4*)d = v0; *(f32x4*)(d + 4) = v1; } } }
    }
};
template <class Epi, class Sched, bool ALIGN_EPI = false, bool SP2 = false>
__device__ __forceinline__ void gemm_phase(PG8_LAS unsigned char* lds, const Gemm g, const Sched& S, const Epi& E) {
    const int tid = threadIdx.x, wid = __builtin_amdgcn_readfirstlane(tid >> 6), lane = tid & 63, wr = wid >> 2, wc = wid & 3, fr = lane & 15, fq = lane >> 4;
    const int K = g.K;
    unsigned voffA[2], voffB[2];
#pragma unroll
    for (int i = 0; i < 2; ++i) { int R, C; stage_rc(tid * 16 + i * 8192, R, C); const int Rb = Epi::PERM ? ((R & ~31) + perm32(R & 31)) : R;
        voffA[i] = (unsigned)(R * K + C) * 2u; voffB[i] = (unsigned)(Rb * K + C) * 2u; }
    const size_t kstep = (size_t)(BK * 2);
    const size_t hstep = (size_t)HALF * K * 2;
    const size_t tstep = 2 * hstep;
    const unsigned ldsw = (unsigned)wid * 1024u;
    const int aoff = lds_byte(wr * 64 + fr, fq * 8), boff = lds_byte(wc * 32 + fr, fq * 8);
#define PG8_SA(b, h) (((b) * 2 + (h)) * HTB)
#define PG8_SB(b, h) ((4 + (b) * 2 + (h)) * HTB)
#define PG8_STAGE(bufoff, gbase, voff) do { _Pragma("unroll") for (int _i = 0; _i < 2; ++_i) \
        __builtin_amdgcn_global_load_lds((const unsigned*)((const char*)(gbase) + (voff)[_i]), (PG8_LAS unsigned*)(lds + (bufoff) + ldsw + _i * 8192), 16, 0, 0); } while (0)
#define PG8_LDA(dst, b, h) do { _Pragma("unroll") for (int m = 0; m < 4; ++m) _Pragma("unroll") for (int k = 0; k < 2; ++k) dst[m][k] = *(const PG8_LAS bf16x8*)(lds + PG8_SA(b, h) + aoff + m * 2048 + k * 1024); } while (0)
#define PG8_LDB(dst, b, h) do { _Pragma("unroll") for (int n = 0; n < 2; ++n) _Pragma("unroll") for (int k = 0; k < 2; ++k) dst[n][k] = *(const PG8_LAS bf16x8*)(lds + PG8_SB(b, h) + boff + n * 2048 + k * 1024); } while (0)
#define PG8_MMA(ai, bj, At, Bt) do { __builtin_amdgcn_s_setprio(1); _Pragma("unroll") for (int m = 0; m < 4; ++m) _Pragma("unroll") for (int n = 0; n < 2; ++n) _Pragma("unroll") for (int k = 0; k < 2; ++k) \
        acc[ai][bj][m][n] = __builtin_amdgcn_mfma_f32_16x16x32_bf16(Bt[n][k], At[m][k], acc[ai][bj][m][n], 0, 0, 0); __builtin_amdgcn_s_setprio(0); } while (0)
#define PG8_WAIT_V(n) asm volatile("s_waitcnt vmcnt(" #n ")" ::: "memory")
#define PG8_WAIT_L(n) asm volatile("s_waitcnt lgkmcnt(" #n ")" ::: "memory")
#define PG8_BAR __builtin_amdgcn_s_barrier()
#define PG8_SCHED __builtin_amdgcn_sched_barrier(0)
    Unit cur, nxt; int ui = 0;
    if (!S.next(0, cur)) return;
    f32x4 acc[2][2][4][2];
#pragma unroll
    for (int a = 0; a < 2; ++a)
#pragma unroll
        for (int b = 0; b < 2; ++b)
#pragma unroll
            for (int m = 0; m < 4; ++m)
#pragma unroll
                for (int n = 0; n < 2; ++n) acc[a][b][m][n] = (f32x4){0.f, 0.f, 0.f, 0.f};
    bf16x8 At[4][2], B0[2][2], B1[2][2];
    const char* cA = (const char*)g.A + (size_t)cur.pm * tstep + (size_t)cur.kt0 * (BK * 2); const char* cB = (const char*)g.Bt + (size_t)cur.pn * tstep + (size_t)cur.kt0 * (BK * 2);
    S.a_ready(cur);
    if constexpr (SP2) {
        PG8_STAGE(PG8_SB(0, 0), cB, voffB); PG8_STAGE(PG8_SB(0, 1), cB + hstep, voffB); PG8_STAGE(PG8_SA(0, 0), cA, voffA); PG8_STAGE(PG8_SA(0, 1), cA + hstep, voffA);
        if (wr == 1) PG8_BAR;
        PG8_WAIT_V(2); PG8_BAR;
        PG8_STAGE(PG8_SB(1, 0), cB + kstep, voffB); PG8_STAGE(PG8_SA(1, 0), cA + kstep, voffA); PG8_STAGE(PG8_SB(1, 1), cB + hstep + kstep, voffB);
        PG8_WAIT_V(6); PG8_BAR;
    } else {
        PG8_STAGE(PG8_SB(0, 0), cB, voffB); PG8_STAGE(PG8_SA(0, 0), cA, voffA); PG8_STAGE(PG8_SB(0, 1), cB + hstep, voffB); PG8_STAGE(PG8_SA(0, 1), cA + hstep, voffA);
        if (wr == 1) PG8_BAR;
        PG8_WAIT_V(4); PG8_BAR;
        PG8_STAGE(PG8_SB(1, 0), cB + kstep, voffB); PG8_STAGE(PG8_SA(1, 0), cA + kstep, voffA); PG8_STAGE(PG8_SB(1, 1), cB + hstep + kstep, voffB);
        PG8_WAIT_V(6); PG8_BAR;
    }
    for (;;) {
        const bool has_next = S.next(ui + 1, nxt);
        const char* nA = has_next ? (const char*)g.A + (size_t)nxt.pm * tstep + (size_t)nxt.kt0 * (BK * 2) : cA; const char* nB = has_next ? (const char*)g.Bt + (size_t)nxt.pn * tstep + (size_t)nxt.kt0 * (BK * 2) : cB;
        const int nt = cur.nt;
        for (int t = 0; t < nt; t += 2) {
            const bool last = (t == nt - 2);
            const char* a1 = cA + (size_t)(t + 1) * kstep;
            const char* a2 = last ? nA : cA + (size_t)(t + 2) * kstep; const char* b2 = last ? nB : cB + (size_t)(t + 2) * kstep;
            const char* a3 = a2 + kstep; const char* b3 = b2 + kstep;
            if (last && has_next) S.a_ready(nxt);
            if constexpr (SP2) {
            PG8_LDB(B0, 0, 0); PG8_LDB(B1, 0, 1); PG8_SCHED; PG8_LDA(At, 0, 0); PG8_STAGE(PG8_SA(1, 1), a1 + hstep, voffA);
            PG8_WAIT_V(8); PG8_WAIT_L(0); PG8_BAR; PG8_MMA(0, 0, At, B0); PG8_MMA(0, 1, At, B1); PG8_BAR; PG8_SCHED;
            PG8_LDA(At, 0, 1); PG8_STAGE(PG8_SB(0, 0), b2, voffB); PG8_STAGE(PG8_SB(0, 1), b2 + hstep, voffB); PG8_STAGE(PG8_SA(0, 0), a2, voffA);
            PG8_WAIT_V(8); PG8_WAIT_L(0); PG8_BAR; PG8_MMA(1, 0, At, B0); PG8_MMA(1, 1, At, B1); PG8_BAR; PG8_SCHED;
            PG8_LDB(B0, 1, 0); PG8_LDB(B1, 1, 1); PG8_SCHED; PG8_LDA(At, 1, 0); PG8_STAGE(PG8_SA(0, 1), a2 + hstep, voffA);
            PG8_WAIT_V(8); PG8_WAIT_L(0); PG8_BAR; PG8_MMA(0, 0, At, B0); PG8_MMA(0, 1, At, B1); PG8_BAR; PG8_SCHED;
            PG8_LDA(At, 1, 1); PG8_STAGE(PG8_SB(1, 0), b3, voffB); PG8_STAGE(PG8_SB(1, 1), b3 + hstep, voffB); PG8_STAGE(PG8_SA(1, 0), a3, voffA);
            PG8_WAIT_V(8); PG8_WAIT_L(0); PG8_BAR; PG8_MMA(1, 0, At, B0); PG8_MMA(1, 1, At, B1); PG8_BAR; PG8_SCHED;
            } else {
            PG8_LDB(B0, 0, 0); PG8_SCHED; PG8_LDA(At, 0, 0); PG8_STAGE(PG8_SA(1, 1), a1 + hstep, voffA);
            PG8_WAIT_L(8); PG8_BAR; PG8_WAIT_L(0); PG8_MMA(0, 0, At, B0); PG8_BAR; PG8_SCHED;
            PG8_LDB(B1, 0, 1); PG8_STAGE(PG8_SB(0, 0), b2, voffB);
            PG8_BAR; PG8_WAIT_L(0); PG8_MMA(0, 1, At, B1); PG8_BAR;
            PG8_LDA(At, 0, 1); PG8_STAGE(PG8_SA(0, 0), a2, voffA);
            PG8_BAR; PG8_WAIT_L(0); PG8_MMA(1, 0, At, B0); PG8_BAR; PG8_SCHED;
            PG8_STAGE(PG8_SB(0, 1), b2 + hstep, voffB);
            PG8_WAIT_V(6); PG8_BAR; PG8_MMA(1, 1, At, B1); PG8_BAR;
            PG8_LDB(B0, 1, 0); PG8_SCHED; PG8_LDA(At, 1, 0); PG8_STAGE(PG8_SA(0, 1), a2 + hstep, voffA);
            PG8_WAIT_L(8); PG8_BAR; PG8_WAIT_L(0); PG8_MMA(0, 0, At, B0); PG8_BAR; PG8_SCHED;
            PG8_LDB(B1, 1, 1); PG8_STAGE(PG8_SB(1, 0), b3, voffB);
            PG8_BAR; PG8_WAIT_L(0); PG8_MMA(0, 1, At, B1); PG8_BAR;
            PG8_LDA(At, 1, 1); PG8_STAGE(PG8_SA(1, 0), a3, voffA);
            PG8_BAR; PG8_WAIT_L(0); PG8_MMA(1, 0, At, B0); PG8_BAR; PG8_SCHED;
            PG8_STAGE(PG8_SB(1, 1), b3 + hstep, voffB);
            PG8_WAIT_V(6); PG8_BAR; PG8_MMA(1, 1, At, B1); PG8_BAR;
            }
        }
        if constexpr (ALIGN_EPI) { if (wr == 0) PG8_BAR; }
        if constexpr (!Epi::AFTER_DRAIN) { E(acc, cur, wr, wc, fr, fq); S.done(cur); }
        if (!has_next) break;
#pragma unroll
        for (int a = 0; a < 2; ++a)
#pragma unroll
            for (int b = 0; b < 2; ++b)
#pragma unroll
                for (int m = 0; m < 4; ++m)
#pragma unroll
                    for (int n = 0; n < 2; ++n) acc[a][b][m][n] = (f32x4){0.f, 0.f, 0.f, 0.f};
        cur = nxt; cA = nA; cB = nB; ++ui;
        if constexpr (ALIGN_EPI) { if (wr == 1) PG8_BAR; }
    }
    PG8_WAIT_V(0);
    if constexpr (!ALIGN_EPI) { if (wr == 0) PG8_BAR; }
    PG8_BAR;
    if constexpr (Epi::AFTER_DRAIN) { E.fused(acc, cur, wr, wc, fr, fq, lds, wid, lane); S.done(cur); }
#undef PG8_SA
#undef PG8_SB
#undef PG8_STAGE
#undef PG8_LDA
#undef PG8_LDB
#undef PG8_MMA
#undef PG8_WAIT_V
#undef PG8_WAIT_L
#undef PG8_BAR
#undef PG8_SCHED
}
}

#ifndef PG8_SP2
#define PG8_SP2 true
#endif
#ifndef PG8_ALIGN
#define PG8_ALIGN true
#endif
#define XB_TMO      128
#define XB_XCNT(j)  (256  + 64 * (j))
#define XB_XSUB(j)  (1280 + 64 * (j))
#define XB_XGEN(j)  (2304 + 64 * (j))
#define XB_TOP      3328
#define XB_TOPGEN   3392
#define XCD_BAR_WORDS 3456
#define XB_SPIN_CAP (1u << 18)

__device__ __forceinline__ unsigned xb_ld(unsigned* p)              { return __hip_atomic_load(p, __ATOMIC_RELAXED, __HIP_MEMORY_SCOPE_AGENT); }
__device__ __forceinline__ unsigned xb_add(unsigned* p, unsigned v) { return __hip_atomic_fetch_add(p, v, __ATOMIC_RELAXED, __HIP_MEMORY_SCOPE_AGENT); }
__device__ __forceinline__ unsigned xb_xcc_id() { return (unsigned)__builtin_amdgcn_s_getreg((3 << 11) | 20) & 0xFu; }
#define XB_SPIN(cond, bar) do { unsigned _sp = 0; while (cond) { __builtin_amdgcn_s_sleep(1); \
    if ((++_sp & 255u) == 0u) { if (xb_ld(&(bar)[XB_TMO])) break; if (_sp > XB_SPIN_CAP) { atomicAdd(&(bar)[XB_TMO], 1u); break; } } } } while (0)

struct XcdBarrier {
    unsigned* bar; unsigned x;
    volatile LAS unsigned* st;
};

__device__ __forceinline__ XcdBarrier xcd_barrier_post(unsigned* bar, volatile LAS unsigned* st) {
    XcdBarrier b; b.bar = bar; b.x = xb_xcc_id(); b.st = st;
    if (threadIdx.x == 0) (void)xb_add(&bar[XB_XCNT(b.x)], 1u);
    return b;
}
__device__ __forceinline__ void xcd_barrier_complete(unsigned* bar, unsigned x, unsigned& nloc, unsigned& nx) {
    const unsigned G = gridDim.x * gridDim.y * gridDim.z;
    unsigned sum, cnt, mine, sp = 0u;
    for (;;) {
        sum = 0u; cnt = 0u; mine = 0u;
#pragma unroll
        for (unsigned j = 0; j < 16; ++j) { const unsigned c = xb_ld(&bar[XB_XCNT(j)]); sum += c; cnt += (c > 0u) ? 1u : 0u; mine = (j == x) ? c : mine; }
        if (sum == G) break;
        __builtin_amdgcn_s_sleep(1);
        if ((++sp & 255u) == 0u) { if (xb_ld(&bar[XB_TMO])) break; if (sp > XB_SPIN_CAP) { atomicAdd(&bar[XB_TMO], 1u); break; } }
    }
    nloc = mine > 0u ? mine : 1u; nx = cnt > 0u ? cnt : 1u;
}

__device__ __forceinline__ void xcd_barrier(const XcdBarrier& b) {
    asm volatile("s_waitcnt vmcnt(0)" ::: "memory");
    __syncthreads();
    if (threadIdx.x == 0) {
        unsigned* bar = b.bar;
        __builtin_amdgcn_s_waitcnt(0);
        unsigned nloc = b.st[0], nx = b.st[1];
        if (nloc == 0u) { xcd_barrier_complete(bar, b.x, nloc, nx); b.st[0] = nloc; b.st[1] = nx; }
        const unsigned old = xb_add(&bar[XB_XSUB(b.x)], 1u);
        const unsigned gen = old / nloc;
        if (old + 1u == (gen + 1u) * nloc) {
            __builtin_amdgcn_fence(__ATOMIC_RELEASE, "agent");
            asm volatile("s_waitcnt vmcnt(0)" ::: "memory");
            const unsigned og = xb_add(&bar[XB_TOP], 1u);
            const unsigned tg = og / nx;
            if (og + 1u == (tg + 1u) * nx) xb_add(&bar[XB_TOPGEN], 1u);
            else XB_SPIN(xb_ld(&bar[XB_TOPGEN]) == tg, bar);
            __builtin_amdgcn_fence(__ATOMIC_ACQUIRE, "agent");
            xb_add(&bar[XB_XGEN(b.x)], 1u);
            asm volatile("s_waitcnt vmcnt(0)" ::: "memory");
        } else {
            XB_SPIN(xb_ld(&bar[XB_XGEN(b.x)]) == gen, bar);
            __builtin_amdgcn_fence(__ATOMIC_ACQUIRE, "agent");
            asm volatile("s_waitcnt vmcnt(0)" ::: "memory");
        }
    }
    __syncthreads();
}

constexpr int SK_KS_O = 8, SK_KS_G = 4, SK_KS_D = 22;
typedef short v4i16_t __attribute__((ext_vector_type(4)));
__device__ __forceinline__ s16x4 tr16(const LAS unsigned char* p) { return __builtin_bit_cast(s16x4, __builtin_amdgcn_ds_read_tr16_b64_v4i16((LAS v4i16_t*)p)); }
__device__ __forceinline__ bf16x8 cat8(s16x4 a, s16x4 b) { return (bf16x8){a[0], a[1], a[2], a[3], b[0], b[1], b[2], b[3]}; }
__device__ __forceinline__ int crow(int r, int hi) { return (r & 3) + 8 * (r >> 2) + 4 * hi; }
__device__ __forceinline__ f32x16 mfma32(bf16x8 a, bf16x8 b, f32x16 c) { return __builtin_amdgcn_mfma_f32_32x32x16_bf16(a, b, c, 0, 0, 0); }
__device__ __forceinline__ f32x4 mfma16(bf16x8 a, bf16x8 b, f32x4 c) { return __builtin_amdgcn_mfma_f32_16x16x32_bf16(a, b, c, 0, 0, 0); }
__device__ __forceinline__ v4u pack8(const float* v) { v4u w; w.x = cvtpk(v[0], v[1]); w.y = cvtpk(v[2], v[3]); w.z = cvtpk(v[4], v[5]); w.w = cvtpk(v[6], v[7]); return w; }
__device__ __forceinline__ void unpack8(v4u w, float* v) { v[0] = bflo(w.x); v[1] = bfhi(w.x); v[2] = bflo(w.y); v[3] = bfhi(w.y); v[4] = bflo(w.z); v[5] = bfhi(w.z); v[6] = bflo(w.w); v[7] = bfhi(w.w); }

__device__ __forceinline__ void p0_transpose_tile(const float* W, int K, int N, bf16* WT, int tile, int lane) {
    const int nblk = N >> 6, kb = tile / nblk, nb = tile - kb * nblk, nq = lane & 15, kq = lane >> 4;
    const float* src = W + (size_t)(64 * kb + 16 * kq) * N + 64 * nb + 4 * nq;
    f32x4 v[16];
#pragma unroll
    for (int i = 0; i < 16; ++i) v[i] = *(const f32x4*)(src + (size_t)i * N);
    bf16* dst = WT + (size_t)(64 * nb + 4 * nq) * K + 64 * kb + 16 * kq;
#pragma unroll
    for (int e = 0; e < 4; ++e) {
        v4u lo, hi;
        lo.x = cvtpk(v[0][e], v[1][e]); lo.y = cvtpk(v[2][e], v[3][e]); lo.z = cvtpk(v[4][e], v[5][e]); lo.w = cvtpk(v[6][e], v[7][e]);
        hi.x = cvtpk(v[8][e], v[9][e]); hi.y = cvtpk(v[10][e], v[11][e]); hi.z = cvtpk(v[12][e], v[13][e]); hi.w = cvtpk(v[14][e], v[15][e]);
        *(v4u*)(dst + (size_t)e * K) = lo; *(v4u*)(dst + (size_t)e * K + 8) = hi;
    }
}
__device__ __forceinline__ void p0_mod_item(LAS unsigned char* lds, const float* cp, const float* cs, const float* w_ada, const float* b_ada, float* MOD, int item, int tid, int lane, int wave) {
    const int n0 = 64 * item, nq = lane & 15, kg = lane >> 4;
    f32x4 acc[9][4];
#pragma unroll
    for (int rb = 0; rb < 9; ++rb)
#pragma unroll
        for (int e = 0; e < 4; ++e) acc[rb][e] = (f32x4){0.f, 0.f, 0.f, 0.f};
    for (int ks = 0; ks < 8; ++ks) {
        const int k0 = 256 * wave + 32 * ks + 8 * kg;
        f32x4 bv[8];
#pragma unroll
        for (int j = 0; j < 8; ++j) bv[j] = *(const f32x4*)(w_ada + (size_t)(k0 + j) * NMODC + n0 + 4 * nq);
        bf16x8 bfr[4];
#pragma unroll
        for (int e = 0; e < 4; ++e) { v4u w; w.x = cvtpk(bv[0][e], bv[1][e]); w.y = cvtpk(bv[2][e], bv[3][e]); w.z = cvtpk(bv[4][e], bv[5][e]); w.w = cvtpk(bv[6][e], bv[7][e]); bfr[e] = __builtin_bit_cast(bf16x8, w); }
#pragma unroll
        for (int rb = 0; rb < 9; ++rb) {
            const int r = 16 * rb + nq;
            v4u aw = (v4u){0u, 0u, 0u, 0u};
            if (r < NMODR) { const float* crow_ = (r < 2) ? cp + (size_t)r * DM : cs + (size_t)(r - 2) * DM;
                const f32x4 a0 = *(const f32x4*)(crow_ + k0), a1 = *(const f32x4*)(crow_ + k0 + 4);
                aw.x = cvtpk(silu_f(a0[0]), silu_f(a0[1])); aw.y = cvtpk(silu_f(a0[2]), silu_f(a0[3])); aw.z = cvtpk(silu_f(a1[0]), silu_f(a1[1])); aw.w = cvtpk(silu_f(a1[2]), silu_f(a1[3])); }
            const bf16x8 af = __builtin_bit_cast(bf16x8, aw);
#pragma unroll
            for (int e = 0; e < 4; ++e) acc[rb][e] = mfma16(af, bfr[e], acc[rb][e]);
        }
    }
    LAS float* RED = (LAS float*)lds;
    __syncthreads();
    for (int w = 0; w < 8; ++w) {
        if (wave == w) {
#pragma unroll
            for (int rb = 0; rb < 9; ++rb)
#pragma unroll
                for (int e = 0; e < 4; ++e)
#pragma unroll
                    for (int reg = 0; reg < 4; ++reg) { const int idx = (16 * rb + 4 * kg + reg) * 64 + 4 * nq + e; const float p = acc[rb][e][reg]; RED[idx] = (w == 0) ? p : RED[idx] + p; }
        }
        __syncthreads();
    }
    for (int idx = tid; idx < NMODR * 64; idx += 512) { const int r = idx >> 6, cc = idx & 63; MOD[(size_t)r * NMODC + n0 + cc] = RED[idx] + b_ada[n0 + cc]; }
    __syncthreads();
}

__device__ __forceinline__ int mod_row(int r) { return r < MPROMPT ? (r >> 13) : 2 + (r - MPROMPT); }

__device__ __forceinline__ void lds_fill_vec(LAS float* dst, const float* __restrict__ src, int tid) { *(LAS f32x4*)(dst + 4 * tid) = *(const f32x4*)(src + 4 * tid); }
__device__ __forceinline__ f32x4 ldsv(const LAS float* v, int lane, int j, int q) { return *(const LAS f32x4*)(v + 8 * lane + 512 * j + 4 * q); }
__device__ __forceinline__ void load_row_f32(f32x4 (&d)[4][2], const float* __restrict__ p) {
#pragma unroll
    for (int j = 0; j < 4; ++j) { d[j][0] = *(const f32x4*)(p + 512 * j); d[j][1] = *(const f32x4*)(p + 512 * j + 4); } }
__device__ __forceinline__ void load_row_bf16(v4u (&d)[4], const bf16* __restrict__ p) {
#pragma unroll
    for (int j = 0; j < 4; ++j) d[j] = *(const v4u*)(p + 512 * j); }
__device__ __forceinline__ void p1_rows(LAS unsigned char* lds, const float* __restrict__ xp, const float* __restrict__ xs, const float* __restrict__ gpre, const float* __restrict__ MOD, bf16* __restrict__ H, int gw, int NGW, int tid, int lane) {
    LAS float* G = (LAS float*)lds; LAS float* SH = G + 2048; LAS float* SC = SH + 4096;
    lds_fill_vec(G, gpre, tid); lds_fill_vec(SH, MOD, tid); lds_fill_vec(SH + 2048, MOD + NMODC, tid); lds_fill_vec(SC, MOD + DM, tid); lds_fill_vec(SC + 2048, MOD + NMODC + DM, tid);
    __syncthreads();
    f32x4 nx[4][2];
    if (gw < MPROMPT) load_row_f32(nx, xp + (size_t)gw * DM + 8 * lane);
    for (int r = gw; r < MPROMPT; r += NGW) {
        f32x4 v[4][2];
#pragma unroll
        for (int j = 0; j < 4; ++j) { v[j][0] = nx[j][0]; v[j][1] = nx[j][1]; }
        if (r + NGW < MPROMPT) load_row_f32(nx, xp + (size_t)(r + NGW) * DM + 8 * lane);
        const int b = r >> 13; float ss = 0.f;
#pragma unroll
        for (int j = 0; j < 4; ++j)
#pragma unroll
            for (int i = 0; i < 4; ++i) ss += v[j][0][i] * v[j][0][i] + v[j][1][i] * v[j][1][i];
        const float rstd = rsqrtf(wave_sum(ss) * (1.0f / DM) + EPS);
        bf16* hrow = H + (size_t)r * DM + 8 * lane;
#pragma unroll
        for (int j = 0; j < 4; ++j) { float o[8];
#pragma unroll
            for (int q = 0; q < 2; ++q) { const f32x4 g = ldsv(G, lane, j, q), sh = ldsv(SH + 2048 * b, lane, j, q), sc = ldsv(SC + 2048 * b, lane, j, q);
#pragma unroll
                for (int i = 0; i < 4; ++i) o[4 * q + i] = v[j][q][i] * rstd * g[i] * (1.0f + sc[i]) + sh[i]; }
            *(v4u*)(hrow + 512 * j) = pack8(o); }
    }
    for (int r = MPROMPT + gw; r < MPAD; r += NGW) {
        bf16* hrow = H + (size_t)r * DM + 8 * lane;
        if (r >= MTOK) {
#pragma unroll
            for (int j = 0; j < 4; ++j) *(v4u*)(hrow + 512 * j) = (v4u){0u, 0u, 0u, 0u};
            continue; }
        f32x4 v[4][2]; load_row_f32(v, xs + (size_t)(r - MPROMPT) * DM + 8 * lane);
        const float* mr = MOD + (size_t)mod_row(r) * NMODC + 8 * lane; float ss = 0.f;
#pragma unroll
        for (int j = 0; j < 4; ++j)
#pragma unroll
            for (int i = 0; i < 4; ++i) ss += v[j][0][i] * v[j][0][i] + v[j][1][i] * v[j][1][i];
        const float rstd = rsqrtf(wave_sum(ss) * (1.0f / DM) + EPS);
#pragma unroll
        for (int j = 0; j < 4; ++j) { float o[8];
#pragma unroll
            for (int q = 0; q < 2; ++q) { const f32x4 g = ldsv(G, lane, j, q), sh = *(const f32x4*)(mr + 512 * j + 4 * q), sc = *(const f32x4*)(mr + DM + 512 * j + 4 * q);
#pragma unroll
                for (int i = 0; i < 4; ++i) o[4 * q + i] = v[j][q][i] * rstd * g[i] * (1.0f + sc[i]) + sh[i]; }
            *(v4u*)(hrow + 512 * j) = pack8(o); }
    }
    __syncthreads();
}
template <bool LDSMOD>
__device__ __forceinline__ void p5_finish(const float (&ov)[4][8], const f32x4 (&xv)[4][2], const LAS float* GP, const LAS float* GPRE, const LAS float* GT, const LAS float* SHF, const LAS float* SCF,
                                          const float* __restrict__ mr, float* __restrict__ x1r, bf16* __restrict__ hrow, int lane) {
    float ss = 0.f;
#pragma unroll
    for (int j = 0; j < 4; ++j)
#pragma unroll
        for (int i = 0; i < 8; ++i) ss += ov[j][i] * ov[j][i];
    const float rstd_o = rsqrtf(wave_sum(ss) * (1.0f / DM) + EPS);
    float x1[4][8]; float s1 = 0.f;
#pragma unroll
    for (int j = 0; j < 4; ++j)
#pragma unroll
        for (int q = 0; q < 2; ++q) { const f32x4 gp = ldsv(GP, lane, j, q), gt = LDSMOD ? ldsv(GT, lane, j, q) : *(const f32x4*)(mr + 2 * DM + 512 * j + 4 * q); f32x4 y;
#pragma unroll
            for (int i = 0; i < 4; ++i) { y[i] = xv[j][q][i] + gt[i] * (ov[j][4 * q + i] * rstd_o * gp[i]); x1[j][4 * q + i] = y[i]; s1 += y[i] * y[i]; }
            *(f32x4*)(x1r + 512 * j + 4 * q) = y; }
    const float rstd_1 = rsqrtf(wave_sum(s1) * (1.0f / DM) + EPS);
#pragma unroll
    for (int j = 0; j < 4; ++j) { float o[8];
#pragma unroll
        for (int q = 0; q < 2; ++q) { const f32x4 g = ldsv(GPRE, lane, j, q), sh = LDSMOD ? ldsv(SHF, lane, j, q) : *(const f32x4*)(mr + 3 * DM + 512 * j + 4 * q), sc = LDSMOD ? ldsv(SCF, lane, j, q) : *(const f32x4*)(mr + 4 * DM + 512 * j + 4 * q);
#pragma unroll
            for (int i = 0; i < 4; ++i) o[4 * q + i] = x1[j][4 * q + i] * rstd_1 * g[i] * (1.0f + sc[i]) + sh[i]; }
        *(v4u*)(hrow + 512 * j) = pack8(o); }
}
__device__ __forceinline__ void p5_rows(LAS unsigned char* lds, const float* __restrict__ xp, const float* __restrict__ xs, const bf16* __restrict__ O, const float* __restrict__ OS  ,
                                        const float* __restrict__ gpost, const float* __restrict__ gpre, const float* __restrict__ MOD, float* __restrict__ out, bf16* __restrict__ H2, int gw, int NGW, int tid, int lane) {
    LAS float* GP = (LAS float*)lds; LAS float* GPRE = GP + 2048; LAS float* GT = GPRE + 2048; LAS float* SHF = GT + 4096; LAS float* SCF = SHF + 4096;
    lds_fill_vec(GP, gpost, tid); lds_fill_vec(GPRE, gpre, tid);
#pragma unroll
    for (int b = 0; b < 2; ++b) { lds_fill_vec(GT + 2048 * b, MOD + b * NMODC + 2 * DM, tid); lds_fill_vec(SHF + 2048 * b, MOD + b * NMODC + 3 * DM, tid); lds_fill_vec(SCF + 2048 * b, MOD + b * NMODC + 4 * DM, tid); }
    __syncthreads();
    v4u no[4]; f32x4 nx[4][2];
    if (gw < MPROMPT) { load_row_bf16(no, O + (size_t)gw * DM + 8 * lane); load_row_f32(nx, xp + (size_t)gw * DM + 8 * lane); }
    for (int r = gw; r < MPROMPT; r += NGW) {
        float ov[4][8]; f32x4 xv[4][2];
#pragma unroll
        for (int j = 0; j < 4; ++j) { unpack8(no[j], ov[j]); xv[j][0] = nx[j][0]; xv[j][1] = nx[j][1]; }
        if (r + NGW < MPROMPT) { load_row_bf16(no, O + (size_t)(r + NGW) * DM + 8 * lane); load_row_f32(nx, xp + (size_t)(r + NGW) * DM + 8 * lane); }
        const int b = r >> 13;
        p5_finish<true>(ov, xv, GP, GPRE, GT + 2048 * b, SHF + 2048 * b, SCF + 2048 * b, nullptr, out + O_YP + (size_t)r * DM + 8 * lane, H2 + (size_t)r * DM + 8 * lane, lane);
    }
    for (int r = MPROMPT + gw; r < MPAD; r += NGW) {
        bf16* hrow = H2 + (size_t)r * DM + 8 * lane;
        if (r >= MTOK) {
#pragma unroll
            for (int j = 0; j < 4; ++j) *(v4u*)(hrow + 512 * j) = (v4u){0u, 0u, 0u, 0u};
            continue; }
        const int sr_ = r - MPROMPT; const float* sr = OS + (size_t)sr_ * DM + 8 * lane;
        float ov[4][8]; f32x4 xv[4][2]; load_row_f32(xv, xs + (size_t)sr_ * DM + 8 * lane);
#pragma unroll
        for (int j = 0; j < 4; ++j)
#pragma unroll
            for (int q = 0; q < 2; ++q) { f32x4 a = *(const f32x4*)(sr + 512 * j + 4 * q);
#pragma unroll
                for (int s = 1; s < SK_KS_O; ++s) a += *(const f32x4*)(sr + (size_t)s * NSAMP * DM + 512 * j + 4 * q);
#pragma unroll
                for (int i = 0; i < 4; ++i) ov[j][4 * q + i] = a[i]; }
        p5_finish<false>(ov, xv, GP, GPRE, nullptr, nullptr, nullptr, MOD + (size_t)mod_row(r) * NMODC + 8 * lane, out + O_YS + (size_t)sr_ * DM + 8 * lane, hrow, lane);
    }
    __syncthreads();
}
template <bool LDSMOD>
__device__ __forceinline__ void p9_finish(const float (&yv)[4][8], const f32x4 (&xv)[4][2], const LAS float* GP, const LAS float* GT, const float* __restrict__ mr, float* __restrict__ x1r, int lane) {
    float ss = 0.f;
#pragma unroll
    for (int j = 0; j < 4; ++j)
#pragma unroll
        for (int i = 0; i < 8; ++i) ss += yv[j][i] * yv[j][i];
    const float rstd = rsqrtf(wave_sum(ss) * (1.0f / DM) + EPS);
#pragma unroll
    for (int j = 0; j < 4; ++j)
#pragma unroll
        for (int q = 0; q < 2; ++q) { const f32x4 gp = ldsv(GP, lane, j, q), gt = LDSMOD ? ldsv(GT, lane, j, q) : *(const f32x4*)(mr + 5 * DM + 512 * j + 4 * q); f32x4 y;
#pragma unroll
            for (int i = 0; i < 4; ++i) y[i] = xv[j][q][i] + gt[i] * (yv[j][4 * q + i] * rstd * gp[i]);
            *(f32x4*)(x1r + 512 * j + 4 * q) = y; }
}
__device__ __forceinline__ void p9_rows(LAS unsigned char* lds, const bf16* __restrict__ YF, const float* __restrict__ YS  , const float* __restrict__ gpost, const float* __restrict__ MOD, float* out, int gw, int NGW, int tid, int lane) {
    LAS float* GP = (LAS float*)lds; LAS float* GT = GP + 2048;
    lds_fill_vec(GP, gpost, tid); lds_fill_vec(GT, MOD + 5 * DM, tid); lds_fill_vec(GT + 2048, MOD + NMODC + 5 * DM, tid);
    __syncthreads();
    v4u ny[4]; f32x4 nx[4][2];
    if (gw < MPROMPT) { load_row_bf16(ny, YF + (size_t)gw * DM + 8 * lane); load_row_f32(nx, out + O_YP + (size_t)gw * DM + 8 * lane); }
    for (int r = gw; r < MPROMPT; r += NGW) {
        float yv[4][8]; f32x4 xv[4][2];
#pragma unroll
        for (int j = 0; j < 4; ++j) { unpack8(ny[j], yv[j]); xv[j][0] = nx[j][0]; xv[j][1] = nx[j][1]; }
        if (r + NGW < MPROMPT) { load_row_bf16(ny, YF + (size_t)(r + NGW) * DM + 8 * lane); load_row_f32(nx, out + O_YP + (size_t)(r + NGW) * DM + 8 * lane); }
        p9_finish<true>(yv, xv, GP, GT + 2048 * (r >> 13), nullptr, out + O_YP + (size_t)r * DM + 8 * lane, lane);
    }
    for (int r = MPROMPT + gw; r < MTOK; r += NGW) {
        const int sr_ = r - MPROMPT; const float* sr = YS + (size_t)sr_ * DM + 8 * lane; float* x1r = out + O_YS + (size_t)sr_ * DM + 8 * lane;
        float yv[4][8]; f32x4 xv[4][2]; load_row_f32(xv, x1r);
#pragma unroll
        for (int j = 0; j < 4; ++j)
#pragma unroll
            for (int q = 0; q < 2; ++q) { f32x4 a = *(const f32x4*)(sr + 512 * j + 4 * q);
                for (int s = 1; s < SK_KS_D; ++s) a += *(const f32x4*)(sr + (size_t)s * NSAMP * DM + 512 * j + 4 * q);
#pragma unroll
                for (int i = 0; i < 4; ++i) yv[j][4 * q + i] = a[i]; }
        p9_finish<false>(yv, xv, GP, nullptr, MOD + (size_t)mod_row(r) * NMODC + 8 * lane, x1r, lane);
    }
}
__device__ __forceinline__ void p7_prompt(const bf16* A, bf16* U, const float* conv_w, const float* conv_b, int gw, int NGW, int lane) {
    for (int it = gw; it < 11 * (MPROMPT / 32); it += NGW) {
        const int rr = it / 11, cg = it - rr * 11, r0 = 32 * rr, c0 = 512 * cg + 8 * lane;
        float w0[8], w1[8], w2[8], bb[8], am2[8], am1[8];
#pragma unroll
        for (int q = 0; q < 2; ++q) { const f32x4 a = *(const f32x4*)(conv_w + c0 + 4 * q), b = *(const f32x4*)(conv_w + DFF + c0 + 4 * q), c = *(const f32x4*)(conv_w + 2 * DFF + c0 + 4 * q), d = *(const f32x4*)(conv_b + c0 + 4 * q);
#pragma unroll
            for (int i = 0; i < 4; ++i) { w0[4 * q + i] = a[i]; w1[4 * q + i] = b[i]; w2[4 * q + i] = c[i]; bb[4 * q + i] = d[i]; } }
        if ((r0 & (SEQ - 1)) == 0) {
#pragma unroll
            for (int i = 0; i < 8; ++i) { am2[i] = 0.f; am1[i] = 0.f; }
        } else { unpack8(*(const v4u*)(A + (size_t)(r0 - 2) * DFF + c0), am2); unpack8(*(const v4u*)(A + (size_t)(r0 - 1) * DFF + c0), am1); }
#pragma unroll 4
        for (int r = r0; r < r0 + 32; ++r) {
            float a[8], u[8], o[8];
            unpack8(*(const v4u*)(A + (size_t)r * DFF + c0), a); unpack8(*(const v4u*)(U + (size_t)r * DFF + c0), u);
#pragma unroll
            for (int i = 0; i < 8; ++i) { const float cv = bb[i] + w0[i] * am2[i] + w1[i] * am1[i] + w2[i] * a[i]; o[i] = gelu_f(cv) * u[i]; am2[i] = am1[i]; am1[i] = a[i]; }
            *(v4u*)(U + (size_t)r * DFF + c0) = pack8(o);
        }
    }
}
__device__ __forceinline__ void p7_sample(const bf16* __restrict__ SL  , bf16* __restrict__ U, const float* __restrict__ state, const float* __restrict__ conv_w, const float* __restrict__ conv_b, float* __restrict__ out, int gtid, int NGT) {
    for (int it = gtid; it < NSAMP * (DFF / 8); it += NGT) {
        const int sb = it / (DFF / 8), c0 = 8 * (it - sb * (DFF / 8));
        float a[8], u[8], o[8];
#pragma unroll
        for (int i = 0; i < 8; ++i) { a[i] = 0.f; u[i] = 0.f; }
#pragma unroll
        for (int s = 0; s < SK_KS_G; ++s) { const bf16* r = SL + ((size_t)s * NSAMP + sb) * (2 * DFF) + c0; float ta[8], tu[8]; unpack8(*(const v4u*)r, ta); unpack8(*(const v4u*)(r + DFF), tu);
#pragma unroll
            for (int i = 0; i < 8; ++i) { a[i] += ta[i]; u[i] += tu[i]; } }
#pragma unroll
        for (int q = 0; q < 2; ++q) { const f32x4 w0 = *(const f32x4*)(conv_w + c0 + 4 * q), w1 = *(const f32x4*)(conv_w + DFF + c0 + 4 * q), w2 = *(const f32x4*)(conv_w + 2 * DFF + c0 + 4 * q), bb = *(const f32x4*)(conv_b + c0 + 4 * q);
            const f32x4 s0 = *(const f32x4*)(state + (size_t)(sb * 2 + 0) * DFF + c0 + 4 * q), s1 = *(const f32x4*)(state + (size_t)(sb * 2 + 1) * DFF + c0 + 4 * q);
#pragma unroll
            for (int i = 0; i < 4; ++i) { const float cv = bb[i] + w0[i] * s0[i] + w1[i] * s1[i] + w2[i] * a[4 * q + i]; o[4 * q + i] = gelu_f(cv) * u[4 * q + i]; }
            *(f32x4*)(out + O_CS + (size_t)(sb * 2 + 0) * DFF + c0 + 4 * q) = s1;
            *(f32x4*)(out + O_CS + (size_t)(sb * 2 + 1) * DFF + c0 + 4 * q) = (f32x4){a[4 * q], a[4 * q + 1], a[4 * q + 2], a[4 * q + 3]}; }
        *(v4u*)(U + (size_t)(MPROMPT + sb) * DFF + c0) = pack8(o);
    }
}
constexpr int SK_CH = 512, SK_ROWB = SK_CH * 2 + 16, SK_BUF = 64 * SK_ROWB;
static_assert(2 * SK_BUF <= MISC_OFF, "skinny LDS");
template <class Epi>
__device__ __forceinline__ void skinny_phase(LAS unsigned char* lds, const bf16* __restrict__ As, const bf16* __restrict__ Bt, int N, int K, int KS, const Epi& E, int it0, int stride, int tid_, int lane_, int wave) {
    const int ncb = N >> 6, nitems = ncb * 2 * KS, nchunks = (K / KS) / SK_CH;
    for (int it = it0; it < nitems; it += stride) {
        int tid = tid_, lane = lane_; asm volatile("" : "+v"(tid), "+v"(lane));
        const int sl = it / (ncb * 2), r2 = it - sl * (ncb * 2), cb = r2 >> 1, rh = r2 & 1, n0 = cb * 64 + 16 * (wave & 3), kbeg = sl * (K / KS);
        const bf16* Ap = As + (size_t)(64 * rh + (tid >> 6)) * K + kbeg + 8 * (tid & 63);
        const bf16* Bp = Bt + (size_t)(n0 + (lane & 15)) * K + kbeg + 8 * (lane >> 4);
        LAS unsigned char* wdst = lds + (tid >> 6) * SK_ROWB + (tid & 63) * 16;
        const LAS unsigned char* rsrc = lds + (32 * (wave >> 2) + (lane & 15)) * SK_ROWB + (lane >> 4) * 16;
        f32x4 acc[2];
#pragma unroll
        for (int rb = 0; rb < 2; ++rb) acc[rb] = (f32x4){0.f, 0.f, 0.f, 0.f};
        v4u areg[8]; bf16x8 bnext[16];
#pragma unroll
        for (int i = 0; i < 8; ++i) areg[i] = *(const v4u*)(Ap + (size_t)(8 * i) * K);
#pragma unroll
        for (int ks = 0; ks < 16; ++ks) bnext[ks] = *(const bf16x8*)(Bp + 32 * ks);
        __syncthreads();
#pragma unroll
        for (int i = 0; i < 8; ++i) *(LAS v4u*)(wdst + 8 * i * SK_ROWB) = areg[i];
        for (int kc = 0; kc < nchunks; ++kc) {
            __syncthreads();
            bf16x8 bcur[16];
#pragma unroll
            for (int ks = 0; ks < 16; ++ks) bcur[ks] = bnext[ks];
            const bool more = kc + 1 < nchunks;
            if (more) {
#pragma unroll
                for (int i = 0; i < 8; ++i) areg[i] = *(const v4u*)(Ap + (size_t)(8 * i) * K + SK_CH * (kc + 1));
#pragma unroll
                for (int ks = 0; ks < 16; ++ks) bnext[ks] = *(const bf16x8*)(Bp + SK_CH * (kc + 1) + 32 * ks);
            }
            const LAS unsigned char* rb_ = rsrc + (kc & 1) * SK_BUF;
#pragma unroll
            for (int ks = 0; ks < 16; ++ks)
#pragma unroll
                for (int rb = 0; rb < 2; ++rb) { const bf16x8 af = *(const LAS bf16x8*)(rb_ + rb * 16 * SK_ROWB + ks * 64); acc[rb] = mfma16(bcur[ks], af, acc[rb]); }
            if (more) {
                LAS unsigned char* wd = wdst + ((kc + 1) & 1) * SK_BUF;
#pragma unroll
                for (int i = 0; i < 8; ++i) *(LAS v4u*)(wd + 8 * i * SK_ROWB) = areg[i];
            }
        }
#pragma unroll
        for (int rb = 0; rb < 2; ++rb) E.small(64 * rh + 32 * (wave >> 2) + 16 * rb + (lane & 15), n0 + 4 * (lane >> 4), acc[rb], sl);
    }
}
__device__ __forceinline__ void skinny_share(int nwg, int G, int c, int& it0, int& stride) { const int rem = nwg % G; if (rem == 0) { it0 = c; stride = G; } else if (c >= rem) { it0 = c - rem; stride = G - rem; } else { it0 = 1 << 30; stride = 1; } }
constexpr int MX_K = 0, MX_V = 32768, MX_VN = 65536, MX_STG = 98304, MX_TAB = 131072, MX_PART = MX_TAB + 1536, MX_END = MX_PART + 4096;
static_assert(MX_END <= MISC_OFF, "mixer LDS");
__device__ __forceinline__ void mixer_prompt_item(LAS unsigned char* lds, const bf16* __restrict__ Z, const f32x2* __restrict__ STAT, const bf16* __restrict__ TRIL, bf16* __restrict__ MERGED,
                                                  const float* __restrict__ sinks, const float* __restrict__ rel_bias, const float* __restrict__ lng, const float* __restrict__ lnb, const float* __restrict__ b_s,
                                                  int item, int tid, int lane, int wave) {
    asm volatile("" : "+v"(tid), "+v"(lane));
    const int g = item & 15, n = (item >> 4) & 63, b = item >> 10, kvh = g >> 2, R0 = b * SEQ + n * 128;
    LAS unsigned char* Kt = lds + MX_K; LAS unsigned char* Vt = lds + MX_V; LAS unsigned char* VNt = lds + MX_VN; LAS unsigned char* STG = lds + MX_STG + wave * 4096;
    LAS float* TAB = (LAS float*)(lds + MX_TAB); LAS f32x2* PART = (LAS f32x2*)(lds + MX_PART);
    const int hh = wave & 1, qb = wave >> 1, head = 2 * g + hh, ql = lane & 31, hi = lane >> 5;
    f32x2 st[8];
#pragma unroll
    for (int p = 0; p < 8; ++p) st[p] = STAT[(size_t)(8 * (tid >> 7) + p) * MPAD + R0 + (tid & 127)];
    v4u kreg[4], vreg[4], greg[4];
#pragma unroll
    for (int i = 0; i < 4; ++i) {
        const int q = tid + 512 * i, j = q >> 3, c = q & 7;
        if (n > 0 || j >= 128) { const bf16* src = Z + (size_t)(R0 - 128 + j) * DIN + 64 * kvh + 8 * c; kreg[i] = *(const v4u*)(src + CK); vreg[i] = *(const v4u*)(src + CV); }
    }
#pragma unroll
    for (int i = 0; i < 4; ++i) { const int q = tid + 512 * i, j = q >> 4, c = q & 15; greg[i] = *(const v4u*)(Z + (size_t)(R0 + j) * DIN + CG + 128 * g + 8 * c); }
    bf16x8 qf[4];
    { const bf16* qp = Z + (size_t)(R0 + 32 * qb + ql) * DIN + CQ + 64 * head + 8 * hi;
#pragma unroll
      for (int d0 = 0; d0 < 4; ++d0) qf[d0] = *(const bf16x8*)(qp + 16 * d0); }
    const float sk = sinks[head] * LOG2E;
    __syncthreads();
    { float s1 = 0.f, s2 = 0.f;
#pragma unroll
      for (int p = 0; p < 8; ++p) { s1 += st[p].x; s2 += st[p].y; }
      PART[tid] = (f32x2){s1, s2}; }
    if (tid < 384) {
        const int th = tid / 192, idx = tid - th * 192, dist = idx - 32;
        TAB[tid] = (dist >= 0 && dist <= 128) ? rel_bias[t5_bucket(dist) * 32 + 2 * g + th] * LOG2E : -1e30f;
    }
#pragma unroll
    for (int i = 0; i < 4; ++i) {
        const int q = tid + 512 * i, j = q >> 3, c = q & 7;
        if (n > 0 || j >= 128) {
            *(LAS v4u*)(Kt + j * 128 + ((c ^ ((j >> 1) & 7)) << 4)) = kreg[i];
            *(LAS v4u*)(Vt + (j >> 4) * 2048 + (c >> 2) * 1024 + ((j >> 3) & 1) * 512 + (j & 7) * 64 + (c & 3) * 16) = vreg[i];
        }
    }
    const int nsteps = 2 * (qb + 1);
    bf16x8 wf[8];
    { const bf16* wp = TRIL + ((size_t)g * 128 + 32 * qb + ql) * 128 + 8 * hi;
#pragma unroll
      for (int s = 0; s < 8; ++s) if (s < nsteps) wf[s] = *(const bf16x8*)(wp + 16 * s); }
    __syncthreads();
#pragma unroll
    for (int i = 0; i < 4; ++i) {
        const int q = tid + 512 * i, j = q >> 4, c = q & 15, ch = 128 * g + 8 * c;
        float v[8]; unpack8(greg[i], v);
        const f32x2 pa_ = PART[j], pb_ = PART[128 + j], pc_ = PART[256 + j], pd_ = PART[384 + j];
        const float mean = ((pa_.x + pb_.x) + (pc_.x + pd_.x)) * (1.0f / DM), var = ((pa_.y + pb_.y) + (pc_.y + pd_.y)) * (1.0f / DM) - mean * mean, rstd = rsqrtf(fmaxf(var, 0.f) + EPS);
#pragma unroll
        for (int qq = 0; qq < 2; ++qq) { const f32x4 gg = *(const f32x4*)(lng + ch + 4 * qq), bb = *(const f32x4*)(lnb + ch + 4 * qq);
#pragma unroll
            for (int k = 0; k < 4; ++k) v[4 * qq + k] = (v[4 * qq + k] - mean) * rstd * gg[k] + bb[k]; }
        *(LAS v4u*)(VNt + (j >> 4) * 4096 + (c >> 2) * 1024 + ((j >> 3) & 1) * 512 + (j & 7) * 64 + (c & 3) * 16) = pack8(v);
    }
    __syncthreads();
    const int tmin = (n == 0) ? (4 - qb) : 0;
    f32x16 p[5];
    int tboff = (hh * 192 + ql - 4 * hi + 5) * 4, kboff = (32 * qb + ql) * 128, swz = (ql >> 1) & 7;
    asm volatile("" : "+v"(tboff), "+v"(kboff), "+v"(swz));
    const LAS float* tb = (const LAS float*)((const LAS unsigned char*)TAB + tboff);
    const LAS unsigned char* kb0 = Kt + kboff;
#pragma unroll
    for (int t = 0; t < 5; ++t) {
        if (t >= tmin) {
            f32x16 acc = {};
#pragma unroll
            for (int d0 = 0; d0 < 4; ++d0) { const bf16x8 kf = *(const LAS bf16x8*)(kb0 + t * 4096 + (((2 * d0 + hi) ^ swz) << 4)); acc = mfma32(kf, qf[d0], acc); }
#pragma unroll
            for (int r = 0; r < 16; ++r) acc[r] += tb[155 - 32 * t - (r & 3) - 8 * (r >> 2)];
            p[t] = acc;
        } else {
#pragma unroll
            for (int r = 0; r < 16; ++r) p[t][r] = -1e30f;
        }
    }
    float m = -1e30f;
#pragma unroll
    for (int t = 0; t < 5; ++t)
#pragma unroll
        for (int r = 0; r < 16; ++r) m = fmaxf(m, p[t][r]);
    m = fmaxf(m, __shfl_xor(m, 32));
    m = fmaxf(m, sk);
    float sum = 0.f;
#pragma unroll
    for (int t = 0; t < 5; ++t)
#pragma unroll
        for (int r = 0; r < 16; ++r) { p[t][r] = fast_exp2(p[t][r] - m); sum += p[t][r]; }
    sum += __shfl_xor(sum, 32);
    const float inv = 1.0f / (sum + fast_exp2(sk - m));
    v4u mga[4], mgb[4], mu[4]; float bsv[4];
#pragma unroll
    for (int i = 0; i < 4; ++i) { const bf16* zr = Z + (size_t)(R0 + 32 * qb + 8 * i + (lane >> 3)) * DIN + 128 * g + 64 * hh + 8 * (lane & 7);
        mga[i] = *(const v4u*)(zr + CGA); mgb[i] = *(const v4u*)(zr + CGB); mu[i] = *(const v4u*)(zr + CU); bsv[i] = b_s[g * 128 + 32 * qb + 8 * i + (lane >> 3)]; }
    f32x16 o[2] = {{}, {}}, sg[2] = {{}, {}};
    int vlane = (4 * hi + ((lane & 15) >> 2)) * 64 + ((lane >> 4) & 1) * 32 + (lane & 3) * 8 + 2 * qb * 2048;
    asm volatile("" : "+v"(vlane));
#pragma unroll
    for (int t = 0; t < 5; ++t) {
        if (t >= tmin) {
#pragma unroll
            for (int s = 0; s < 2; ++s) {
                v4u pw; pw.x = cvtpk(p[t][8 * s + 0] * inv, p[t][8 * s + 1] * inv); pw.y = cvtpk(p[t][8 * s + 2] * inv, p[t][8 * s + 3] * inv);
                pw.z = cvtpk(p[t][8 * s + 4] * inv, p[t][8 * s + 5] * inv); pw.w = cvtpk(p[t][8 * s + 6] * inv, p[t][8 * s + 7] * inv);
                const bf16x8 pa = __builtin_bit_cast(bf16x8, pw);
                const LAS unsigned char* vp = Vt + (2 * t + s) * 2048 + vlane;
#pragma unroll
                for (int dh = 0; dh < 2; ++dh) { const bf16x8 vf = cat8(tr16(vp + dh * 1024), tr16(vp + dh * 1024 + 512)); o[dh] = mfma32(pa, vf, o[dh]); }
            }
        }
    }
    { int nlane = hi * 512 + ((lane & 15) >> 2) * 64 + ((lane >> 4) & 1) * 32 + (lane & 3) * 8 + (2 * hh) * 1024;
      asm volatile("" : "+v"(nlane));
#pragma unroll
      for (int s = 0; s < 8; ++s) {
          if (s < nsteps) {
              const LAS unsigned char* np = VNt + s * 4096 + nlane;
#pragma unroll
              for (int dh = 0; dh < 2; ++dh) { const bf16x8 vf = cat8(tr16(np + dh * 1024), tr16(np + dh * 1024 + 256)); sg[dh] = mfma32(wf[s], vf, sg[dh]); }
          }
      } }
    v4u t1[4], t2[4];
    int swoff = (4 * hi) * 128 + ql * 2, sroff = (lane >> 3) * 128 + (lane & 7) * 16;
    asm volatile("" : "+v"(swoff), "+v"(sroff));
    LAS unsigned char* stw = STG + swoff; const LAS unsigned char* str_ = STG + sroff;
#pragma unroll
    for (int dh = 0; dh < 2; ++dh)
#pragma unroll
        for (int r = 0; r < 16; ++r) *(LAS bf16*)(stw + ((r & 3) + 8 * (r >> 2)) * 128 + 64 * dh) = (bf16)(cvtpk(o[dh][r], 0.f) & 0xffffu);
    LDS_WAIT();
#pragma unroll
    for (int i = 0; i < 4; ++i) t1[i] = *(const LAS v4u*)(str_ + i * 1024);
    LDS_WAIT();
#pragma unroll
    for (int dh = 0; dh < 2; ++dh)
#pragma unroll
        for (int r = 0; r < 16; ++r) *(LAS bf16*)(stw + ((r & 3) + 8 * (r >> 2)) * 128 + 64 * dh) = (bf16)(cvtpk(sg[dh][r], 0.f) & 0xffffu);
    LDS_WAIT();
#pragma unroll
    for (int i = 0; i < 4; ++i) t2[i] = *(const LAS v4u*)(str_ + i * 1024);
    LDS_WAIT();
#pragma unroll
    for (int i = 0; i < 4; ++i) {
        const size_t grow = (size_t)(R0 + 32 * qb + 8 * i + (lane >> 3)); const int ch = 128 * g + 64 * hh + 8 * (lane & 7);
        float a[8], s[8], ga[8], gb[8], u[8], o8[8];
        unpack8(t1[i], a); unpack8(t2[i], s); unpack8(mga[i], ga); unpack8(mgb[i], gb); unpack8(mu[i], u);
#pragma unroll
        for (int k = 0; k < 8; ++k) o8[k] = ga[k] * a[k] + gb[k] * (u[k] * (s[k] + bsv[i]));
        *(v4u*)(MERGED + grow * DM + ch) = pack8(o8);
    }
}
constexpr int SM_K = 0, SM_V = 33792, SM_Q = SM_V + 129 * 64 * 4, SM_S = SM_Q + 2048, SM_R = SM_S + 8 * 132 * 4, SM_END = SM_R + 64;
static_assert(SM_K + 129 * 65 * 4 <= SM_V && SM_END <= RING_BYTES, "sample mixer LDS");
__device__ __forceinline__ void mixer_sample_item(LAS unsigned char* lds, const bf16* __restrict__ Z, bf16* __restrict__ MERGED, const float* __restrict__ cache_k, const float* __restrict__ cache_v,
                                                  const float* __restrict__ sinks, const float* __restrict__ rel_bias, const float* __restrict__ lng, const float* __restrict__ lnb,
                                                  const float* __restrict__ w_s, const float* __restrict__ b_s, float* __restrict__ out, int item, int tid, int lane, int wave) {
    asm volatile("" : "+v"(tid), "+v"(lane));
    const int kvh = item & 3, sb = item >> 2; const size_t zrow = (size_t)(MPROMPT + sb) * DIN;
    LAS float* KS = (LAS float*)(lds + SM_K); LAS float* VS = (LAS float*)(lds + SM_V); LAS float* QS = (LAS float*)(lds + SM_Q); LAS float* SC = (LAS float*)(lds + SM_S); LAS float* RED = (LAS float*)(lds + SM_R);
    const int head = 8 * kvh + wave, ch = 64 * head + lane, grp = ch >> 7;
    float kc[16], vc[16];
#pragma unroll
    for (int i = 0; i < 16; ++i) { const size_t ci = ((size_t)(sb * 128 + 8 * i + wave) * 4 + kvh) * 64 + lane; kc[i] = cache_k[ci]; vc[i] = cache_v[ci]; }
    const float knew = bf1(Z[zrow + CK + 64 * kvh + lane]), vnew = bf1(Z[zrow + CV + 64 * kvh + lane]);
    const float qv = bf1(Z[zrow + CQ + 64 * head + lane]);
    const v2u gvw = *(const v2u*)(Z + zrow + CG + 4 * tid);
    const float gvc = bf1(Z[zrow + CG + ch]), uc = bf1(Z[zrow + CU + ch]), gac = bf1(Z[zrow + CGA + ch]), gbc = bf1(Z[zrow + CGB + ch]);
    const float lg = lng[ch], lb = lnb[ch], ws0 = w_s[(size_t)grp * 128 * 128], bs0 = b_s[grp * 128], sk = sinks[head] * LOG2E;
    __syncthreads();
#pragma unroll
    for (int i = 0; i < 16; ++i) { const int j = 8 * i + wave; KS[j * 65 + lane] = kc[i]; VS[j * 64 + lane] = vc[i];
        if (j >= 1) { const size_t co = ((size_t)(sb * 128 + j - 1) * 4 + kvh) * 64 + lane; out[O_KS + co] = kc[i]; out[O_VS + co] = vc[i]; } }
    if (wave == 0) { KS[128 * 65 + lane] = knew; VS[128 * 64 + lane] = vnew; }
    QS[tid] = qv;
    { const float g0 = bflo(gvw.x), g1 = bfhi(gvw.x), g2 = bflo(gvw.y), g3 = bfhi(gvw.y);
      const float a = wave_sum((g0 + g1) + (g2 + g3)), q = wave_sum((g0 * g0 + g1 * g1) + (g2 * g2 + g3 * g3));
      if (lane == 0) { RED[wave] = a; RED[8 + wave] = q; } }
    __syncthreads();
    for (int e = tid; e < 8 * 129; e += 512) {
        const int h8 = e / 129, j = e - 129 * h8; float dot = 0.f;
#pragma unroll 16
        for (int d = 0; d < 64; ++d) dot += QS[h8 * 64 + d] * KS[j * 65 + d];
        SC[h8 * 132 + j] = dot + rel_bias[t5_bucket(128 - j) * 32 + 8 * kvh + h8] * LOG2E;
    }
    __syncthreads();
    { const float s0 = SC[wave * 132 + lane], s1 = SC[wave * 132 + 64 + lane], s2 = (lane == 0) ? SC[wave * 132 + 128] : -1e30f;
      const float m = fmaxf(wave_max(fmaxf(fmaxf(s0, s1), s2)), sk);
      const float e0 = fast_exp2(s0 - m), e1 = fast_exp2(s1 - m), e2 = fast_exp2(s2 - m);
      const float inv = 1.0f / (wave_sum(e0 + e1 + e2) + fast_exp2(sk - m));
      SC[wave * 132 + lane] = e0 * inv; SC[wave * 132 + 64 + lane] = e1 * inv; if (lane == 0) SC[wave * 132 + 128] = e2 * inv; }
    LDS_WAIT();
    float ya = 0.f;
#pragma unroll 3
    for (int j = 0; j < 129; ++j) ya += SC[wave * 132 + j] * VS[j * 64 + lane];
    float s1 = 0.f, s2 = 0.f;
#pragma unroll
    for (int w = 0; w < 8; ++w) { s1 += RED[w]; s2 += RED[8 + w]; }
    const float mean = s1 * (1.0f / DM), var = s2 * (1.0f / DM) - mean * mean, rstd = rsqrtf(fmaxf(var, 0.f) + EPS);
    const float vn = (gvc - mean) * rstd * lg + lb;
    out[O_SG + (size_t)sb * DM + ch] = vn;
    const float mg = gac * ya + gbc * (uc * (ws0 * vn + bs0));
    MERGED[(size_t)(MPROMPT + sb) * DM + ch] = (bf16)(cvtpk(mg, 0.f) & 0xffffu);
}
constexpr int NWAVES = 8, G_NOM = 256;
constexpr int CW_BAR = 4096;
static_assert((CW_BAR + XCD_BAR_WORDS) * 4 <= (int)CTL_ZERO_BYTES, "control words inside the memset region");
constexpr int N_PHASES = 10;
struct Args { const float* in[26]; float* out; unsigned char* ws; int ph_lo, ph_hi; };

__global__ void __launch_bounds__(NWAVES * 64, 2) fwd_kernel(Args args) {
    extern __shared__ __attribute__((aligned(16))) unsigned char lds_raw[];
    LAS unsigned char* lds = (LAS unsigned char*)lds_raw;
    volatile LAS unsigned* MISC = (volatile LAS unsigned*)(lds + MISC_OFF);
    const int tid = threadIdx.x, lane = tid & 63, wave = __builtin_amdgcn_readfirstlane(tid >> 6);
    const int G = gridDim.x, bx = blockIdx.x, vcu = (G % 8 == 0) ? (bx % 8) * (G / 8) + bx / 8 : bx;
    const int gw = vcu * NWAVES + wave, NGW = G * NWAVES;
    unsigned char* ws = args.ws; float* out = args.out;
    gu32* ctl = (gu32*)(ws + WS_CTL);
    float* MOD = (float*)(ws + WS_MOD); f32x2* STAT = (f32x2*)(ws + WS_STAT); bf16* TRIL = (bf16*)(ws + WS_TRIL);
    bf16* WO_T = (bf16*)(ws + WS_WO); bf16* WGU_T = (bf16*)(ws + WS_WGU); bf16* WD_T = (bf16*)(ws + WS_WD); bf16* WIN_T = (bf16*)(ws + WS_WIN);
    bf16* Zb = (bf16*)(ws + WS_Z); bf16* Ob = (bf16*)(ws + WS_O); bf16* ABUF = (bf16*)(ws + WS_ABUF); bf16* UBUF = (bf16*)(ws + WS_UBUF); bf16* H2 = (bf16*)(ws + WS_H2); bf16* YF = (bf16*)(ws + WS_YF);
    float* SLAB = (float*)(ws + WS_SLAB); bf16* SLABGU = (bf16*)(ws + WS_SLABGU);
    bf16* Hb = (bf16*)out;
    for (int u = tid; u < 32; u += NWAVES * 64) MISC[u] = 0u;
    __syncthreads();
    const int lo = args.ph_lo, hi = args.ph_hi;
    const bool one_launch = (hi - lo) > 1;
    XcdBarrier bar; bar.bar = (unsigned*)(ctl + CW_BAR); bar.x = 0; bar.st = nullptr;
    if (one_launch) bar = xcd_barrier_post((unsigned*)(ctl + CW_BAR), MISC + 8);
#define IN(k) (lo <= (k) && (k) < hi)
#ifndef PROBE_PHASE
#define PROBE_PHASE -1
#endif
    unsigned long long pt0 = 0ull, pt1 = 0ull;
#define SEAM(k) do { if (IN(k) && IN((k) + 1)) xcd_barrier(bar); if (PROBE_PHASE == (k) + 1) pt0 = __builtin_amdgcn_s_memrealtime(); if (PROBE_PHASE == (k)) pt1 = __builtin_amdgcn_s_memrealtime(); } while (0)
    if (PROBE_PHASE == 0) pt0 = __builtin_amdgcn_s_memrealtime();

    if (IN(0)) {
        if (bx < NMODC / 64) p0_mod_item(lds, args.in[2], args.in[3], args.in[7], args.in[8], MOD, bx, tid, lane, wave);
        constexpr int T_IN = 32 * 168, T_O = 32 * 32, T_G = 32 * 88, T_D = 88 * 32, T_ALL = T_IN + T_O + 2 * T_G + T_D;
        constexpr int NMB = NMODC / 64, T_HEAD = (G_NOM - NMB) * NWAVES * 2;
        const bool head_ok = (G > NMB);
        for (int pass = 0; pass < 2; ++pass) {
            int it, step, end;
            if (pass == 0) { if (!head_ok || bx < NMB) continue; it = (bx - NMB) * NWAVES + wave; step = (G - NMB) * NWAVES; end = T_HEAD; }
            else { it = (head_ok ? T_HEAD : 0) + gw; step = NGW; end = T_ALL; }
            for (; it < end; it += step) {
                int r = it;
                if (r < T_IN) { p0_transpose_tile(args.in[13], DM, DIN, WIN_T, r, lane); continue; } r -= T_IN;
                if (r < T_O) { p0_transpose_tile(args.in[14], DM, DM, WO_T, r, lane); continue; } r -= T_O;
                if (r < T_G) { p0_transpose_tile(args.in[22], DM, DFF, WGU_T, r, lane); continue; } r -= T_G;
                if (r < T_G) { p0_transpose_tile(args.in[21], DM, DFF, WGU_T + (size_t)DFF * DM, r, lane); continue; } r -= T_G;
                p0_transpose_tile(args.in[25], DFF, DM, WD_T, r, lane);
            }
        }
        { const float* w_s = args.in[19];
          for (int it = vcu * 512 + tid; it < 16 * 128 * 128 / 8; it += G * 512) { const int e0 = 8 * it, j0 = e0 & 127, i = (e0 >> 7) & 127;
              const f32x4 a = *(const f32x4*)(w_s + e0), b = *(const f32x4*)(w_s + e0 + 4); float v[8];
#pragma unroll
              for (int k = 0; k < 4; ++k) { v[k] = (j0 + k <= i) ? a[k] : 0.f; v[4 + k] = (j0 + 4 + k <= i) ? b[k] : 0.f; }
              *(v4u*)(TRIL + e0) = pack8(v); } }
    }
    SEAM(0);
    if (IN(1)) p1_rows(lds, args.in[0], args.in[1], args.in[9], MOD, Hb, gw, NGW, tid, lane);
    SEAM(1);
    if (IN(2)) {
        pg8::Gemm g{Hb, WIN_T, MPROMPT, DIN, DM}; pg8::SplitOrder S; S.init(MPROMPT, DIN, DM, 1, G, bx);
        pg8::EpiZ E{Zb, out, STAT};
        pg8::gemm_phase<pg8::EpiZ, pg8::SplitOrder, PG8_ALIGN, PG8_SP2>(lds, g, S, E);
    }
    SEAM(2);
    if (IN(3)) {
        for (int it = vcu; it < 2048; it += G) mixer_prompt_item(lds, Zb, STAT, TRIL, Hb, args.in[15], args.in[16], args.in[17], args.in[18], args.in[20], it, tid, lane, wave);
        for (int it = vcu; it < 512; it += G) mixer_sample_item(lds, Zb, Hb, args.in[4], args.in[5], args.in[15], args.in[16], args.in[17], args.in[18], args.in[19], args.in[20], out, it, tid, lane, wave);
    }
    SEAM(3);
    if (IN(4)) {
        pg8::Gemm g{Hb, WO_T, MPROMPT, DM, DM}; pg8::SplitOrder S; S.init(MPROMPT, DM, DM, SK_KS_O, G, bx);
        pg8::EpiPlain E{Ob, DM, SLAB};
        pg8::gemm_phase<pg8::EpiPlain, pg8::SplitOrder, PG8_ALIGN, PG8_SP2>(lds, g, S, E);
    }
    SEAM(4);
    if (IN(5)) p5_rows(lds, args.in[0], args.in[1], Ob, SLAB, args.in[10], args.in[11], MOD, out, H2, gw, NGW, tid, lane);
    SEAM(5);
    if (IN(6)) {
        pg8::Gemm g{H2, WGU_T, MPROMPT, 2 * DFF, DM}; pg8::SplitOrder S; S.init(MPROMPT, 2 * DFF, DM, SK_KS_G, G, bx);
        pg8::EpiGU E{ABUF, UBUF, out, SLABGU};
        pg8::gemm_phase<pg8::EpiGU, pg8::SplitOrder, PG8_ALIGN, PG8_SP2>(lds, g, S, E);
    }
    SEAM(6);
    if (IN(7)) {
        p7_prompt(ABUF, UBUF, args.in[23], args.in[24], gw, NGW, lane);
        p7_sample(SLABGU, UBUF, args.in[6], args.in[23], args.in[24], out, vcu * 512 + tid, G * 512);
    }
    SEAM(7);
    if (IN(8)) {
        pg8::Gemm g{UBUF, WD_T, MPROMPT, DM, DFF}; pg8::SplitOrder S; S.init(MPROMPT, DM, DFF, SK_KS_D, G, bx);
        pg8::EpiPlain E{YF, DM, SLAB};
        pg8::gemm_phase<pg8::EpiPlain, pg8::SplitOrder, PG8_ALIGN, PG8_SP2>(lds, g, S, E);
    }
    SEAM(8);
    if (IN(9)) p9_rows(lds, YF, SLAB, args.in[12], MOD, out, gw, NGW, tid, lane);
    if (PROBE_PHASE >= 0) { if (PROBE_PHASE == 9) pt1 = __builtin_amdgcn_s_memrealtime();
        if (bx == 0 && tid == 0) { const unsigned long long te = __builtin_amdgcn_s_memrealtime(), dl = 4ull * (pt1 - pt0); while (__builtin_amdgcn_s_memrealtime() - te < dl) __builtin_amdgcn_s_sleep(32); } }
#undef IN
#undef SEAM
}

#ifndef MK_ONE_LAUNCH
#define MK_ONE_LAUNCH 1
#endif
extern "C" void kernel_launch(void* const* d_in, const int* in_sizes, int n_in, void* d_out, int out_size, void* d_ws, size_t ws_size, hipStream_t stream) {
    static int grid = 0;
    if (grid == 0) {
        if (n_in != 26 || in_sizes[0] != MPROMPT * DM || out_size != (int)O_END || ws_size < WS_END) {
            fprintf(stderr, "kernel_launch: unexpected problem shape (n_in %d, in0 %d, out %d, ws %zu); nothing launched\n", n_in, n_in > 0 ? in_sizes[0] : -1, out_size, ws_size); grid = -1; return; }
        int dev = 0, cus = 0, per_cu = 0;
        if (hipGetDevice(&dev) != hipSuccess || hipDeviceGetAttribute(&cus, hipDeviceAttributeMultiprocessorCount, dev) != hipSuccess) { grid = -1; return; }
        if (hipFuncSetAttribute((const void*)fwd_kernel, hipFuncAttributeMaxDynamicSharedMemorySize, LDS_BYTES) != hipSuccess) { fprintf(stderr, "kernel_launch: hipFuncSetAttribute failed\n"); grid = -1; return; }
        if (hipOccupancyMaxActiveBlocksPerMultiprocessor(&per_cu, (const void*)fwd_kernel, NWAVES * 64, LDS_BYTES) != hipSuccess || per_cu < 1) { fprintf(stderr, "kernel_launch: occupancy query says %d blocks per CU; nothing launched\n", per_cu); (void)hipGetLastError(); grid = -1; return; }
        grid = cus;
    }
    if (grid < 0) return;
    if (hipMemsetAsync((char*)d_ws + WS_CTL, 0, CTL_ZERO_BYTES, stream) != hipSuccess) return;
    Args a{};
    for (int i = 0; i < 26; ++i) a.in[i] = (const float*)d_in[i];
    a.out = (float*)d_out; a.ws = (unsigned char*)d_ws;
#if MK_ONE_LAUNCH
    a.ph_lo = 0; a.ph_hi = N_PHASES;
    void* kargs[] = {&a};
    hipError_t e = hipLaunchCooperativeKernel((const void*)fwd_kernel, dim3(grid), dim3(NWAVES * 64), kargs, LDS_BYTES, stream);
    if (e != hipSuccess) fprintf(stderr, "kernel_launch: cooperative launch failed: %s (grid %d)\n", hipGetErrorString(e), grid);
#else
    for (int p = 0; p < N_PHASES; ++p) { a.ph_lo = p; a.ph_hi = p + 1; hipLaunchKernelGGL(fwd_kernel, dim3(grid), dim3(NWAVES * 64), LDS_BYTES, stream, a); }
#endif
}
```

```cpp
#include <hip/hip_runtime.h>
#include <cstdio>
#include <cstdint>

constexpr int DM = 2048, SEQ = 8192, NBATCH = 2, MPROMPT = NBATCH * SEQ, NSAMP = 128, MTOK = MPROMPT + NSAMP, MPAD = 16640;
constexpr int DIN = 10752, DFF = 5632, NMODC = 12288, NMODR = 130;
constexpr int CQ = 0, CK = 2048, CV = 2304, CU = 2560, CG = 4608, CGA = 6656, CGB = 8704;
constexpr float EPS = 1e-6f, LOG2E = 1.4426950408889634f, QSCALE = 0.125f * 1.4426950408889634f;
constexpr size_t O_YP = 0, O_YS = 33554432, O_KP = 33816576, O_VP = 33882112, O_CP = 33947648, O_KS = 33970176, O_VS = 38164480, O_CS = 42358784, O_SG = 43800576, O_END = 44062720;

constexpr size_t KiB = 1024, MiB = 1u << 20;
constexpr size_t WS_CTL = 0, CTL_ZERO_BYTES = 64 * KiB;
constexpr size_t WS_SILU = 128 * KiB;
constexpr size_t WS_MOD = 1 * MiB;
constexpr size_t WS_STAT = WS_MOD + 6656 * KiB;
constexpr size_t WS_TRIL = WS_STAT + 4352 * KiB;
constexpr size_t WS_WO = WS_TRIL + 512 * KiB;
constexpr size_t WS_WGU = WS_WO + 8 * MiB;
constexpr size_t WS_WD = WS_WGU + 44 * MiB;
constexpr size_t WS_ARENA = WS_WD + 22 * MiB;
constexpr size_t WS_WIN = WS_ARENA;
constexpr size_t WS_Z = WS_ARENA + 42 * MiB;
constexpr size_t WS_O = WS_ARENA;
constexpr size_t WS_ABUF = WS_ARENA;
constexpr size_t WS_UBUF = WS_ABUF + (size_t)MPAD * DFF * 2;
constexpr size_t WS_H2 = WS_UBUF + (size_t)MPAD * DFF * 2;
constexpr size_t WS_YF = WS_ABUF;
constexpr size_t WS_SLAB = WS_ARENA + 128 * MiB;
constexpr size_t WS_SLABGU = WS_STAT;
constexpr size_t WS_END = WS_H2 + (size_t)MPAD * DM * 2;
static_assert(WS_MOD + (size_t)NMODR * NMODC * 4 <= WS_STAT && WS_STAT + (size_t)32 * MPAD * 8 <= WS_TRIL, "ws map");
static_assert(WS_Z + (size_t)MPAD * DIN * 2 <= 512 * MiB && WS_END <= 512 * MiB, "ws map exceeds 512 MiB");
static_assert(WS_SLABGU + (size_t)4 * NSAMP * 2 * DFF * 2 <= WS_WGU && WS_SLAB + (size_t)22 * NSAMP * DM * 4 <= WS_UBUF, "slab regions");

constexpr int RING_BYTES = 131072;
constexpr int MISC_OFF = 143360;
constexpr int LDS_BYTES = 147456;

#define GAS __attribute__((address_space(1)))
#define LAS __attribute__((address_space(3)))
typedef unsigned short bf16;
typedef unsigned v4u __attribute__((ext_vector_type(4)));
typedef unsigned v2u __attribute__((ext_vector_type(2)));
typedef float f32x2 __attribute__((ext_vector_type(2)));
typedef float f32x4 __attribute__((ext_vector_type(4)));
typedef float f32x16 __attribute__((ext_vector_type(16)));
typedef short bf16x8 __attribute__((ext_vector_type(8)));
typedef short s16x4 __attribute__((ext_vector_type(4)));
typedef __bf16 bf16x2_t __attribute__((ext_vector_type(2)));
typedef GAS unsigned gu32;
#define RLX_AGENT __ATOMIC_RELAXED, __HIP_MEMORY_SCOPE_AGENT
#define LDS_WAIT() asm volatile("s_waitcnt lgkmcnt(0)" ::: "memory")
#define VM_WAIT() asm volatile("s_waitcnt vmcnt(0)" ::: "memory")

__device__ __forceinline__ unsigned cvtpk(float lo, float hi) { f32x2 v = {lo, hi}; bf16x2_t b = __builtin_convertvector(v, bf16x2_t); return __builtin_bit_cast(unsigned, b); }
__device__ __forceinline__ float bflo(unsigned w) { return __uint_as_float(w << 16); }
__device__ __forceinline__ float bfhi(unsigned w) { return __uint_as_float(w & 0xffff0000u); }
__device__ __forceinline__ float bf1(bf16 b) { return __uint_as_float((unsigned)b << 16); }
__device__ __forceinline__ float fast_rcp(float x) { return __builtin_amdgcn_rcpf(x); }
__device__ __forceinline__ float fast_exp2(float x) { return __builtin_amdgcn_exp2f(x); }
__device__ __forceinline__ float sigmoid_f(float x) { return fast_rcp(1.0f + fast_exp2(-LOG2E * x)); }
__device__ __forceinline__ float gelu_f(float x) { const float u = x * (0.7978845608028654f + 0.035677408136300125f * x * x); return x * fast_rcp(1.0f + fast_exp2(-2.0f * LOG2E * u)); }
__device__ __forceinline__ float silu_f(float x) { return x * sigmoid_f(x); }
__device__ __forceinline__ float wave_sum(float v) {
#pragma unroll
    for (int o = 1; o < 64; o <<= 1) v += __shfl_xor(v, o);
    return v;
}
__device__ __forceinline__ float wave_max(float v) {
#pragma unroll
    for (int o = 1; o < 64; o <<= 1) v = fmaxf(v, __shfl_xor(v, o));
    return v;
}
__device__ __forceinline__ int t5_bucket(int d) {
    if (d < 16) return d;
    int b = 16;
    b += d >= 19; b += d >= 21; b += d >= 24; b += d >= 27; b += d >= 31; b += d >= 35; b += d >= 40; b += d >= 46; b += d >= 52; b += d >= 59; b += d >= 67; b += d >= 77; b += d >= 87; b += d >= 99; b += d >= 113;
    return b;
}
namespace pg8 {
#define PG8_LAS __attribute__((address_space(3)))
typedef unsigned short bf16_t;
typedef short bf16x8 __attribute__((ext_vector_type(8)));
typedef float f32x4 __attribute__((ext_vector_type(4)));
typedef unsigned u32x4 __attribute__((ext_vector_type(4)));
constexpr int BM = 256, BK = 64, HALF = 128, HTB = HALF * BK * 2  , STAGE_BYTES = 8 * HTB, NXCD = 8, WGM = 8;

__host__ __device__ __forceinline__ int lds_byte(int r, int c) { const int st = (r >> 4) * 2 + (c >> 5), rr = r & 15, cc = c & 31, ob = rr * 64 + cc * 2; return st * 1024 + (ob ^ (((ob >> 9) & 1) << 5)); }
__host__ __device__ __forceinline__ void stage_rc(int b, int& R, int& C) { const int st = b / 1024, sb = b % 1024, swz = sb ^ (((sb >> 9) & 1) << 5); R = (st >> 1) * 16 + swz / 64; C = (st & 1) * 32 + (swz % 64) / 2; }
__host__ __device__ __forceinline__ int perm32(int rho) { const int n = rho >> 4, i = rho & 15; return 8 * (i >> 2) + 4 * n + (i & 3); }

struct Unit { int pm, pn, kt0, nt, sl; };
struct Gemm { const bf16_t* A; const bf16_t* Bt; int M, N, K; };

struct StaticOrder {
    int nM, nN, nwg, G, c;
    __host__ __device__ void init(int M, int N, int G_, int c_) { nM = M / BM; nN = N / BM; nwg = nM * nN; G = G_; c = c_; }
    __host__ __device__ bool next(int i, Unit& u) const {
        const long L = (long)i * G + c; if (L >= nwg) return false;
        int wgid = (int)L; { const int q = nwg / NXCD, r = nwg % NXCD, xcd = wgid % NXCD, off = wgid / NXCD; wgid = (xcd < r ? xcd * (q + 1) : r * (q + 1) + (xcd - r) * q) + off; }
        const int nig = WGM * nN, gid = wgid / nig, fm = gid * WGM, gsz = (nM - fm) < WGM ? (nM - fm) : WGM;
        u.pm = fm + ((wgid % nig) % gsz); u.pn = (wgid % nig) / gsz; return true;
    }
    __device__ __forceinline__ void a_ready(const Unit&) const {}
    __device__ __forceinline__ void done(const Unit&) const {}
};
struct SplitOrder {
    int nM, nN, nwg, G, c, KT, KS;
    __host__ __device__ void init(int M, int N, int K, int KS_, int G_, int c_) { nM = M / BM; nN = N / BM; nwg = nM * nN; G = G_; c = c_; KT = K / BK; KS = KS_; }
    __host__ __device__ bool next(int i, Unit& u) const {
        const long L = (long)i * G + c; const bool mainu = L < nwg; const long Ls = L - nwg; const bool samp = !mainu && Ls < (long)nN * KS;
        int wgid = mainu ? (int)L : 0; { const int q = nwg / NXCD, r = nwg % NXCD, xcd = wgid % NXCD, off = wgid / NXCD; wgid = (xcd < r ? xcd * (q + 1) : r * (q + 1) + (xcd - r) * q) + off; }
        const int nig = WGM * nN, gid = wgid / nig, fm = gid * WGM, gsz = (nM - fm) < WGM ? (nM - fm) : WGM;
        const int pm_main = fm + ((wgid % nig) % gsz), pn_main = (wgid % nig) / gsz;
        const int idx = samp ? (int)Ls : 0, ks = idx / nN, ntS = KT / KS;
        u.pm = mainu ? pm_main : nM; u.pn = mainu ? pn_main : idx - ks * nN; u.nt = mainu ? KT : ntS; u.kt0 = mainu ? 0 : ks * ntS; u.sl = (mainu || KS == 1) ? -1 : ks;
        return mainu || samp;
    }
    __device__ __forceinline__ void a_ready(const Unit&) const {}
    __device__ __forceinline__ void done(const Unit&) const {}
};

__device__ __forceinline__ void store8(bf16_t* p, const f32x4 v0, const f32x4 v1) {
    u32x4 w; w.x = cvtpk(v0[0], v0[1]); w.y = cvtpk(v0[2], v0[3]); w.z = cvtpk(v1[0], v1[1]); w.w = cvtpk(v1[2], v1[3]); *(u32x4*)p = w;
}
__device__ __forceinline__ void store4(bf16_t* p, const f32x4 v) { v2u w; w.x = cvtpk(v[0], v[1]); w.y = cvtpk(v[2], v[3]); *(v2u*)p = w; }
struct EpiPlain {
    static constexpr bool PERM = true, AFTER_DRAIN = false;
    bf16_t* O; int ldc;
    float* slab;
    __device__ __forceinline__ void small(int srow, int col, const f32x4 v, int sl) const { *(f32x4*)(slab + ((size_t)sl * NSAMP + srow) * ldc + col) = v; }
    __device__ __forceinline__ void operator()(const f32x4 (&acc)[2][2][4][2], const Unit& u, int wr, int wc, int fr, int fq) const {
        const int row0 = u.pm * BM + wr * 64 + fr, col0 = u.pn * BM + wc * 32 + 8 * fq;
        if (u.sl >= 0) {
#pragma unroll
            for (int m = 0; m < 4; ++m) { float* rowp = slab + ((size_t)u.sl * NSAMP + wr * 64 + m * 16 + fr) * ldc + col0;
#pragma unroll
                for (int bj = 0; bj < 2; ++bj) { *(f32x4*)(rowp + bj * HALF) = acc[0][bj][m][0]; *(f32x4*)(rowp + bj * HALF + 4) = acc[0][bj][m][1]; } }
            return; }
#pragma unroll
        for (int ai = 0; ai < 2; ++ai)
#pragma unroll
            for (int m = 0; m < 4; ++m) { bf16_t* rowp = O + (size_t)(row0 + ai * HALF + m * 16) * ldc + col0;
#pragma unroll
                for (int bj = 0; bj < 2; ++bj) store8(rowp + bj * HALF, acc[ai][bj][m][0], acc[ai][bj][m][1]); }
    }
};
struct EpiZ {
    static constexpr bool PERM = true, AFTER_DRAIN = false;
    bf16_t* Z; float* out; f32x2* stat;
    __device__ __forceinline__ void small(int srow, int col, f32x4 v, int) const {
        if (col < CK) v = v * QSCALE;
        else if (col < CU) { float* d = out + (col < CV ? O_KS + (size_t)(srow * 128 + 127) * 256 + (col - CK) : O_VS + (size_t)(srow * 128 + 127) * 256 + (col - CV)); *(f32x4*)d = v; }
        else if (col < CGA) {
#pragma unroll
            for (int i = 0; i < 4; ++i) v[i] = gelu_f(v[i]);
        } else {
#pragma unroll
            for (int i = 0; i < 4; ++i) v[i] = sigmoid_f(v[i]);
        }
        store4(Z + (size_t)(MPROMPT + srow) * DIN + col, v);
    }
    __device__ __forceinline__ void operator()(const f32x4 (&acc)[2][2][4][2], const Unit& u, int wr, int wc, int fr, int fq) const {
        const int pn = u.pn, row0 = u.pm * BM + wr * 64 + fr, cw = wc * 32 + 8 * fq, col0 = pn * BM + cw;
        if (pn < 8) {
#pragma unroll
            for (int ai = 0; ai < 2; ++ai)
#pragma unroll
                for (int m = 0; m < 4; ++m) { bf16_t* rowp = Z + (size_t)(row0 + ai * HALF + m * 16) * DIN + col0;
#pragma unroll
                    for (int bj = 0; bj < 2; ++bj) store8(rowp + bj * HALF, acc[ai][bj][m][0] * QSCALE, acc[ai][bj][m][1] * QSCALE); }
        } else if (pn < 10) {
            const size_t o_p = (pn == 8) ? O_KP : O_VP, o_s = (pn == 8) ? O_KS : O_VS;
#pragma unroll
            for (int ai = 0; ai < 2; ++ai)
#pragma unroll
                for (int m = 0; m < 4; ++m) { const int lr = wr * 64 + m * 16 + fr; bf16_t* rowp = Z + (size_t)(row0 + ai * HALF + m * 16) * DIN + col0;
#pragma unroll
                    for (int bj = 0; bj < 2; ++bj) { const f32x4 v0 = acc[ai][bj][m][0], v1 = acc[ai][bj][m][1]; store8(rowp + bj * HALF, v0, v1);
                        if (ai == 1 && (u.pm == 31 || u.pm == 63)) { float* d = out + o_p + (size_t)((u.pm >> 5) * 128 + lr) * 256 + cw + bj * HALF; *(f32x4*)d = v0; *(f32x4*)(d + 4) = v1; }
                        if (ai == 0 && u.pm == 64) { float* d = out + o_s + (size_t)(lr * 128 + 127) * 256 + cw + bj * HALF; *(f32x4*)d = v0; *(f32x4*)(d + 4) = v1; } } }
        } else if (pn < 26) {
#pragma unroll
            for (int ai = 0; ai < 2; ++ai)
#pragma unroll
                for (int m = 0; m < 4; ++m) { const int row = row0 + ai * HALF + m * 16; bf16_t* rowp = Z + (size_t)row * DIN + col0; float s1 = 0.f, s2 = 0.f;
#pragma unroll
                    for (int bj = 0; bj < 2; ++bj) { f32x4 v0 = acc[ai][bj][m][0], v1 = acc[ai][bj][m][1];
#pragma unroll
                        for (int i = 0; i < 4; ++i) { v0[i] = gelu_f(v0[i]); v1[i] = gelu_f(v1[i]); s1 += v0[i] + v1[i]; s2 += v0[i] * v0[i] + v1[i] * v1[i]; }
                        store8(rowp + bj * HALF, v0, v1); }
                    if (pn >= 18) { s1 += __shfl_xor(s1, 16); s1 += __shfl_xor(s1, 32); s2 += __shfl_xor(s2, 16); s2 += __shfl_xor(s2, 32);
                        if (fq == 0) stat[(size_t)((pn - 18) * 4 + wc) * MPAD + row] = (f32x2){s1, s2}; } }
        } else {
#pragma unroll
            for (int ai = 0; ai < 2; ++ai)
#pragma unroll
                for (int m = 0; m < 4; ++m) { bf16_t* rowp = Z + (size_t)(row0 + ai * HALF + m * 16) * DIN + col0;
#pragma unroll
                    for (int bj = 0; bj < 2; ++bj) { f32x4 v0 = acc[ai][bj][m][0], v1 = acc[ai][bj][m][1];
#pragma unroll
                        for (int i = 0; i < 4; ++i) { v0[i] = sigmoid_f(v0[i]); v1[i] = sigmoid_f(v1[i]); }
                        store8(rowp + bj * HALF, v0, v1); } }
        }
    }
};
__device__ __forceinline__ float dpp_shr1(float old, float src) { return __int_as_float(__builtin_amdgcn_update_dpp(__float_as_int(old), __float_as_int(src), 0x111, 0xf, 0xf, false)); }
__device__ __forceinline__ float dpp_ror1(float src) { return __int_as_float(__builtin_amdgcn_update_dpp(0, __float_as_int(src), 0x121, 0xf, 0xf, false)); }
struct EpiGUF {
    static constexpr bool PERM = true, AFTER_DRAIN = false;
    bf16_t* HID; float* out; bf16_t* slab; float* AH; float* A01; float* U01; const float* conv_w; const float* conv_b; LAS float* halo;
    __device__ __forceinline__ void operator()(const f32x4 (&acc)[2][2][4][2], const Unit& u, int wr, int wc, int fr, int fq) const {
        if (u.sl >= 0) {
#pragma unroll
            for (int m = 0; m < 4; ++m) { bf16_t* rowp = slab + ((size_t)u.sl * NSAMP + wr * 64 + m * 16 + fr) * (2 * DFF) + u.pn * BM + wc * 32 + 8 * fq;
#pragma unroll
                for (int bj = 0; bj < 2; ++bj) store8(rowp + bj * HALF, acc[0][bj][m][0], acc[0][bj][m][1]); }
            return; }
        const int cl = wc * 32 + 8 * fq, hc = u.pn * HALF + cl;
        if (fr >= 14) {
#pragma unroll
            for (int ai = 0; ai < 2; ++ai) { LAS float* h = halo + ((2 * ai + wr) * 2 + (fr - 14)) * HALF + cl; *(LAS f32x4*)h = acc[ai][0][3][0]; *(LAS f32x4*)(h + 4) = acc[ai][0][3][1]; }
            if (wr == 1) { float* d = AH + ((size_t)u.pm * 2 + (fr - 14)) * DFF + hc; *(f32x4*)d = acc[1][0][3][0]; *(f32x4*)(d + 4) = acc[1][0][3][1];
                if (u.pm == 31 || u.pm == 63) { float* e = out + O_CP + (size_t)((u.pm >> 5) * 2 + (fr - 14)) * DFF + hc; *(f32x4*)e = acc[1][0][3][0]; *(f32x4*)(e + 4) = acc[1][0][3][1]; } }
        }
        if (fr < 2 && wr == 0) { float* d = A01 + ((size_t)u.pm * 2 + fr) * DFF + hc; *(f32x4*)d = acc[0][0][0][0]; *(f32x4*)(d + 4) = acc[0][0][0][1];
            float* e = U01 + ((size_t)u.pm * 2 + fr) * DFF + hc; *(f32x4*)e = acc[0][1][0][0]; *(f32x4*)(e + 4) = acc[0][1][0][1]; }
        f32x4 w0[2], w1[2], w2[2], bb[2];
#pragma unroll
        for (int n = 0; n < 2; ++n) { w0[n] = *(const f32x4*)(conv_w + hc + 4 * n); w1[n] = *(const f32x4*)(conv_w + DFF + hc + 4 * n); w2[n] = *(const f32x4*)(conv_w + 2 * DFF + hc + 4 * n); bb[n] = *(const f32x4*)(conv_b + hc + 4 * n); }
        asm volatile("s_waitcnt lgkmcnt(0)" ::: "memory"); __builtin_amdgcn_s_barrier(); asm volatile("" ::: "memory");
        const int row0 = u.pm * BM + wr * 64 + fr;
#pragma unroll
        for (int ai = 0; ai < 2; ++ai) {
            const int blk = 2 * ai + wr;
            f32x4 h1[2], h2[2];
#pragma unroll
            for (int n = 0; n < 2; ++n) { if (blk > 0) { const LAS float* hp = halo + ((blk - 1) * 2) * HALF + cl + 4 * n; h2[n] = *(const LAS f32x4*)hp; h1[n] = *(const LAS f32x4*)(hp + HALF); } else { h1[n] = (f32x4){0.f, 0.f, 0.f, 0.f}; h2[n] = h1[n]; } }
            f32x4 hv[4][2];
#pragma unroll
            for (int n = 0; n < 2; ++n)
#pragma unroll
                for (int i = 0; i < 4; ++i) { float x1 = h1[n][i], x2 = h2[n][i];
#pragma unroll
                    for (int m = 0; m < 4; ++m) { const float a = acc[ai][0][m][n][i], s1 = dpp_shr1(x1, a), s2 = dpp_shr1(x2, s1);
                        const float cv = bb[n][i] + w0[n][i] * s2 + w1[n][i] * s1 + w2[n][i] * a; hv[m][n][i] = gelu_f(cv) * acc[ai][1][m][n][i];
                        x1 = dpp_ror1(a); x2 = dpp_ror1(s1); } }
#pragma unroll
            for (int m = 0; m < 4; ++m) store8(HID + (size_t)(row0 + ai * HALF + m * 16) * DFF + hc, hv[m][0], hv[m][1]);
        }
    }
};
template <class Epi, class Sched, bool ALIGN_EPI = false, bool SP2 = false>
__device__ __forceinline__ void gemm_phase(PG8_LAS unsigned char* lds, const Gemm g, const Sched& S, const Epi& E) {
    const int tid = threadIdx.x, wid = __builtin_amdgcn_readfirstlane(tid >> 6), lane = tid & 63, wr = wid >> 2, wc = wid & 3, fr = lane & 15, fq = lane >> 4;
    const int K = g.K;
    unsigned voffA[2], voffB[2];
#pragma unroll
    for (int i = 0; i < 2; ++i) { int R, C; stage_rc(tid * 16 + i * 8192, R, C); const int Rb = Epi::PERM ? ((R & ~31) + perm32(R & 31)) : R;
        voffA[i] = (unsigned)(R * K + C) * 2u; voffB[i] = (unsigned)(Rb * K + C) * 2u; }
    const size_t kstep = (size_t)(BK * 2);
    const size_t hstep = (size_t)HALF * K * 2;
    const size_t tstep = 2 * hstep;
    const unsigned ldsw = (unsigned)wid * 1024u;
    const int aoff = lds_byte(wr * 64 + fr, fq * 8), boff = lds_byte(wc * 32 + fr, fq * 8);
#define PG8_SA(b, h) (((b) * 2 + (h)) * HTB)
#define PG8_SB(b, h) ((4 + (b) * 2 + (h)) * HTB)
#define PG8_STAGE(bufoff, gbase, voff) do { _Pragma("unroll") for (int _i = 0; _i < 2; ++_i) \
        __builtin_amdgcn_global_load_lds((const unsigned*)((const char*)(gbase) + (voff)[_i]), (PG8_LAS unsigned*)(lds + (bufoff) + ldsw + _i * 8192), 16, 0, 0); } while (0)
#define PG8_LDA(dst, b, h) do { _Pragma("unroll") for (int m = 0; m < 4; ++m) _Pragma("unroll") for (int k = 0; k < 2; ++k) dst[m][k] = *(const PG8_LAS bf16x8*)(lds + PG8_SA(b, h) + aoff + m * 2048 + k * 1024); } while (0)
#define PG8_LDB(dst, b, h) do { _Pragma("unroll") for (int n = 0; n < 2; ++n) _Pragma("unroll") for (int k = 0; k < 2; ++k) dst[n][k] = *(const PG8_LAS bf16x8*)(lds + PG8_SB(b, h) + boff + n * 2048 + k * 1024); } while (0)
#define PG8_MMA(ai, bj, At, Bt) do { __builtin_amdgcn_s_setprio(1); _Pragma("unroll") for (int m = 0; m < 4; ++m) _Pragma("unroll") for (int n = 0; n < 2; ++n) _Pragma("unroll") for (int k = 0; k < 2; ++k) \
        acc[ai][bj][m][n] = __builtin_amdgcn_mfma_f32_16x16x32_bf16(Bt[n][k], At[m][k], acc[ai][bj][m][n], 0, 0, 0); __builtin_amdgcn_s_setprio(0); } while (0)
#define PG8_WAIT_V(n) asm volatile("s_waitcnt vmcnt(" #n ")" ::: "memory")
#define PG8_WAIT_L(n) asm volatile("s_waitcnt lgkmcnt(" #n ")" ::: "memory")
#define PG8_BAR __builtin_amdgcn_s_barrier()
#define PG8_SCHED __builtin_amdgcn_sched_barrier(0)
    Unit cur, nxt; int ui = 0;
    if (!S.next(0, cur)) return;
    f32x4 acc[2][2][4][2];
#pragma unroll
    for (int a = 0; a < 2; ++a)
#pragma unroll
        for (int b = 0; b < 2; ++b)
#pragma unroll
            for (int m = 0; m < 4; ++m)
#pragma unroll
                for (int n = 0; n < 2; ++n) acc[a][b][m][n] = (f32x4){0.f, 0.f, 0.f, 0.f};
    bf16x8 At[4][2], B0[2][2], B1[2][2];
    const char* cA = (const char*)g.A + (size_t)cur.pm * tstep + (size_t)cur.kt0 * (BK * 2); const char* cB = (const char*)g.Bt + (size_t)cur.pn * tstep + (size_t)cur.kt0 * (BK * 2);
    S.a_ready(cur);
    if constexpr (SP2) {
        PG8_STAGE(PG8_SB(0, 0), cB, voffB); PG8_STAGE(PG8_SB(0, 1), cB + hstep, voffB); PG8_STAGE(PG8_SA(0, 0), cA, voffA); PG8_STAGE(PG8_SA(0, 1), cA + hstep, voffA);
        if (wr == 1) PG8_BAR;
        PG8_WAIT_V(2); PG8_BAR;
        PG8_STAGE(PG8_SB(1, 0), cB + kstep, voffB); PG8_STAGE(PG8_SA(1, 0), cA + kstep, voffA); PG8_STAGE(PG8_SB(1, 1), cB + hstep + kstep, voffB);
        PG8_WAIT_V(6); PG8_BAR;
    } else {
        PG8_STAGE(PG8_SB(0, 0), cB, voffB); PG8_STAGE(PG8_SA(0, 0), cA, voffA); PG8_STAGE(PG8_SB(0, 1), cB + hstep, voffB); PG8_STAGE(PG8_SA(0, 1), cA + hstep, voffA);
        if (wr == 1) PG8_BAR;
        PG8_WAIT_V(4); PG8_BAR;
        PG8_STAGE(PG8_SB(1, 0), cB + kstep, voffB); PG8_STAGE(PG8_SA(1, 0), cA + kstep, voffA); PG8_STAGE(PG8_SB(1, 1), cB + hstep + kstep, voffB);
        PG8_WAIT_V(6); PG8_BAR;
    }
    for (;;) {
        const bool has_next = S.next(ui + 1, nxt);
        const char* nA = has_next ? (const char*)g.A + (size_t)nxt.pm * tstep + (size_t)nxt.kt0 * (BK * 2) : cA; const char* nB = has_next ? (const char*)g.Bt + (size_t)nxt.pn * tstep + (size_t)nxt.kt0 * (BK * 2) : cB;
        const int nt = cur.nt;
        for (int t = 0; t < nt; t += 2) {
            const bool last = (t == nt - 2);
            const char* a1 = cA + (size_t)(t + 1) * kstep;
            const char* a2 = last ? nA : cA + (size_t)(t + 2) * kstep; const char* b2 = last ? nB : cB + (size_t)(t + 2) * kstep;
            const char* a3 = a2 + kstep; const char* b3 = b2 + kstep;
            if (last && has_next) S.a_ready(nxt);
            if constexpr (SP2) {
            PG8_LDB(B0, 0, 0); PG8_LDB(B1, 0, 1); PG8_SCHED; PG8_LDA(At, 0, 0); PG8_STAGE(PG8_SA(1, 1), a1 + hstep, voffA);
            PG8_WAIT_V(8); PG8_WAIT_L(0); PG8_BAR; PG8_MMA(0, 0, At, B0); PG8_MMA(0, 1, At, B1); PG8_BAR; PG8_SCHED;
            PG8_LDA(At, 0, 1); PG8_STAGE(PG8_SB(0, 0), b2, voffB); PG8_STAGE(PG8_SB(0, 1), b2 + hstep, voffB); PG8_STAGE(PG8_SA(0, 0), a2, voffA);
            PG8_WAIT_V(8); PG8_WAIT_L(0); PG8_BAR; PG8_MMA(1, 0, At, B0); PG8_MMA(1, 1, At, B1); PG8_BAR; PG8_SCHED;
            PG8_LDB(B0, 1, 0); PG8_LDB(B1, 1, 1); PG8_SCHED; PG8_LDA(At, 1, 0); PG8_STAGE(PG8_SA(0, 1), a2 + hstep, voffA);
            PG8_WAIT_V(8); PG8_WAIT_L(0); PG8_BAR; PG8_MMA(0, 0, At, B0); PG8_MMA(0, 1, At, B1); PG8_BAR; PG8_SCHED;
            PG8_LDA(At, 1, 1); PG8_STAGE(PG8_SB(1, 0), b3, voffB); PG8_STAGE(PG8_SB(1, 1), b3 + hstep, voffB); PG8_STAGE(PG8_SA(1, 0), a3, voffA);
            PG8_WAIT_V(8); PG8_WAIT_L(0); PG8_BAR; PG8_MMA(1, 0, At, B0); PG8_MMA(1, 1, At, B1); PG8_BAR; PG8_SCHED;
            } else {
            PG8_LDB(B0, 0, 0); PG8_SCHED; PG8_LDA(At, 0, 0); PG8_STAGE(PG8_SA(1, 1), a1 + hstep, voffA);
            PG8_WAIT_L(8); PG8_BAR; PG8_WAIT_L(0); PG8_MMA(0, 0, At, B0); PG8_BAR; PG8_SCHED;
            PG8_LDB(B1, 0, 1); PG8_STAGE(PG8_SB(0, 0), b2, voffB);
            PG8_BAR; PG8_WAIT_L(0); PG8_MMA(0, 1, At, B1); PG8_BAR;
            PG8_LDA(At, 0, 1); PG8_STAGE(PG8_SA(0, 0), a2, voffA);
            PG8_BAR; PG8_WAIT_L(0); PG8_MMA(1, 0, At, B0); PG8_BAR; PG8_SCHED;
            PG8_STAGE(PG8_SB(0, 1), b2 + hstep, voffB);
            PG8_WAIT_V(6); PG8_BAR; PG8_MMA(1, 1, At, B1); PG8_BAR;
            PG8_LDB(B0, 1, 0); PG8_SCHED; PG8_LDA(At, 1, 0); PG8_STAGE(PG8_SA(0, 1), a2 + hstep, voffA);
            PG8_WAIT_L(8); PG8_BAR; PG8_WAIT_L(0); PG8_MMA(0, 0, At, B0); PG8_BAR; PG8_SCHED;
            PG8_LDB(B1, 1, 1); PG8_STAGE(PG8_SB(1, 0), b3, voffB);
            PG8_BAR; PG8_WAIT_L(0); PG8_MMA(0, 1, At, B1); PG8_BAR;
            PG8_LDA(At, 1, 1); PG8_STAGE(PG8_SA(1, 0), a3, voffA);
            PG8_BAR; PG8_WAIT_L(0); PG8_MMA(1, 0, At, B0); PG8_BAR; PG8_SCHED;
            PG8_STAGE(PG8_SB(1, 1), b3 + hstep, voffB);
            PG8_WAIT_V(6); PG8_BAR; PG8_MMA(1, 1, At, B1); PG8_BAR;
            }
        }
        if constexpr (ALIGN_EPI) { if (wr == 0) PG8_BAR; }
        if constexpr (!Epi::AFTER_DRAIN) { E(acc, cur, wr, wc, fr, fq); S.done(cur); }
        if (!has_next) break;
#pragma unroll
        for (int a = 0; a < 2; ++a)
#pragma unroll
            for (int b = 0; b < 2; ++b)
#pragma unroll
                for (int m = 0; m < 4; ++m)
#pragma unroll
                    for (int n = 0; n < 2; ++n) acc[a][b][m][n] = (f32x4){0.f, 0.f, 0.f, 0.f};
        cur = nxt; cA = nA; cB = nB; ++ui;
        if constexpr (ALIGN_EPI) { if (wr == 1) PG8_BAR; }
    }
    PG8_WAIT_V(0);
    if constexpr (!ALIGN_EPI) { if (wr == 0) PG8_BAR; }
    PG8_BAR;
    if constexpr (Epi::AFTER_DRAIN) { E.fused(acc, cur, wr, wc, fr, fq, lds, wid, lane); S.done(cur); }
#undef PG8_SA
#undef PG8_SB
#undef PG8_STAGE
#undef PG8_LDA
#undef PG8_LDB
#undef PG8_MMA
#undef PG8_WAIT_V
#undef PG8_WAIT_L
#undef PG8_BAR
#undef PG8_SCHED
}
}

#ifndef PG8_SP2
#define PG8_SP2 true
#endif
#ifndef PG8_ALIGN
#define PG8_ALIGN true
#endif
#define XB_TMO      128
#define XB_XCNT(j)  (256  + 64 * (j))
#define XB_XSUB(j)  (1280 + 64 * (j))
#define XB_XGEN(j)  (2304 + 64 * (j))
#define XB_TOP      3328
#define XB_TOPGEN   3392
#define XCD_BAR_WORDS 3456
#define XB_SPIN_CAP (1u << 18)

__device__ __forceinline__ unsigned xb_ld(unsigned* p)              { return __hip_atomic_load(p, __ATOMIC_RELAXED, __HIP_MEMORY_SCOPE_AGENT); }
__device__ __forceinline__ unsigned xb_add(unsigned* p, unsigned v) { return __hip_atomic_fetch_add(p, v, __ATOMIC_RELAXED, __HIP_MEMORY_SCOPE_AGENT); }
__device__ __forceinline__ unsigned xb_xcc_id() { return (unsigned)__builtin_amdgcn_s_getreg((3 << 11) | 20) & 0xFu; }
#define XB_SPIN(cond, bar) do { unsigned _sp = 0; while (cond) { __builtin_amdgcn_s_sleep(1); \
    if ((++_sp & 255u) == 0u) { if (xb_ld(&(bar)[XB_TMO])) break; if (_sp > XB_SPIN_CAP) { atomicAdd(&(bar)[XB_TMO], 1u); break; } } } } while (0)

struct XcdBarrier {
    unsigned* bar; unsigned x;
    volatile LAS unsigned* st;
};

__device__ __forceinline__ XcdBarrier xcd_barrier_post(unsigned* bar, volatile LAS unsigned* st) {
    XcdBarrier b; b.bar = bar; b.x = xb_xcc_id(); b.st = st;
    if (threadIdx.x == 0) (void)xb_add(&bar[XB_XCNT(b.x)], 1u);
    return b;
}
__device__ __forceinline__ void xcd_barrier_complete(unsigned* bar, unsigned x, unsigned& nloc, unsigned& nx) {
    const unsigned G = gridDim.x * gridDim.y * gridDim.z;
    unsigned sum, cnt, mine, sp = 0u;
    for (;;) {
        sum = 0u; cnt = 0u; mine = 0u;
#pragma unroll
        for (unsigned j = 0; j < 16; ++j) { const unsigned c = xb_ld(&bar[XB_XCNT(j)]); sum += c; cnt += (c > 0u) ? 1u : 0u; mine = (j == x) ? c : mine; }
        if (sum == G) break;
        __builtin_amdgcn_s_sleep(1);
        if ((++sp & 255u) == 0u) { if (xb_ld(&bar[XB_TMO])) break; if (sp > XB_SPIN_CAP) { atomicAdd(&bar[XB_TMO], 1u); break; } }
    }
    nloc = mine > 0u ? mine : 1u; nx = cnt > 0u ? cnt : 1u;
}

__device__ __forceinline__ void xcd_barrier(const XcdBarrier& b) {
    asm volatile("s_waitcnt vmcnt(0)" ::: "memory");
    __syncthreads();
    if (threadIdx.x == 0) {
        unsigned* bar = b.bar;
        __builtin_amdgcn_s_waitcnt(0);
        unsigned nloc = b.st[0], nx = b.st[1];
        if (nloc == 0u) { xcd_barrier_complete(bar, b.x, nloc, nx); b.st[0] = nloc; b.st[1] = nx; }
        const unsigned old = xb_add(&bar[XB_XSUB(b.x)], 1u);
        const unsigned gen = old / nloc;
        if (old + 1u == (gen + 1u) * nloc) {
            __builtin_amdgcn_fence(__ATOMIC_RELEASE, "agent");
            asm volatile("s_waitcnt vmcnt(0)" ::: "memory");
            const unsigned og = xb_add(&bar[XB_TOP], 1u);
            const unsigned tg = og / nx;
            if (og + 1u == (tg + 1u) * nx) xb_add(&bar[XB_TOPGEN], 1u);
            else XB_SPIN(xb_ld(&bar[XB_TOPGEN]) == tg, bar);
            __builtin_amdgcn_fence(__ATOMIC_ACQUIRE, "agent");
            xb_add(&bar[XB_XGEN(b.x)], 1u);
            asm volatile("s_waitcnt vmcnt(0)" ::: "memory");
        } else {
            XB_SPIN(xb_ld(&bar[XB_XGEN(b.x)]) == gen, bar);
            __builtin_amdgcn_fence(__ATOMIC_ACQUIRE, "agent");
            asm volatile("s_waitcnt vmcnt(0)" ::: "memory");
        }
    }
    __syncthreads();
}

constexpr int SK_KS_O = 8, SK_KS_G = 4, SK_KS_D = 22;
typedef short v4i16_t __attribute__((ext_vector_type(4)));
__device__ __forceinline__ s16x4 tr16(const LAS unsigned char* p) { return __builtin_bit_cast(s16x4, __builtin_amdgcn_ds_read_tr16_b64_v4i16((LAS v4i16_t*)p)); }
__device__ __forceinline__ bf16x8 cat8(s16x4 a, s16x4 b) { return (bf16x8){a[0], a[1], a[2], a[3], b[0], b[1], b[2], b[3]}; }
__device__ __forceinline__ int crow(int r, int hi) { return (r & 3) + 8 * (r >> 2) + 4 * hi; }
__device__ __forceinline__ f32x16 mfma32(bf16x8 a, bf16x8 b, f32x16 c) { return __builtin_amdgcn_mfma_f32_32x32x16_bf16(a, b, c, 0, 0, 0); }
__device__ __forceinline__ f32x4 mfma16(bf16x8 a, bf16x8 b, f32x4 c) { return __builtin_amdgcn_mfma_f32_16x16x32_bf16(a, b, c, 0, 0, 0); }
__device__ __forceinline__ v4u pack8(const float* v) { v4u w; w.x = cvtpk(v[0], v[1]); w.y = cvtpk(v[2], v[3]); w.z = cvtpk(v[4], v[5]); w.w = cvtpk(v[6], v[7]); return w; }
__device__ __forceinline__ void unpack8(v4u w, float* v) { v[0] = bflo(w.x); v[1] = bfhi(w.x); v[2] = bflo(w.y); v[3] = bfhi(w.y); v[4] = bflo(w.z); v[5] = bfhi(w.z); v[6] = bflo(w.w); v[7] = bfhi(w.w); }

template <bool GU = false>
__device__ __forceinline__ void p0_transpose_tile(const float* W, int K, int N, bf16* WT, int tile, int lane) {
    const int nblk = N >> 6, kb = tile / nblk, nb = tile - kb * nblk, nq = lane & 15, kq = lane >> 4;
    const float* src = W + (size_t)(64 * kb + 16 * kq) * N + 64 * nb + 4 * nq;
    f32x4 v[16];
#pragma unroll
    for (int i = 0; i < 16; ++i) v[i] = *(const f32x4*)(src + (size_t)i * N);
    bf16* dst = WT + (size_t)((GU ? (nb >> 1) * 256 + (nb & 1) * 64 : 64 * nb) + 4 * nq) * K + 64 * kb + 16 * kq;
#pragma unroll
    for (int e = 0; e < 4; ++e) {
        v4u lo, hi;
        lo.x = cvtpk(v[0][e], v[1][e]); lo.y = cvtpk(v[2][e], v[3][e]); lo.z = cvtpk(v[4][e], v[5][e]); lo.w = cvtpk(v[6][e], v[7][e]);
        hi.x = cvtpk(v[8][e], v[9][e]); hi.y = cvtpk(v[10][e], v[11][e]); hi.z = cvtpk(v[12][e], v[13][e]); hi.w = cvtpk(v[14][e], v[15][e]);
        *(v4u*)(dst + (size_t)e * K) = lo; *(v4u*)(dst + (size_t)e * K + 8) = hi;
    }
}
__device__ __forceinline__ void p0_silu(const float* __restrict__ cp, const float* __restrict__ cs, bf16* __restrict__ SILU, int gtid, int NGT) {
    for (int it = gtid; it < 144 * 256; it += NGT) { const int r = it >> 8, c8 = (it & 255) * 8; float v[8];
        if (r < NMODR) { const float* src = ((r < 2) ? cp + (size_t)r * DM : cs + (size_t)(r - 2) * DM) + c8; const f32x4 a = *(const f32x4*)src, b = *(const f32x4*)(src + 4);
#pragma unroll
            for (int i = 0; i < 4; ++i) { v[i] = silu_f(a[i]); v[4 + i] = silu_f(b[i]); } }
        else {
#pragma unroll
            for (int i = 0; i < 8; ++i) v[i] = 0.f; }
        *(v4u*)(SILU + (size_t)r * DM + c8) = pack8(v); }
}
__device__ __forceinline__ void p0_mod_item(LAS unsigned char* lds, const bf16* __restrict__ SILU, const float* __restrict__ w_ada, const float* __restrict__ b_ada, float* __restrict__ MOD, int item, int tid, int lane, int wave) {
    const int n0 = 64 * item, nq = lane & 15, kg = lane >> 4, grp = wave >> 2, wq = wave & 3;
    f32x4 acc[5][4];
#pragma unroll
    for (int rb = 0; rb < 5; ++rb)
#pragma unroll
        for (int e = 0; e < 4; ++e) acc[rb][e] = (f32x4){0.f, 0.f, 0.f, 0.f};
    const float* wp = w_ada + (size_t)(512 * wq + 8 * kg) * NMODC + n0 + 4 * nq;
    const bf16* ap = SILU + (size_t)(80 * grp + nq) * DM + 512 * wq + 8 * kg;
    f32x4 bnA[8], bnB[8];
#pragma unroll
    for (int j = 0; j < 8; ++j) bnA[j] = *(const f32x4*)(wp + (size_t)j * NMODC);
#pragma unroll
    for (int j = 0; j < 8; ++j) bnB[j] = *(const f32x4*)(wp + (size_t)(32 + j) * NMODC);
#define MOD_STEP(BN, ks) do { \
        bf16x8 af[5]; \
        _Pragma("unroll") for (int rb = 0; rb < 5; ++rb) af[rb] = (grp == 1 && rb == 4) ? (bf16x8){0, 0, 0, 0, 0, 0, 0, 0} : *(const bf16x8*)(ap + (size_t)(16 * rb) * DM + 32 * (ks)); \
        __builtin_amdgcn_sched_barrier(0); \
        bf16x8 bfr[4]; \
        _Pragma("unroll") for (int e = 0; e < 4; ++e) { v4u w; w.x = cvtpk(BN[0][e], BN[1][e]); w.y = cvtpk(BN[2][e], BN[3][e]); w.z = cvtpk(BN[4][e], BN[5][e]); w.w = cvtpk(BN[6][e], BN[7][e]); bfr[e] = __builtin_bit_cast(bf16x8, w); } \
        __builtin_amdgcn_sched_barrier(0); \
        if ((ks) + 2 < 16) { _Pragma("unroll") for (int j = 0; j < 8; ++j) BN[j] = *(const f32x4*)(wp + (size_t)(32 * ((ks) + 2) + j) * NMODC); } \
        __builtin_amdgcn_sched_barrier(0); \
        _Pragma("unroll") for (int rb = 0; rb < 5; ++rb) \
            _Pragma("unroll") for (int e = 0; e < 4; ++e) acc[rb][e] = mfma16(af[rb], bfr[e], acc[rb][e]); \
        } while (0)
    for (int ks = 0; ks < 16; ks += 2) { MOD_STEP(bnA, ks); MOD_STEP(bnB, ks + 1); }
#undef MOD_STEP
    LAS float* SLB = (LAS float*)lds;
    __syncthreads();
#pragma unroll
    for (int ps = 0; ps < 2; ++ps) {
#pragma unroll
        for (int rr = 0; rr < 3; ++rr) { if (3 * ps + rr < 5) {
#pragma unroll
            for (int e = 0; e < 4; ++e)
#pragma unroll
                for (int reg = 0; reg < 4; ++reg) SLB[wave * 3072 + (16 * rr + 4 * kg + reg) * 64 + 4 * nq + e] = acc[(3 * ps + rr) < 5 ? 3 * ps + rr : 0][e][reg]; } }
        __syncthreads();
        for (int idx = tid; idx < 2 * 3072; idx += 512) { const int gg = idx / 3072, id2 = idx - gg * 3072, lr = id2 >> 6, cc = id2 & 63, r = 80 * gg + 48 * ps + lr;
            if (r < NMODR && 48 * ps + lr < 80) { float s = SLB[(4 * gg) * 3072 + id2];
#pragma unroll
                for (int w = 1; w < 4; ++w) s += SLB[(4 * gg + w) * 3072 + id2];
                MOD[(size_t)r * NMODC + n0 + cc] = s + b_ada[n0 + cc]; } }
        __syncthreads();
    }
}

__device__ __forceinline__ int mod_row(int r) { return r < MPROMPT ? (r >> 13) : 2 + (r - MPROMPT); }

__device__ __forceinline__ void lds_fill_vec(LAS float* dst, const float* __restrict__ src, int tid) { *(LAS f32x4*)(dst + 4 * tid) = *(const f32x4*)(src + 4 * tid); }
__device__ __forceinline__ f32x4 ldsv(const LAS float* v, int lane, int j, int q) { return *(const LAS f32x4*)(v + 8 * lane + 512 * j + 4 * q); }
__device__ __forceinline__ void load_row_f32(f32x4 (&d)[4][2], const float* __restrict__ p) {
#pragma unroll
    for (int j = 0; j < 4; ++j) { d[j][0] = *(const f32x4*)(p + 512 * j); d[j][1] = *(const f32x4*)(p + 512 * j + 4); } }
__device__ __forceinline__ void load_row_bf16(v4u (&d)[4], const bf16* __restrict__ p) {
#pragma unroll
    for (int j = 0; j < 4; ++j) d[j] = *(const v4u*)(p + 512 * j); }
__device__ __forceinline__ void p1_rows(LAS unsigned char* lds, const float* __restrict__ xp, const float* __restrict__ xs, const float* __restrict__ gpre, const float* __restrict__ MOD, bf16* __restrict__ H, int gw, int NGW, int tid, int lane) {
    LAS float* G = (LAS float*)lds; LAS float* SH = G + 2048; LAS float* SC = SH + 4096;
    lds_fill_vec(G, gpre, tid); lds_fill_vec(SH, MOD, tid); lds_fill_vec(SH + 2048, MOD + NMODC, tid); lds_fill_vec(SC, MOD + DM, tid); lds_fill_vec(SC + 2048, MOD + NMODC + DM, tid);
    __syncthreads();
    f32x4 nx[4][2];
    if (gw < MPROMPT) load_row_f32(nx, xp + (size_t)gw * DM + 8 * lane);
    for (int r = gw; r < MPROMPT; r += NGW) {
        f32x4 v[4][2];
#pragma unroll
        for (int j = 0; j < 4; ++j) { v[j][0] = nx[j][0]; v[j][1] = nx[j][1]; }
        if (r + NGW < MPROMPT) load_row_f32(nx, xp + (size_t)(r + NGW) * DM + 8 * lane);
        const int b = r >> 13; float ss = 0.f;
#pragma unroll
        for (int j = 0; j < 4; ++j)
#pragma unroll
            for (int i = 0; i < 4; ++i) ss += v[j][0][i] * v[j][0][i] + v[j][1][i] * v[j][1][i];
        const float rstd = rsqrtf(wave_sum(ss) * (1.0f / DM) + EPS);
        bf16* hrow = H + (size_t)r * DM + 8 * lane;
#pragma unroll
        for (int j = 0; j < 4; ++j) { float o[8];
#pragma unroll
            for (int q = 0; q < 2; ++q) { const f32x4 g = ldsv(G, lane, j, q), sh = ldsv(SH + 2048 * b, lane, j, q), sc = ldsv(SC + 2048 * b, lane, j, q);
#pragma unroll
                for (int i = 0; i < 4; ++i) o[4 * q + i] = v[j][q][i] * rstd * g[i] * (1.0f + sc[i]) + sh[i]; }
            *(v4u*)(hrow + 512 * j) = pack8(o); }
    }
    for (int r = MPROMPT + gw; r < MPAD; r += NGW) {
        bf16* hrow = H + (size_t)r * DM + 8 * lane;
        if (r >= MTOK) {
#pragma unroll
            for (int j = 0; j < 4; ++j) *(v4u*)(hrow + 512 * j) = (v4u){0u, 0u, 0u, 0u};
            continue; }
        f32x4 v[4][2]; load_row_f32(v, xs + (size_t)(r - MPROMPT) * DM + 8 * lane);
        const float* mr = MOD + (size_t)mod_row(r) * NMODC + 8 * lane; float ss = 0.f;
#pragma unroll
        for (int j = 0; j < 4; ++j)
#pragma unroll
            for (int i = 0; i < 4; ++i) ss += v[j][0][i] * v[j][0][i] + v[j][1][i] * v[j][1][i];
        const float rstd = rsqrtf(wave_sum(ss) * (1.0f / DM) + EPS);
#pragma unroll
        for (int j = 0; j < 4; ++j) { float o[8];
#pragma unroll
            for (int q = 0; q < 2; ++q) { const f32x4 g = ldsv(G, lane, j, q), sh = *(const f32x4*)(mr + 512 * j + 4 * q), sc = *(const f32x4*)(mr + DM + 512 * j + 4 * q);
#pragma unroll
                for (int i = 0; i < 4; ++i) o[4 * q + i] = v[j][q][i] * rstd * g[i] * (1.0f + sc[i]) + sh[i]; }
            *(v4u*)(hrow + 512 * j) = pack8(o); }
    }
    __syncthreads();
}
template <bool LDSMOD>
__device__ __forceinline__ void p5_finish(const float (&ov)[4][8], const f32x4 (&xv)[4][2], const LAS float* GP, const LAS float* GPRE, const LAS float* GT, const LAS float* SHF, const LAS float* SCF,
                                          const float* __restrict__ mr, float* __restrict__ x1r, bf16* __restrict__ hrow, int lane) {
    float ss = 0.f;
#pragma unroll
    for (int j = 0; j < 4; ++j)
#pragma unroll
        for (int i = 0; i < 8; ++i) ss += ov[j][i] * ov[j][i];
    const float rstd_o = rsqrtf(wave_sum(ss) * (1.0f / DM) + EPS);
    float x1[4][8]; float s1 = 0.f;
#pragma unroll
    for (int j = 0; j < 4; ++j)
#pragma unroll
        for (int q = 0; q < 2; ++q) { const f32x4 gp = ldsv(GP, lane, j, q), gt = LDSMOD ? ldsv(GT, lane, j, q) : *(const f32x4*)(mr + 2 * DM + 512 * j + 4 * q); f32x4 y;
#pragma unroll
            for (int i = 0; i < 4; ++i) { y[i] = xv[j][q][i] + gt[i] * (ov[j][4 * q + i] * rstd_o * gp[i]); x1[j][4 * q + i] = y[i]; s1 += y[i] * y[i]; }
            *(f32x4*)(x1r + 512 * j + 4 * q) = y; }
    const float rstd_1 = rsqrtf(wave_sum(s1) * (1.0f / DM) + EPS);
#pragma unroll
    for (int j = 0; j < 4; ++j) { float o[8];
#pragma unroll
        for (int q = 0; q < 2; ++q) { const f32x4 g = ldsv(GPRE, lane, j, q), sh = LDSMOD ? ldsv(SHF, lane, j, q) : *(const f32x4*)(mr + 3 * DM + 512 * j + 4 * q), sc = LDSMOD ? ldsv(SCF, lane, j, q) : *(const f32x4*)(mr + 4 * DM + 512 * j + 4 * q);
#pragma unroll
            for (int i = 0; i < 4; ++i) o[4 * q + i] = x1[j][4 * q + i] * rstd_1 * g[i] * (1.0f + sc[i]) + sh[i]; }
        *(v4u*)(hrow + 512 * j) = pack8(o); }
}
__device__ __forceinline__ void p5_rows(LAS unsigned char* lds, const float* __restrict__ xp, const float* __restrict__ xs, const bf16* __restrict__ O, const float* __restrict__ OS  ,
                                        const float* __restrict__ gpost, const float* __restrict__ gpre, const float* __restrict__ MOD, float* __restrict__ out, bf16* __restrict__ H2, int gw, int NGW, int tid, int lane) {
    LAS float* GP = (LAS float*)lds; LAS float* GPRE = GP + 2048; LAS float* GT = GPRE + 2048; LAS float* SHF = GT + 4096; LAS float* SCF = SHF + 4096;
    lds_fill_vec(GP, gpost, tid); lds_fill_vec(GPRE, gpre, tid);
#pragma unroll
    for (int b = 0; b < 2; ++b) { lds_fill_vec(GT + 2048 * b, MOD + b * NMODC + 2 * DM, tid); lds_fill_vec(SHF + 2048 * b, MOD + b * NMODC + 3 * DM, tid); lds_fill_vec(SCF + 2048 * b, MOD + b * NMODC + 4 * DM, tid); }
    __syncthreads();
    v4u no[4]; f32x4 nx[4][2];
    if (gw < MPROMPT) { load_row_bf16(no, O + (size_t)gw * DM + 8 * lane); load_row_f32(nx, xp + (size_t)gw * DM + 8 * lane); }
    for (int r = gw; r < MPROMPT; r += NGW) {
        float ov[4][8]; f32x4 xv[4][2];
#pragma unroll
        for (int j = 0; j < 4; ++j) { unpack8(no[j], ov[j]); xv[j][0] = nx[j][0]; xv[j][1] = nx[j][1]; }
        if (r + NGW < MPROMPT) { load_row_bf16(no, O + (size_t)(r + NGW) * DM + 8 * lane); load_row_f32(nx, xp + (size_t)(r + NGW) * DM + 8 * lane); }
        const int b = r >> 13;
        p5_finish<true>(ov, xv, GP, GPRE, GT + 2048 * b, SHF + 2048 * b, SCF + 2048 * b, nullptr, out + O_YP + (size_t)r * DM + 8 * lane, H2 + (size_t)r * DM + 8 * lane, lane);
    }
    for (int r = MPROMPT + gw; r < MPAD; r += NGW) {
        bf16* hrow = H2 + (size_t)r * DM + 8 * lane;
        if (r >= MTOK) {
#pragma unroll
            for (int j = 0; j < 4; ++j) *(v4u*)(hrow + 512 * j) = (v4u){0u, 0u, 0u, 0u};
            continue; }
        const int sr_ = r - MPROMPT; const float* sr = OS + (size_t)sr_ * DM + 8 * lane;
        float ov[4][8]; f32x4 xv[4][2]; load_row_f32(xv, xs + (size_t)sr_ * DM + 8 * lane);
#pragma unroll
        for (int j = 0; j < 4; ++j)
#pragma unroll
            for (int q = 0; q < 2; ++q) { f32x4 a = *(const f32x4*)(sr + 512 * j + 4 * q);
#pragma unroll
                for (int s = 1; s < SK_KS_O; ++s) a += *(const f32x4*)(sr + (size_t)s * NSAMP * DM + 512 * j + 4 * q);
#pragma unroll
                for (int i = 0; i < 4; ++i) ov[j][4 * q + i] = a[i]; }
        p5_finish<false>(ov, xv, GP, GPRE, nullptr, nullptr, nullptr, MOD + (size_t)mod_row(r) * NMODC + 8 * lane, out + O_YS + (size_t)sr_ * DM + 8 * lane, hrow, lane);
    }
    __syncthreads();
}
template <bool LDSMOD>
__device__ __forceinline__ void p9_finish(const float (&yv)[4][8], const f32x4 (&xv)[4][2], const LAS float* GP, const LAS float* GT, const float* __restrict__ mr, float* __restrict__ x1r, int lane) {
    float ss = 0.f;
#pragma unroll
    for (int j = 0; j < 4; ++j)
#pragma unroll
        for (int i = 0; i < 8; ++i) ss += yv[j][i] * yv[j][i];
    const float rstd = rsqrtf(wave_sum(ss) * (1.0f / DM) + EPS);
#pragma unroll
    for (int j = 0; j < 4; ++j)
#pragma unroll
        for (int q = 0; q < 2; ++q) { const f32x4 gp = ldsv(GP, lane, j, q), gt = LDSMOD ? ldsv(GT, lane, j, q) : *(const f32x4*)(mr + 5 * DM + 512 * j + 4 * q); f32x4 y;
#pragma unroll
            for (int i = 0; i < 4; ++i) y[i] = xv[j][q][i] + gt[i] * (yv[j][4 * q + i] * rstd * gp[i]);
            *(f32x4*)(x1r + 512 * j + 4 * q) = y; }
}
__device__ __forceinline__ void p9_rows(LAS unsigned char* lds, const bf16* __restrict__ YF, const float* __restrict__ YS  , const float* __restrict__ gpost, const float* __restrict__ MOD, float* out, int gw, int NGW, int tid, int lane) {
    LAS float* GP = (LAS float*)lds; LAS float* GT = GP + 2048;
    lds_fill_vec(GP, gpost, tid); lds_fill_vec(GT, MOD + 5 * DM, tid); lds_fill_vec(GT + 2048, MOD + NMODC + 5 * DM, tid);
    __syncthreads();
    v4u ny[4]; f32x4 nx[4][2];
    if (gw < MPROMPT) { load_row_bf16(ny, YF + (size_t)gw * DM + 8 * lane); load_row_f32(nx, out + O_YP + (size_t)gw * DM + 8 * lane); }
    for (int r = gw; r < MPROMPT; r += NGW) {
        float yv[4][8]; f32x4 xv[4][2];
#pragma unroll
        for (int j = 0; j < 4; ++j) { unpack8(ny[j], yv[j]); xv[j][0] = nx[j][0]; xv[j][1] = nx[j][1]; }
        if (r + NGW < MPROMPT) { load_row_bf16(ny, YF + (size_t)(r + NGW) * DM + 8 * lane); load_row_f32(nx, out + O_YP + (size_t)(r + NGW) * DM + 8 * lane); }
        p9_finish<true>(yv, xv, GP, GT + 2048 * (r >> 13), nullptr, out + O_YP + (size_t)r * DM + 8 * lane, lane);
    }
    for (int r = MPROMPT + gw; r < MTOK; r += NGW) {
        const int sr_ = r - MPROMPT; const float* sr = YS + (size_t)sr_ * DM + 8 * lane; float* x1r = out + O_YS + (size_t)sr_ * DM + 8 * lane;
        float yv[4][8]; f32x4 xv[4][2]; load_row_f32(xv, x1r);
#pragma unroll
        for (int j = 0; j < 4; ++j)
#pragma unroll
            for (int q = 0; q < 2; ++q) { f32x4 a = *(const f32x4*)(sr + 512 * j + 4 * q);
                for (int s = 1; s < SK_KS_D; ++s) a += *(const f32x4*)(sr + (size_t)s * NSAMP * DM + 512 * j + 4 * q);
#pragma unroll
                for (int i = 0; i < 4; ++i) yv[j][4 * q + i] = a[i]; }
        p9_finish<false>(yv, xv, GP, nullptr, MOD + (size_t)mod_row(r) * NMODC + 8 * lane, x1r, lane);
    }
}
__device__ __forceinline__ void p7_sample(const bf16* __restrict__ SL  , bf16* __restrict__ U, const float* __restrict__ state, const float* __restrict__ conv_w, const float* __restrict__ conv_b, float* __restrict__ out, int gtid, int NGT) {
    for (int it = gtid; it < NSAMP * (DFF / 8); it += NGT) {
        const int sb = it / (DFF / 8), c0 = 8 * (it - sb * (DFF / 8)), sc = (c0 >> 7) * 256 + (c0 & 127);
        float a[8], u[8], o[8];
#pragma unroll
        for (int i = 0; i < 8; ++i) { a[i] = 0.f; u[i] = 0.f; }
#pragma unroll
        for (int s = 0; s < SK_KS_G; ++s) { const bf16* r = SL + ((size_t)s * NSAMP + sb) * (2 * DFF) + sc; float ta[8], tu[8]; unpack8(*(const v4u*)r, ta); unpack8(*(const v4u*)(r + 128), tu);
#pragma unroll
            for (int i = 0; i < 8; ++i) { a[i] += ta[i]; u[i] += tu[i]; } }
#pragma unroll
        for (int q = 0; q < 2; ++q) { const f32x4 w0 = *(const f32x4*)(conv_w + c0 + 4 * q), w1 = *(const f32x4*)(conv_w + DFF + c0 + 4 * q), w2 = *(const f32x4*)(conv_w + 2 * DFF + c0 + 4 * q), bb = *(const f32x4*)(conv_b + c0 + 4 * q);
            const f32x4 s0 = *(const f32x4*)(state + (size_t)(sb * 2 + 0) * DFF + c0 + 4 * q), s1 = *(const f32x4*)(state + (size_t)(sb * 2 + 1) * DFF + c0 + 4 * q);
#pragma unroll
            for (int i = 0; i < 4; ++i) { const float cv = bb[i] + w0[i] * s0[i] + w1[i] * s1[i] + w2[i] * a[4 * q + i]; o[4 * q + i] = gelu_f(cv) * u[4 * q + i]; }
            *(f32x4*)(out + O_CS + (size_t)(sb * 2 + 0) * DFF + c0 + 4 * q) = s1;
            *(f32x4*)(out + O_CS + (size_t)(sb * 2 + 1) * DFF + c0 + 4 * q) = (f32x4){a[4 * q], a[4 * q + 1], a[4 * q + 2], a[4 * q + 3]}; }
        *(v4u*)(U + (size_t)(MPROMPT + sb) * DFF + c0) = pack8(o);
    }
}
__device__ __forceinline__ void p8_fixup(int pm, const float* __restrict__ AH, const float* __restrict__ A01, const float* __restrict__ U01, const float* __restrict__ conv_w, const float* __restrict__ conv_b, bf16* __restrict__ HID, int tid) {
    if (pm >= MPROMPT / 256 || (pm & 31) == 0) return;
    for (int ch = tid; ch < DFF / 8; ch += 512) { const int c0 = 8 * ch; float o0[8], o1[8];
#pragma unroll
        for (int q = 0; q < 2; ++q) { const int c = c0 + 4 * q;
            const f32x4 w0 = *(const f32x4*)(conv_w + c), w1 = *(const f32x4*)(conv_w + DFF + c), w2 = *(const f32x4*)(conv_w + 2 * DFF + c), bb = *(const f32x4*)(conv_b + c);
            const f32x4 p2 = *(const f32x4*)(AH + ((size_t)(pm - 1) * 2 + 0) * DFF + c), p1 = *(const f32x4*)(AH + ((size_t)(pm - 1) * 2 + 1) * DFF + c);
            const f32x4 a0 = *(const f32x4*)(A01 + ((size_t)pm * 2 + 0) * DFF + c), a1 = *(const f32x4*)(A01 + ((size_t)pm * 2 + 1) * DFF + c);
            const f32x4 u0 = *(const f32x4*)(U01 + ((size_t)pm * 2 + 0) * DFF + c), u1 = *(const f32x4*)(U01 + ((size_t)pm * 2 + 1) * DFF + c);
#pragma unroll
            for (int i = 0; i < 4; ++i) { o0[4 * q + i] = gelu_f(bb[i] + w0[i] * p2[i] + w1[i] * p1[i] + w2[i] * a0[i]) * u0[i]; o1[4 * q + i] = gelu_f(bb[i] + w0[i] * p1[i] + w1[i] * a0[i] + w2[i] * a1[i]) * u1[i]; } }
        *(v4u*)(HID + (size_t)(256 * pm) * DFF + c0) = pack8(o0); *(v4u*)(HID + (size_t)(256 * pm + 1) * DFF + c0) = pack8(o1); }
}
constexpr int MX_K = 0, MX_V = 32768, MX_VN = 65536, MX_STG = 98304, MX_TAB = 131072, MX_PART = MX_TAB + 1536, MX_END = MX_PART + 4096;
static_assert(MX_END <= MISC_OFF, "mixer LDS");
__device__ __forceinline__ void mixer_prompt_item(LAS unsigned char* lds, const bf16* __restrict__ Z, const f32x2* __restrict__ STAT, const bf16* __restrict__ TRIL, bf16* __restrict__ MERGED,
                                                  const float* __restrict__ sinks, const float* __restrict__ rel_bias, const float* __restrict__ lng, const float* __restrict__ lnb, const float* __restrict__ b_s,
                                                  int item, int tid, int lane, int wave) {
    asm volatile("" : "+v"(tid), "+v"(lane));
    const int g = item & 15, n = (item >> 4) & 63, b = item >> 10, kvh = g >> 2, R0 = b * SEQ + n * 128;
    LAS unsigned char* Kt = lds + MX_K; LAS unsigned char* Vt = lds + MX_V; LAS unsigned char* VNt = lds + MX_VN; LAS unsigned char* STG = lds + MX_STG + wave * 4096;
    LAS float* TAB = (LAS float*)(lds + MX_TAB); LAS f32x2* PART = (LAS f32x2*)(lds + MX_PART);
    const int hh = wave & 1, qb = wave >> 1, head = 2 * g + hh, ql = lane & 31, hi = lane >> 5;
    f32x2 st[8];
#pragma unroll
    for (int p = 0; p < 8; ++p) st[p] = STAT[(size_t)(8 * (tid >> 7) + p) * MPAD + R0 + (tid & 127)];
    v4u kreg[4], vreg[4], greg[4];
#pragma unroll
    for (int i = 0; i < 4; ++i) {
        const int q = tid + 512 * i, j = q >> 3, c = q & 7;
        if (n > 0 || j >= 128) { const bf16* src = Z + (size_t)(R0 - 128 + j) * DIN + 64 * kvh + 8 * c; kreg[i] = *(const v4u*)(src + CK); vreg[i] = *(const v4u*)(src + CV); }
    }
#pragma unroll
    for (int i = 0; i < 4; ++i) { const int q = tid + 512 * i, j = q >> 4, c = q & 15; greg[i] = *(const v4u*)(Z + (size_t)(R0 + j) * DIN + CG + 128 * g + 8 * c); }
    bf16x8 qf[4];
    { const bf16* qp = Z + (size_t)(R0 + 32 * qb + ql) * DIN + CQ + 64 * head + 8 * hi;
#pragma unroll
      for (int d0 = 0; d0 < 4; ++d0) qf[d0] = *(const bf16x8*)(qp + 16 * d0); }
    const float sk = sinks[head] * LOG2E;
    __syncthreads();
    { float s1 = 0.f, s2 = 0.f;
#pragma unroll
      for (int p = 0; p < 8; ++p) { s1 += st[p].x; s2 += st[p].y; }
      PART[tid] = (f32x2){s1, s2}; }
    if (tid < 384) {
        const int th = tid / 192, idx = tid - th * 192, dist = idx - 32;
        TAB[tid] = (dist >= 0 && dist <= 128) ? rel_bias[t5_bucket(dist) * 32 + 2 * g + th] * LOG2E : -1e30f;
    }
#pragma unroll
    for (int i = 0; i < 4; ++i) {
        const int q = tid + 512 * i, j = q >> 3, c = q & 7;
        if (n > 0 || j >= 128) {
            *(LAS v4u*)(Kt + j * 128 + ((c ^ ((j >> 1) & 7)) << 4)) = kreg[i];
            *(LAS v4u*)(Vt + (j >> 4) * 2048 + (c >> 2) * 1024 + ((j >> 3) & 1) * 512 + (j & 7) * 64 + (c & 3) * 16) = vreg[i];
        }
    }
    const int nsteps = 2 * (qb + 1);
    bf16x8 wf[8];
    { const bf16* wp = TRIL + ((size_t)g * 128 + 32 * qb + ql) * 128 + 8 * hi;
#pragma unroll
      for (int s = 0; s < 8; ++s) if (s < nsteps) wf[s] = *(const bf16x8*)(wp + 16 * s); }
    __syncthreads();
#pragma unroll
    for (int i = 0; i < 4; ++i) {
        const int q = tid + 512 * i, j = q >> 4, c = q & 15, ch = 128 * g + 8 * c;
        float v[8]; unpack8(greg[i], v);
        const f32x2 pa_ = PART[j], pb_ = PART[128 + j], pc_ = PART[256 + j], pd_ = PART[384 + j];
        const float mean = ((pa_.x + pb_.x) + (pc_.x + pd_.x)) * (1.0f / DM), var = ((pa_.y + pb_.y) + (pc_.y + pd_.y)) * (1.0f / DM) - mean * mean, rstd = rsqrtf(fmaxf(var, 0.f) + EPS);
#pragma unroll
        for (int qq = 0; qq < 2; ++qq) { const f32x4 gg = *(const f32x4*)(lng + ch + 4 * qq), bb = *(const f32x4*)(lnb + ch + 4 * qq);
#pragma unroll
            for (int k = 0; k < 4; ++k) v[4 * qq + k] = (v[4 * qq + k] - mean) * rstd * gg[k] + bb[k]; }
        *(LAS v4u*)(VNt + (j >> 4) * 4096 + (c >> 2) * 1024 + ((j >> 3) & 1) * 512 + (j & 7) * 64 + (c & 3) * 16) = pack8(v);
    }
    __syncthreads();
    const int tmin = (n == 0) ? (4 - qb) : 0;
    f32x16 p[5];
    int tboff = (hh * 192 + ql - 4 * hi + 5) * 4, kboff = (32 * qb + ql) * 128, swz = (ql >> 1) & 7;
    asm volatile("" : "+v"(tboff), "+v"(kboff), "+v"(swz));
    const LAS float* tb = (const LAS float*)((const LAS unsigned char*)TAB + tboff);
    const LAS unsigned char* kb0 = Kt + kboff;
#pragma unroll
    for (int t = 0; t < 5; ++t) {
        if (t >= tmin) {
            f32x16 acc = {};
#pragma unroll
            for (int d0 = 0; d0 < 4; ++d0) { const bf16x8 kf = *(const LAS bf16x8*)(kb0 + t * 4096 + (((2 * d0 + hi) ^ swz) << 4)); acc = mfma32(kf, qf[d0], acc); }
#pragma unroll
            for (int r = 0; r < 16; ++r) acc[r] += tb[155 - 32 * t - (r & 3) - 8 * (r >> 2)];
            p[t] = acc;
        } else {
#pragma unroll
            for (int r = 0; r < 16; ++r) p[t][r] = -1e30f;
        }
    }
    float m = -1e30f;
#pragma unroll
    for (int t = 0; t < 5; ++t)
#pragma unroll
        for (int r = 0; r < 16; ++r) m = fmaxf(m, p[t][r]);
    m = fmaxf(m, __shfl_xor(m, 32));
    m = fmaxf(m, sk);
    float sum = 0.f;
#pragma unroll
    for (int t = 0; t < 5; ++t)
#pragma unroll
        for (int r = 0; r < 16; ++r) { p[t][r] = fast_exp2(p[t][r] - m); sum += p[t][r]; }
    sum += __shfl_xor(sum, 32);
    const float inv = 1.0f / (sum + fast_exp2(sk - m));
    v4u mga[4], mgb[4], mu[4]; float bsv[4];
#pragma unroll
    for (int i = 0; i < 4; ++i) { const bf16* zr = Z + (size_t)(R0 + 32 * qb + 8 * i + (lane >> 3)) * DIN + 128 * g + 64 * hh + 8 * (lane & 7);
        mga[i] = *(const v4u*)(zr + CGA); mgb[i] = *(const v4u*)(zr + CGB); mu[i] = *(const v4u*)(zr + CU); bsv[i] = b_s[g * 128 + 32 * qb + 8 * i + (lane >> 3)]; }
    f32x16 o[2] = {{}, {}}, sg[2] = {{}, {}};
    int vlane = (4 * hi + ((lane & 15) >> 2)) * 64 + ((lane >> 4) & 1) * 32 + (lane & 3) * 8 + 2 * qb * 2048;
    asm volatile("" : "+v"(vlane));
#pragma unroll
    for (int t = 0; t < 5; ++t) {
        if (t >= tmin) {
#pragma unroll
            for (int s = 0; s < 2; ++s) {
                v4u pw; pw.x = cvtpk(p[t][8 * s + 0] * inv, p[t][8 * s + 1] * inv); pw.y = cvtpk(p[t][8 * s + 2] * inv, p[t][8 * s + 3] * inv);
                pw.z = cvtpk(p[t][8 * s + 4] * inv, p[t][8 * s + 5] * inv); pw.w = cvtpk(p[t][8 * s + 6] * inv, p[t][8 * s + 7] * inv);
                const bf16x8 pa = __builtin_bit_cast(bf16x8, pw);
                const LAS unsigned char* vp = Vt + (2 * t + s) * 2048 + vlane;
#pragma unroll
                for (int dh = 0; dh < 2; ++dh) { const bf16x8 vf = cat8(tr16(vp + dh * 1024), tr16(vp + dh * 1024 + 512)); o[dh] = mfma32(pa, vf, o[dh]); }
            }
        }
    }
    { int nlane = hi * 512 + ((lane & 15) >> 2) * 64 + ((lane >> 4) & 1) * 32 + (lane & 3) * 8 + (2 * hh) * 1024;
      asm volatile("" : "+v"(nlane));
#pragma unroll
      for (int s = 0; s < 8; ++s) {
          if (s < nsteps) {
              const LAS unsigned char* np = VNt + s * 4096 + nlane;
#pragma unroll
              for (int dh = 0; dh < 2; ++dh) { const bf16x8 vf = cat8(tr16(np + dh * 1024), tr16(np + dh * 1024 + 256)); sg[dh] = mfma32(wf[s], vf, sg[dh]); }
          }
      } }
    v4u t1[4], t2[4];
    int swoff = (4 * hi) * 128 + ql * 2, sroff = (lane >> 3) * 128 + (lane & 7) * 16;
    asm volatile("" : "+v"(swoff), "+v"(sroff));
    LAS unsigned char* stw = STG + swoff; const LAS unsigned char* str_ = STG + sroff;
#pragma unroll
    for (int dh = 0; dh < 2; ++dh)
#pragma unroll
        for (int r = 0; r < 16; ++r) *(LAS bf16*)(stw + ((r & 3) + 8 * (r >> 2)) * 128 + 64 * dh) = (bf16)(cvtpk(o[dh][r], 0.f) & 0xffffu);
    LDS_WAIT();
#pragma unroll
    for (int i = 0; i < 4; ++i) t1[i] = *(const LAS v4u*)(str_ + i * 1024);
    LDS_WAIT();
#pragma unroll
    for (int dh = 0; dh < 2; ++dh)
#pragma unroll
        for (int r = 0; r < 16; ++r) *(LAS bf16*)(stw + ((r & 3) + 8 * (r >> 2)) * 128 + 64 * dh) = (bf16)(cvtpk(sg[dh][r], 0.f) & 0xffffu);
    LDS_WAIT();
#pragma unroll
    for (int i = 0; i < 4; ++i) t2[i] = *(const LAS v4u*)(str_ + i * 1024);
    LDS_WAIT();
#pragma unroll
    for (int i = 0; i < 4; ++i) {
        const size_t grow = (size_t)(R0 + 32 * qb + 8 * i + (lane >> 3)); const int ch = 128 * g + 64 * hh + 8 * (lane & 7);
        float a[8], s[8], ga[8], gb[8], u[8], o8[8];
        unpack8(t1[i], a); unpack8(t2[i], s); unpack8(mga[i], ga); unpack8(mgb[i], gb); unpack8(mu[i], u);
#pragma unroll
        for (int k = 0; k < 8; ++k) o8[k] = ga[k] * a[k] + gb[k] * (u[k] * (s[k] + bsv[i]));
        *(v4u*)(MERGED + grow * DM + ch) = pack8(o8);
    }
}
constexpr int SM_K = 0, SM_V = 33792, SM_Q = SM_V + 129 * 64 * 4, SM_S = SM_Q + 2048, SM_R = SM_S + 8 * 132 * 4, SM_END = SM_R + 64;
static_assert(SM_K + 129 * 65 * 4 <= SM_V && SM_END <= RING_BYTES, "sample mixer LDS");
__device__ __forceinline__ void mixer_sample_item(LAS unsigned char* lds, const bf16* __restrict__ Z, bf16* __restrict__ MERGED, const float* __restrict__ cache_k, const float* __restrict__ cache_v,
                                                  const float* __restrict__ sinks, const float* __restrict__ rel_bias, const float* __restrict__ lng, const float* __restrict__ lnb,
                                                  const float* __restrict__ w_s, const float* __restrict__ b_s, float* __restrict__ out, int item, int tid, int lane, int wave) {
    asm volatile("" : "+v"(tid), "+v"(lane));
    const int kvh = item & 3, sb = item >> 2; const size_t zrow = (size_t)(MPROMPT + sb) * DIN;
    LAS float* KS = (LAS float*)(lds + SM_K); LAS float* VS = (LAS float*)(lds + SM_V); LAS float* QS = (LAS float*)(lds + SM_Q); LAS float* SC = (LAS float*)(lds + SM_S); LAS float* RED = (LAS float*)(lds + SM_R);
    const int head = 8 * kvh + wave, ch = 64 * head + lane, grp = ch >> 7;
    float kc[16], vc[16];
#pragma unroll
    for (int i = 0; i < 16; ++i) { const size_t ci = ((size_t)(sb * 128 + 8 * i + wave) * 4 + kvh) * 64 + lane; kc[i] = cache_k[ci]; vc[i] = cache_v[ci]; }
    const float knew = bf1(Z[zrow + CK + 64 * kvh + lane]), vnew = bf1(Z[zrow + CV + 64 * kvh + lane]);
    const float qv = bf1(Z[zrow + CQ + 64 * head + lane]);
    const v2u gvw = *(const v2u*)(Z + zrow + CG + 4 * tid);
    const float gvc = bf1(Z[zrow + CG + ch]), uc = bf1(Z[zrow + CU + ch]), gac = bf1(Z[zrow + CGA + ch]), gbc = bf1(Z[zrow + CGB + ch]);
    const float lg = lng[ch], lb = lnb[ch], ws0 = w_s[(size_t)grp * 128 * 128], bs0 = b_s[grp * 128], sk = sinks[head] * LOG2E;
    __syncthreads();
#pragma unroll
    for (int i = 0; i < 16; ++i) { const int j = 8 * i + wave; KS[j * 65 + lane] = kc[i]; VS[j * 64 + lane] = vc[i];
        if (j >= 1) { const size_t co = ((size_t)(sb * 128 + j - 1) * 4 + kvh) * 64 + lane; out[O_KS + co] = kc[i]; out[O_VS + co] = vc[i]; } }
    if (wave == 0) { KS[128 * 65 + lane] = knew; VS[128 * 64 + lane] = vnew; }
    QS[tid] = qv;
    { const float g0 = bflo(gvw.x), g1 = bfhi(gvw.x), g2 = bflo(gvw.y), g3 = bfhi(gvw.y);
      const float a = wave_sum((g0 + g1) + (g2 + g3)), q = wave_sum((g0 * g0 + g1 * g1) + (g2 * g2 + g3 * g3));
      if (lane == 0) { RED[wave] = a; RED[8 + wave] = q; } }
    __syncthreads();
    for (int e = tid; e < 8 * 129; e += 512) {
        const int h8 = e / 129, j = e - 129 * h8; float dot = 0.f;
#pragma unroll 16
        for (int d = 0; d < 64; ++d) dot += QS[h8 * 64 + d] * KS[j * 65 + d];
        SC[h8 * 132 + j] = dot + rel_bias[t5_bucket(128 - j) * 32 + 8 * kvh + h8] * LOG2E;
    }
    __syncthreads();
    { const float s0 = SC[wave * 132 + lane], s1 = SC[wave * 132 + 64 + lane], s2 = (lane == 0) ? SC[wave * 132 + 128] : -1e30f;
      const float m = fmaxf(wave_max(fmaxf(fmaxf(s0, s1), s2)), sk);
      const float e0 = fast_exp2(s0 - m), e1 = fast_exp2(s1 - m), e2 = fast_exp2(s2 - m);
      const float inv = 1.0f / (wave_sum(e0 + e1 + e2) + fast_exp2(sk - m));
      SC[wave * 132 + lane] = e0 * inv; SC[wave * 132 + 64 + lane] = e1 * inv; if (lane == 0) SC[wave * 132 + 128] = e2 * inv; }
    LDS_WAIT();
    float ya = 0.f;
#pragma unroll 3
    for (int j = 0; j < 129; ++j) ya += SC[wave * 132 + j] * VS[j * 64 + lane];
    float s1 = 0.f, s2 = 0.f;
#pragma unroll
    for (int w = 0; w < 8; ++w) { s1 += RED[w]; s2 += RED[8 + w]; }
    const float mean = s1 * (1.0f / DM), var = s2 * (1.0f / DM) - mean * mean, rstd = rsqrtf(fmaxf(var, 0.f) + EPS);
    const float vn = (gvc - mean) * rstd * lg + lb;
    out[O_SG + (size_t)sb * DM + ch] = vn;
    const float mg = gac * ya + gbc * (uc * (ws0 * vn + bs0));
    MERGED[(size_t)(MPROMPT + sb) * DM + ch] = (bf16)(cvtpk(mg, 0.f) & 0xffffu);
}
constexpr int NWAVES = 8, G_NOM = 256;
constexpr int CW_BAR = 4096;
static_assert((CW_BAR + XCD_BAR_WORDS) * 4 <= (int)CTL_ZERO_BYTES, "control words inside the memset region");
constexpr int N_PHASES = 10;
struct Args { const float* in[26]; float* out; unsigned char* ws; int ph_lo, ph_hi; };

__global__ void __launch_bounds__(NWAVES * 64, 2) fwd_kernel(Args args) {
    extern __shared__ __attribute__((aligned(16))) unsigned char lds_raw[];
    LAS unsigned char* lds = (LAS unsigned char*)lds_raw;
    volatile LAS unsigned* MISC = (volatile LAS unsigned*)(lds + MISC_OFF);
    const int tid = threadIdx.x, lane = tid & 63, wave = __builtin_amdgcn_readfirstlane(tid >> 6);
    const int G = gridDim.x, bx = blockIdx.x, vcu = (G % 8 == 0) ? (bx % 8) * (G / 8) + bx / 8 : bx;
    const int gw = vcu * NWAVES + wave, NGW = G * NWAVES;
    unsigned char* ws = args.ws; float* out = args.out;
    gu32* ctl = (gu32*)(ws + WS_CTL);
    float* MOD = (float*)(ws + WS_MOD); f32x2* STAT = (f32x2*)(ws + WS_STAT); bf16* TRIL = (bf16*)(ws + WS_TRIL);
    bf16* WO_T = (bf16*)(ws + WS_WO); bf16* WGU_T = (bf16*)(ws + WS_WGU); bf16* WD_T = (bf16*)(ws + WS_WD); bf16* WIN_T = (bf16*)(ws + WS_WIN);
    bf16* Zb = (bf16*)(ws + WS_Z); bf16* Ob = (bf16*)(ws + WS_O); bf16* ABUF = (bf16*)(ws + WS_ABUF); bf16* UBUF = (bf16*)(ws + WS_UBUF); bf16* H2 = (bf16*)(ws + WS_H2); bf16* YF = (bf16*)(ws + WS_YF);
    bf16* SILU = (bf16*)(ws + WS_SILU); float* AH = (float*)(ws + WS_ARENA + 152 * MiB); float* A01 = AH + (size_t)64 * 2 * DFF; float* U01 = A01 + (size_t)64 * 2 * DFF;
    float* SLAB = (float*)(ws + WS_SLAB); bf16* SLABGU = (bf16*)(ws + WS_SLABGU);
    bf16* Hb = (bf16*)out;
    for (int u = tid; u < 32; u += NWAVES * 64) MISC[u] = 0u;
    __syncthreads();
    const int lo = args.ph_lo, hi = args.ph_hi;
    const bool one_launch = (hi - lo) > 1;
    XcdBarrier bar; bar.bar = (unsigned*)(ctl + CW_BAR); bar.x = 0; bar.st = nullptr;
    if (one_launch) bar = xcd_barrier_post((unsigned*)(ctl + CW_BAR), MISC + 8);
#define IN(k) (lo <= (k) && (k) < hi)
#ifndef PROBE_PHASE
#define PROBE_PHASE -1
#endif
    unsigned long long pt0 = 0ull, pt1 = 0ull;
#define SEAM(k) do { if (IN(k) && IN((k) + 1)) xcd_barrier(bar); if (PROBE_PHASE == (k) + 1) pt0 = __builtin_amdgcn_s_memrealtime(); if (PROBE_PHASE == (k)) pt1 = __builtin_amdgcn_s_memrealtime(); } while (0)
    if (PROBE_PHASE == 0) pt0 = __builtin_amdgcn_s_memrealtime();

    if (IN(0)) {
        p0_silu(args.in[2], args.in[3], SILU, vcu * 512 + tid, G * 512);
        if (one_launch) xcd_barrier(bar);
        if (bx < NMODC / 64) p0_mod_item(lds, SILU, args.in[7], args.in[8], MOD, bx, tid, lane, wave);
        constexpr int T_IN = 32 * 168, T_G = 32 * 88, T_ALL = T_IN + 2 * T_G;
        constexpr int NMB = NMODC / 64, T_HEAD = (G_NOM - NMB) * NWAVES * 3;
        const bool head_ok = (G > NMB);
        for (int pass = 0; pass < 2; ++pass) {
            int it, step, end;
            if (pass == 0) { if (!head_ok || bx < NMB) continue; it = (bx - NMB) * NWAVES + wave; step = (G - NMB) * NWAVES; end = T_HEAD; }
            else { it = (head_ok ? T_HEAD : 0) + gw; step = NGW; end = T_ALL; }
            for (; it < end; it += step) {
                int r = it;
                if (r < T_IN) { p0_transpose_tile(args.in[13], DM, DIN, WIN_T, r, lane); continue; } r -= T_IN;
                if (r < T_G) { p0_transpose_tile<true>(args.in[22], DM, DFF, WGU_T, r, lane); continue; } r -= T_G;
                p0_transpose_tile<true>(args.in[21], DM, DFF, WGU_T + (size_t)128 * DM, r, lane);
            }
        }
        { const float* w_s = args.in[19];
          for (int it = vcu * 512 + tid; it < 16 * 128 * 128 / 8; it += G * 512) { const int e0 = 8 * it, j0 = e0 & 127, i = (e0 >> 7) & 127;
              const f32x4 a = *(const f32x4*)(w_s + e0), b = *(const f32x4*)(w_s + e0 + 4); float v[8];
#pragma unroll
              for (int k = 0; k < 4; ++k) { v[k] = (j0 + k <= i) ? a[k] : 0.f; v[4 + k] = (j0 + 4 + k <= i) ? b[k] : 0.f; }
              *(v4u*)(TRIL + e0) = pack8(v); } }
    }
    SEAM(0);
    if (IN(1)) p1_rows(lds, args.in[0], args.in[1], args.in[9], MOD, Hb, gw, NGW, tid, lane);
    SEAM(1);
    if (IN(2)) {
        pg8::Gemm g{Hb, WIN_T, MPROMPT, DIN, DM}; pg8::SplitOrder S; S.init(MPROMPT, DIN, DM, 1, G, bx);
        pg8::EpiZ E{Zb, out, STAT};
        pg8::gemm_phase<pg8::EpiZ, pg8::SplitOrder, PG8_ALIGN, PG8_SP2>(lds, g, S, E);
        { const int total = S.nwg + S.nN * S.KS, rounds = (total + G - 1) / G, nbusy = total - (rounds - 1) * G;
          if (nbusy < G && bx >= nbusy) { constexpr int T_O = 32 * 32, T_D = 88 * 32;
              for (int it = (bx - nbusy) * NWAVES + wave; it < T_O + T_D; it += (G - nbusy) * NWAVES) {
                  if (it < T_O) p0_transpose_tile(args.in[14], DM, DM, WO_T, it, lane); else p0_transpose_tile(args.in[25], DFF, DM, WD_T, it - T_O, lane); } }
          else if (nbusy >= G) { constexpr int T_O = 32 * 32, T_D = 88 * 32;
              for (int it = gw; it < T_O + T_D; it += NGW) { if (it < T_O) p0_transpose_tile(args.in[14], DM, DM, WO_T, it, lane); else p0_transpose_tile(args.in[25], DFF, DM, WD_T, it - T_O, lane); } } }
    }
    SEAM(2);
    if (IN(3)) {
        for (int it = vcu; it < 2048; it += G) mixer_prompt_item(lds, Zb, STAT, TRIL, Hb, args.in[15], args.in[16], args.in[17], args.in[18], args.in[20], it, tid, lane, wave);
        for (int it = vcu; it < 512; it += G) mixer_sample_item(lds, Zb, Hb, args.in[4], args.in[5], args.in[15], args.in[16], args.in[17], args.in[18], args.in[19], args.in[20], out, it, tid, lane, wave);
    }
    SEAM(3);
    if (IN(4)) {
        pg8::Gemm g{Hb, WO_T, MPROMPT, DM, DM}; pg8::SplitOrder S; S.init(MPROMPT, DM, DM, SK_KS_O, G, bx);
        pg8::EpiPlain E{Ob, DM, SLAB};
        pg8::gemm_phase<pg8::EpiPlain, pg8::SplitOrder, PG8_ALIGN, PG8_SP2>(lds, g, S, E);
    }
    SEAM(4);
    if (IN(5)) p5_rows(lds, args.in[0], args.in[1], Ob, SLAB, args.in[10], args.in[11], MOD, out, H2, gw, NGW, tid, lane);
    SEAM(5);
    if (IN(6)) {
        pg8::Gemm g{H2, WGU_T, MPROMPT, 2 * DFF, DM}; pg8::SplitOrder S; S.init(MPROMPT, 2 * DFF, DM, SK_KS_G, G, bx);
        pg8::EpiGUF E{UBUF, out, SLABGU, AH, A01, U01, args.in[23], args.in[24], (LAS float*)(lds + RING_BYTES)};
        pg8::gemm_phase<pg8::EpiGUF, pg8::SplitOrder, true, PG8_SP2>(lds, g, S, E);
    }
    SEAM(6);
    if (IN(7)) {
        p7_sample(SLABGU, UBUF, args.in[6], args.in[23], args.in[24], out, vcu * 512 + tid, G * 512);
    }
    SEAM(7);
    if (IN(8)) {
        pg8::Gemm g{UBUF, WD_T, MPROMPT, DM, DFF}; pg8::SplitOrder S; S.init(MPROMPT, DM, DFF, SK_KS_D, G, bx);
        { pg8::Unit fu; for (int i = 0; S.next(i, fu); ++i) p8_fixup(fu.pm, AH, A01, U01, args.in[23], args.in[24], UBUF, tid); }
        VM_WAIT(); __syncthreads();
        pg8::EpiPlain E{YF, DM, SLAB};
        pg8::gemm_phase<pg8::EpiPlain, pg8::SplitOrder, PG8_ALIGN, PG8_SP2>(lds, g, S, E);
    }
    SEAM(8);
    if (IN(9)) p9_rows(lds, YF, SLAB, args.in[12], MOD, out, gw, NGW, tid, lane);
    if (PROBE_PHASE >= 0) { if (PROBE_PHASE == 9) pt1 = __builtin_amdgcn_s_memrealtime();
        if (bx == 0 && tid == 0) { const unsigned long long te = __builtin_amdgcn_s_memrealtime(), dl = 4ull * (pt1 - pt0); while (__builtin_amdgcn_s_memrealtime() - te < dl) __builtin_amdgcn_s_sleep(32); } }
#undef IN
#undef SEAM
}

extern "C" void kernel_launch(void* const* d_in, const int* in_sizes, int n_in, void* d_out, int out_size, void* d_ws, size_t ws_size, hipStream_t stream) {
    static int grid = 0;
    if (grid == 0) {
        if (n_in != 26 || in_sizes[0] != MPROMPT * DM || out_size != (int)O_END || ws_size < WS_END) {
            fprintf(stderr, "kernel_launch: unexpected problem shape (n_in %d, in0 %d, out %d, ws %zu); nothing launched\n", n_in, n_in > 0 ? in_sizes[0] : -1, out_size, ws_size); grid = -1; return; }
        int dev = 0, cus = 0, per_cu = 0;
        if (hipGetDevice(&dev) != hipSuccess || hipDeviceGetAttribute(&cus, hipDeviceAttributeMultiprocessorCount, dev) != hipSuccess) { grid = -1; return; }
        if (hipFuncSetAttribute((const void*)fwd_kernel, hipFuncAttributeMaxDynamicSharedMemorySize, LDS_BYTES) != hipSuccess) { fprintf(stderr, "kernel_launch: hipFuncSetAttribute failed\n"); grid = -1; return; }
        if (hipOccupancyMaxActiveBlocksPerMultiprocessor(&per_cu, (const void*)fwd_kernel, NWAVES * 64, LDS_BYTES) != hipSuccess || per_cu < 1) { fprintf(stderr, "kernel_launch: occupancy query says %d blocks per CU; nothing launched\n", per_cu); (void)hipGetLastError(); grid = -1; return; }
        grid = cus;
    }
    if (grid < 0) return;
    if (hipMemsetAsync((char*)d_ws + WS_CTL, 0, CTL_ZERO_BYTES, stream) != hipSuccess) return;
    Args a{};
    for (int i = 0; i < 26; ++i) a.in[i] = (const float*)d_in[i];
    a.out = (float*)d_out; a.ws = (unsigned char*)d_ws;
    a.ph_lo = 0; a.ph_hi = N_PHASES;
    void* kargs[] = {&a};
    hipError_t e = hipLaunchCooperativeKernel((const void*)fwd_kernel, dim3(grid), dim3(NWAVES * 64), kargs, LDS_BYTES, stream);
    if (e != hipSuccess) fprintf(stderr, "kernel_launch: cooperative launch failed: %s (grid %d)\n", hipGetErrorString(e), grid);

}
```
